# Optimizing an MI355X kernel written in HIP

```python
import jax, jax.numpy as jnp
from jax import lax
import numpy as np

D_MODEL = 1024
BATCH = 16
SEQ = 4096
DEPTH = 2
DEC_BATCH = 16
DEC_SEQ = 16
PAST_LEN = 2048

CHUNK = 64
A_WIDTH = 256
A_GROUPS = 4
A_GDIM = A_WIDTH // A_GROUPS
A_CHUNK = 128
B_HEADS = 4
B_DK = 64
B_DV = 64
B_KWIDTH = B_HEADS * B_DK
B_WIDTH = B_HEADS * B_DV
C_HEADS = 8
C_KV_HEADS = 2
C_REP = C_HEADS // C_KV_HEADS
C_HEAD_DIM = 64
C_WIDTH = C_HEADS * C_HEAD_DIM
C_KV_WIDTH = C_KV_HEADS * C_HEAD_DIM
WINDOW = 128
WIN_CHUNKS = WINDOW // CHUNK
CACHE_ROWS = min(WINDOW, PAST_LEN)
ROPE_DIM = C_HEAD_DIM // 4
ROPE_THETA = 500000.0
MIX_WIDTH = A_WIDTH + B_WIDTH + C_WIDTH
IN_SIZES = (A_WIDTH, A_WIDTH, A_WIDTH, B_KWIDTH, B_KWIDTH, B_WIDTH, B_WIDTH, C_WIDTH, C_KV_WIDTH, C_KV_WIDTH, C_WIDTH)
IN_WIDTH = sum(IN_SIZES)
DEEPNORM_ALPHA = (2 * DEPTH) ** 0.25
DEEPNORM_BETA = (8 * DEPTH) ** -0.25
LN_EPS = 1e-5
RMS_EPS = 1e-6

kernel_name = "hybrid_stream_gmlp_hgrn2_swa_step"


def layer_norm(x, g, b):
    xf = x.astype(jnp.float32)
    mu = xf.mean(-1, keepdims=True)
    var = jnp.square(xf - mu).mean(-1, keepdims=True)
    return ((xf - mu) * lax.rsqrt(var + LN_EPS) * g.astype(jnp.float32) + b.astype(jnp.float32)).astype(x.dtype)


def rope_partial(x, pos):
    half = ROPE_DIM // 2
    inv = jnp.power(jnp.float32(ROPE_THETA), -jnp.arange(0, ROPE_DIM, 2, dtype=jnp.float32) / ROPE_DIM)
    ang = pos.astype(jnp.float32)[:, None] * inv[None, :]
    cos = jnp.cos(ang)[None, :, None, :]
    sin = jnp.sin(ang)[None, :, None, :]
    xr = x[..., :ROPE_DIM].astype(jnp.float32)
    x1, x2 = xr[..., :half], xr[..., half:]
    rot = jnp.concatenate([x1 * cos - x2 * sin, x2 * cos + x1 * sin], axis=-1)
    return jnp.concatenate([rot.astype(x.dtype), x[..., ROPE_DIM:]], axis=-1)


def sgu(u, v, ln_g, ln_b, w_s, b_s):
    B_, T, _ = v.shape
    vn = layer_norm(v, ln_g, ln_b)
    L = min(T, A_CHUNK)
    nc = T // L
    vg = vn.reshape(B_, nc, L, A_GROUPS, A_GDIM)
    idx = jnp.arange(L)
    mask = (idx[None, :] // CHUNK) <= (idx[:, None] // CHUNK)
    ws = jnp.where(mask[None], w_s[:, :L, :L], jnp.zeros((), w_s.dtype))
    mixed = jnp.einsum('gij,bcjgd->bcigd', ws, vg) + b_s[:, :L].T[None, None, :, :, None]
    return u * mixed.reshape(B_, T, A_WIDTH).astype(u.dtype), vn


def hgrn2_block(q, k, v, logf, S):
    L = q.shape[1]
    G = jnp.cumsum(logf, axis=1)
    causal = jnp.tril(jnp.ones((L, L), dtype=bool))
    diff = G[:, :, None] - G[:, None, :]
    decay = jnp.exp(jnp.where(causal[None, :, :, None, None], diff, -jnp.inf))
    A = jnp.einsum('bihk,bjhk,bijhk->bhij', q, k, decay)
    o = jnp.einsum('bhij,bjhv->bihv', A, v) + jnp.einsum('bihk,bhkv->bihv', q * jnp.exp(G), S)
    GL = G[:, -1]
    S_new = jnp.exp(GL)[..., None] * S + jnp.einsum('bjhk,bjhv->bhkv', k * jnp.exp(GL[:, None] - G), v)
    return o, S_new


def hgrn2_scan(q, k, v, logf):
    B_, T, H, _ = q.shape
    nc = T // CHUNK

    def to_chunks(a):
        return a.reshape(B_, nc, CHUNK, H, a.shape[-1]).swapaxes(0, 1)

    def step(S, blk):
        qc, kc, vc, gc = blk
        o, S = hgrn2_block(qc, kc, vc, gc, S)
        return S, o

    S0 = jnp.zeros((B_, H, B_DK, B_DV), jnp.float32)
    S_T, o = lax.scan(step, S0, (to_chunks(q), to_chunks(k), to_chunks(v), to_chunks(logf)))
    return o.swapaxes(0, 1).reshape(B_, T, H, B_DV), S_T


def sink_attention(q, k, v, sinks, key_valid):
    B_, C, Q, H, D = q.shape
    qg = q.reshape(B_, C, Q, C_KV_HEADS, C_REP, D).astype(jnp.float32)
    s = jnp.einsum('bcqgrd,bckgd->bcgrqk', qg, k.astype(jnp.float32)) * (D ** -0.5)
    if key_valid is not None:
        s = jnp.where(key_valid[None, :, None, None, None, :], s, -jnp.inf)
    sink = jnp.broadcast_to(sinks.astype(jnp.float32).reshape(1, 1, C_KV_HEADS, C_REP, 1, 1), s.shape[:-1] + (1,))
    p = jax.nn.softmax(jnp.concatenate([s, sink], axis=-1), axis=-1)[..., :-1]
    o = jnp.einsum('bcgrqk,bckgd->bcqgrd', p, v.astype(jnp.float32))
    return o.reshape(B_, C, Q, H * D)


def swa_prompt(q, k, v, sinks):
    B_, T, H, D = q.shape
    nc = T // CHUNK
    pad = WIN_CHUNKS * CHUNK
    kp = jnp.pad(k, ((0, 0), (pad, 0), (0, 0), (0, 0)))
    vp = jnp.pad(v, ((0, 0), (pad, 0), (0, 0), (0, 0)))

    def band(a):
        return jnp.concatenate([a[:, w * CHUNK: w * CHUNK + T].reshape(B_, nc, CHUNK, C_KV_HEADS, D)
                                for w in range(WIN_CHUNKS + 1)], axis=2)

    valid = (jnp.arange(nc)[:, None] + jnp.arange(WIN_CHUNKS + 1)[None, :]) >= WIN_CHUNKS
    valid = jnp.repeat(valid, CHUNK, axis=1)
    o = sink_attention(q.reshape(B_, nc, CHUNK, H, D), band(kp), band(vp), sinks, valid)
    return o.reshape(B_, T, H * D)


def trunk_layer(x, pos, w_in, ln_v_g, ln_v_b, w_s, b_s, lb, norm_b_g, sinks, w_out, ln_g, ln_b,
                state=None, cache=None):
    B_, T, _ = x.shape
    h = x @ w_in
    split_pts = np.cumsum(IN_SIZES)[:-1].tolist()
    uA, vA, zA, qB, fB, iB, zB, qC, kC, vC, zC = jnp.split(h, split_pts, axis=-1)

    yA, vA_rows = sgu(uA, vA, ln_v_g, ln_v_b, w_s, b_s)
    yA = yA * jax.nn.silu(zA)

    f = lb + (1.0 - lb) * jax.nn.sigmoid(fB.astype(jnp.float32))
    logf = jnp.log(f).reshape(B_, T, B_HEADS, B_DK)
    kh = (1.0 - f).reshape(B_, T, B_HEADS, B_DK)
    qh = jax.nn.silu(qB.astype(jnp.float32)).reshape(B_, T, B_HEADS, B_DK)
    vh = iB.astype(jnp.float32).reshape(B_, T, B_HEADS, B_DV)
    if state is None:
        oB, S_new = hgrn2_scan(qh, kh, vh, logf)
    else:
        oB, S_new = hgrn2_block(qh, kh, vh, logf, state.astype(jnp.float32))
    oB = oB * lax.rsqrt(jnp.mean(jnp.square(oB), axis=-1, keepdims=True) + RMS_EPS) * norm_b_g.astype(jnp.float32)
    yB = oB.reshape(B_, T, B_WIDTH).astype(x.dtype) * jax.nn.silu(zB)

    q = rope_partial(qC.reshape(B_, T, C_HEADS, C_HEAD_DIM), pos)
    k = rope_partial(kC.reshape(B_, T, C_KV_HEADS, C_HEAD_DIM), pos)
    v = vC.reshape(B_, T, C_KV_HEADS, C_HEAD_DIM)
    if cache is None:
        oC = swa_prompt(q, k, v, sinks)
        k_keep, v_keep = k[:, -CACHE_ROWS:], v[:, -CACHE_ROWS:]
    else:
        ck, cv = cache
        k_all = jnp.concatenate([ck.astype(k.dtype), k], axis=1)
        v_all = jnp.concatenate([cv.astype(v.dtype), v], axis=1)
        oC = sink_attention(q[:, None], k_all[:, None], v_all[:, None], sinks, None)[:, 0]
        k_keep, v_keep = k, v
    yC = oC.astype(x.dtype) * jax.nn.silu(zC)

    mix = jnp.concatenate([yA, yB, yC], axis=-1)
    out = layer_norm(DEEPNORM_ALPHA * x + mix @ w_out, ln_g, ln_b)
    return out, vA_rows, S_new.astype(x.dtype), k_keep, v_keep


def setup_inputs(seed: int = 0) -> dict:
    key = jax.random.key(seed)
    ks = jax.random.split(key, 16)
    nrm = jax.random.normal
    f32 = jnp.float32
    return {
        "x_prompt": nrm(ks[0], (BATCH, SEQ, D_MODEL), f32),
        "x_sample": nrm(ks[1], (DEC_BATCH, DEC_SEQ, D_MODEL), f32),
        "cache_k": nrm(ks[2], (DEPTH, DEC_BATCH, CACHE_ROWS, C_KV_HEADS, C_HEAD_DIM), f32),
        "cache_v": nrm(ks[3], (DEPTH, DEC_BATCH, CACHE_ROWS, C_KV_HEADS, C_HEAD_DIM), f32),
        "state_hgrn": 0.5 * nrm(ks[4], (DEPTH, DEC_BATCH, B_HEADS, B_DK, B_DV), f32),
        "w_in": nrm(ks[5], (DEPTH, D_MODEL, IN_WIDTH), f32) * D_MODEL ** -0.5,
        "ln_v_g": 1.0 + 0.02 * nrm(ks[6], (DEPTH, A_WIDTH), f32),
        "ln_v_b": 0.02 * nrm(ks[7], (DEPTH, A_WIDTH), f32),
        "w_s": nrm(ks[8], (DEPTH, A_GROUPS, A_CHUNK, A_CHUNK), f32) * A_CHUNK ** -0.5,
        "b_s": 1.0 + 0.02 * nrm(ks[9], (DEPTH, A_GROUPS, A_CHUNK), f32),
        "lb_param": 0.1 * nrm(ks[10], (DEPTH, B_KWIDTH), f32),
        "norm_b_g": 1.0 + 0.02 * nrm(ks[11], (DEPTH, B_DV), f32),
        "sinks": 0.5 * nrm(ks[12], (DEPTH, C_HEADS), f32),
        "w_out": nrm(ks[13], (DEPTH, MIX_WIDTH, D_MODEL), f32) * (MIX_WIDTH ** -0.5) * DEEPNORM_BETA,
        "ln_g": 1.0 + 0.02 * nrm(ks[14], (DEPTH, D_MODEL), f32),
        "ln_b": 0.02 * nrm(ks[15], (DEPTH, D_MODEL), f32),
    }


def reference(x_prompt, x_sample, cache_k, cache_v, state_hgrn, w_in, ln_v_g, ln_v_b, w_s, b_s,
              lb_param, norm_b_g, sinks, w_out, ln_g, ln_b):
    lb_soft = jax.nn.softmax(lb_param.astype(jnp.float32), axis=0)
    lbs = jnp.cumsum(lb_soft, axis=0) - lb_soft[0]
    pos_p = jnp.arange(x_prompt.shape[1], dtype=jnp.int32)
    pos_s = PAST_LEN + jnp.arange(x_sample.shape[1], dtype=jnp.int32)
    yp, ys = x_prompt, x_sample
    kp_l, vp_l, Sp_l, ks_l, vs_l, Ss_l, va_l = [], [], [], [], [], [], []
    for l in range(DEPTH):
        yp, _, Sp, kp, vp = trunk_layer(yp, pos_p, w_in[l], ln_v_g[l], ln_v_b[l], w_s[l], b_s[l], lbs[l],
                                        norm_b_g[l], sinks[l], w_out[l], ln_g[l], ln_b[l])
        ys, va, Ss, kk, vv = trunk_layer(ys, pos_s, w_in[l], ln_v_g[l], ln_v_b[l], w_s[l], b_s[l], lbs[l],
                                         norm_b_g[l], sinks[l], w_out[l], ln_g[l], ln_b[l],
                                         state=state_hgrn[l], cache=(cache_k[l], cache_v[l]))
        kp_l.append(kp); vp_l.append(vp); Sp_l.append(Sp)
        ks_l.append(kk); vs_l.append(vv); Ss_l.append(Ss); va_l.append(va)
    return (yp, ys, jnp.stack(kp_l), jnp.stack(vp_l), jnp.stack(Sp_l),
            jnp.stack(ks_l), jnp.stack(vs_l), jnp.stack(Ss_l), jnp.stack(va_l))
```

```cpp
#define MK_SPLIT 1
#include <hip/hip_runtime.h>
#include <hip/hip_cooperative_groups.h>
#include <cstdio>
#include <cmath>
namespace cg = cooperative_groups;

typedef unsigned short u16;
typedef short bf16x8 __attribute__((ext_vector_type(8)));
typedef short s16x4 __attribute__((ext_vector_type(4)));
typedef float f32x4 __attribute__((ext_vector_type(4)));
typedef unsigned u32x2 __attribute__((ext_vector_type(2)));
typedef unsigned u32x4 __attribute__((ext_vector_type(4)));
#define DI __device__ __forceinline__

constexpr int DM = 1024, NB = 16, SEQ = 4096, NTOKP = NB * SEQ, NTOKS = 256, MTOT = NTOKP + NTOKS;
constexpr int INW = 3072, MIXW = 1024;
constexpr int NCH = 1024, NUNIT = NCH + 16;
constexpr float ALPHA = 1.41421356237309515f;
constexpr int LDS_BYTES = 155648;

constexpr int C_UA = 0, C_VA = 256, C_ZA = 512, C_QB = 768, C_FB = 1024, C_IB = 1280, C_ZB = 1536, C_QC = 1792, C_KC = 2304, C_VC = 2432, C_ZC = 2560;

constexpr size_t WS_WTIN = 0;
constexpr size_t WS_WTOUT = WS_WTIN + 2ull * INW * DM * 2;
constexpr size_t WS_XB = WS_WTOUT + 2ull * DM * DM * 2;
constexpr size_t WS_H = WS_XB + (size_t)MTOT * DM * 2;
constexpr size_t WS_MIX = WS_H + (size_t)MTOT * INW * 2;
constexpr size_t WS_UT = WS_MIX + (size_t)MTOT * MIXW * 2;
constexpr size_t WS_SB = WS_UT + (size_t)NUNIT * 4 * 4096 * 4;
constexpr size_t WS_DEC = WS_SB + (size_t)NUNIT * 4 * 4096 * 2;
constexpr size_t WS_WSB = WS_DEC + (size_t)NUNIT * 4 * 64 * 4;
constexpr size_t WS_RT = WS_WSB + 2ull * 4 * 128 * 128 * 2;
constexpr size_t WS_KVS = WS_RT + 4112ull * 8 * 8;
constexpr size_t WS_LB = WS_KVS + 2ull * 16 * 144 * 256 * 2;
constexpr size_t WS_END = WS_LB + 2ull * 256 * 4;

constexpr size_t O_YP = 0;
constexpr size_t O_YS = O_YP + (size_t)NTOKP * DM;
constexpr size_t O_KP = O_YS + (size_t)NTOKS * DM;
constexpr size_t O_VP = O_KP + 2ull * 16 * 128 * 128;
constexpr size_t O_HP = O_VP + 2ull * 16 * 128 * 128;
constexpr size_t O_KS = O_HP + 2ull * 16 * 4 * 4096;
constexpr size_t O_VS = O_KS + 2ull * 16 * 16 * 128;
constexpr size_t O_HS = O_VS + 2ull * 16 * 16 * 128;
constexpr size_t O_SV = O_HS + 2ull * 16 * 4 * 4096;

struct Params {
    const float* x_prompt; const float* x_sample; const float* cache_k; const float* cache_v; const float* state_hgrn;
    const float* w_in; const float* ln_v_g; const float* ln_v_b; const float* w_s; const float* b_s; const float* lb_param;
    const float* norm_b_g; const float* sinks; const float* w_out; const float* ln_g; const float* ln_b;
    float* out; unsigned char* ws;
    float inv[8];
};

extern __shared__ __attribute__((aligned(16))) unsigned char shm[];

DI unsigned cvt_pk_bf16(float lo, float hi) { unsigned r; asm volatile("v_cvt_pk_bf16_f32 %0, %1, %2" : "=v"(r) : "v"(lo), "v"(hi)); return r; }
DI u16 f2bf(float x) { return (u16)(cvt_pk_bf16(x, 0.f) & 0xffffu); }
DI float bf2f(u16 v) { return __uint_as_float(((unsigned)v) << 16); }
DI float bflo(unsigned w) { return __uint_as_float(w << 16); }
DI float bfhi(unsigned w) { return __uint_as_float(w & 0xffff0000u); }
DI float silu_f(float x) { return x * __builtin_amdgcn_rcpf(1.f + __expf(-x)); }
DI float wave_sum(float v) {
#pragma unroll
    for (int o = 1; o < 64; o <<= 1) v += __shfl_xor(v, o);
    return v;
}
#define MFMA16(a, b, c) __builtin_amdgcn_mfma_f32_16x16x32_bf16((a), (b), (c), 0, 0, 0)

constexpr int BM = 256, BK = 64, HALF = 128, NXCD = 8, WGM = 8, HT = HALF * BK;
DI int lds_byte(int r, int c) { int st = (r >> 4) * 2 + (c >> 5), rr = r & 15, cc = c & 31, ob = rr * 64 + cc * 2; return st * 1024 + (ob ^ (((ob >> 9) & 1) << 5)); }
DI void stage_rc(int b, int& R, int& C) { int st = b / 1024, sb = b % 1024, swz = sb ^ (((sb >> 9) & 1) << 5); R = (st >> 1) * 16 + swz / 64; C = (st & 1) * 32 + (swz % 64) / 2; }

#define LAS __attribute__((address_space(3)))
template <class Epi>
DI void gemm_phase(const u16* __restrict__ A, const u16* __restrict__ Bt, int M, int N, int K, const Epi& epi) {
    LAS unsigned char* lds = (LAS unsigned char*)shm;
    const int tid = threadIdx.x, wid = __builtin_amdgcn_readfirstlane(tid >> 6), lane = tid & 63, wr = wid >> 2, wc = wid & 3, fr = lane & 15, fq = lane >> 4;
    constexpr int HTB = HT * 2;
    unsigned voff[2];
#pragma unroll
    for (int i = 0; i < 2; ++i) { int R, C; stage_rc(tid * 16 + i * 8192, R, C); voff[i] = (unsigned)(R * K + C) * 2u; }
    const size_t kstep = (size_t)(BK * 2), hstep = (size_t)HALF * K * 2, tstep = 2 * hstep;
    const unsigned ldsw = (unsigned)wid * 1024u;
    const int aoff = lds_byte(wr * 64 + fr, fq * 8), boff = lds_byte(wc * 32 + fr, fq * 8);
#define SA(b, h) (((b) * 2 + (h)) * HTB)
#define SB(b, h) ((4 + (b) * 2 + (h)) * HTB)
#define STAGE(bufoff, gbase) do { _Pragma("unroll") for (int _i = 0; _i < 2; ++_i) \
    __builtin_amdgcn_global_load_lds((const unsigned*)((const char*)(gbase) + voff[_i]), (LAS unsigned*)(lds + (bufoff) + ldsw + _i * 8192), 16, 0, 0); } while (0)
#define LDA(dst, b, h) do { _Pragma("unroll") for (int m = 0; m < 4; ++m) _Pragma("unroll") for (int k = 0; k < 2; ++k) dst[m][k] = *(const LAS bf16x8*)(lds + SA(b, h) + aoff + m * 2048 + k * 1024); } while (0)
#define LDB(dst, b, h) do { _Pragma("unroll") for (int n = 0; n < 2; ++n) _Pragma("unroll") for (int k = 0; k < 2; ++k) dst[n][k] = *(const LAS bf16x8*)(lds + SB(b, h) + boff + n * 2048 + k * 1024); } while (0)
#define MMA(ai, bj, At, Bt_) do { __builtin_amdgcn_s_setprio(1); _Pragma("unroll") for (int m = 0; m < 4; ++m) _Pragma("unroll") for (int n = 0; n < 2; ++n) _Pragma("unroll") for (int k = 0; k < 2; ++k) \
      acc[ai][bj][m][n] = MFMA16(Bt_[n][k], At[m][k], acc[ai][bj][m][n]); \
    __builtin_amdgcn_s_setprio(0); } while (0)
#define WAIT_V(n) asm volatile("s_waitcnt vmcnt(" #n ")" ::: "memory")
#define WAIT_L(n) asm volatile("s_waitcnt lgkmcnt(" #n ")" ::: "memory")
#define BAR __builtin_amdgcn_s_barrier()
#define SCHED __builtin_amdgcn_sched_barrier(0)
    const int nM = M / BM, nN = N / BM, nwg = nM * nN;
    const int nt = K / BK;
    for (int rnd = 0;; ++rnd) {
        const long L = (long)rnd * gridDim.x + blockIdx.x;
        if (L >= nwg) break;
        int wgid = (int)L;
        { int q = nwg / NXCD, r = nwg % NXCD, xcd = wgid % NXCD, off = wgid / NXCD; wgid = (xcd < r ? xcd * (q + 1) : r * (q + 1) + (xcd - r) * q) + off; }
        const int nig = WGM * nN, gid = wgid / nig, fm = gid * WGM, gsz = min(nM - fm, WGM);
        const int pm = fm + ((wgid % nig) % gsz), pn = (wgid % nig) / gsz, brow = pm * BM, bcol = pn * BM;
        const char* cA = (const char*)A + (size_t)pm * tstep; const char* cB = (const char*)Bt + (size_t)pn * tstep;
        f32x4 acc[2][2][4][2];
#pragma unroll
        for (int a = 0; a < 2; ++a)
#pragma unroll
            for (int b = 0; b < 2; ++b)
#pragma unroll
                for (int m = 0; m < 4; ++m)
#pragma unroll
                    for (int n = 0; n < 2; ++n) acc[a][b][m][n] = (f32x4){0.f, 0.f, 0.f, 0.f};
        bf16x8 At[4][2], B0[2][2], B1[2][2];
        STAGE(SB(0, 0), cB); STAGE(SA(0, 0), cA); STAGE(SB(0, 1), cB + hstep); STAGE(SA(0, 1), cA + hstep);
        if (wr == 1) BAR;
        WAIT_V(4); BAR;
        STAGE(SB(1, 0), cB + kstep); STAGE(SA(1, 0), cA + kstep); STAGE(SB(1, 1), cB + hstep + kstep);
        WAIT_V(6); BAR;
        for (int t = 0; t < nt - 2; t += 2) {
            const char* a1 = cA + (size_t)(t + 1) * kstep; const char* a2 = a1 + kstep; const char* a3 = a2 + kstep;
            const char* b2 = cB + (size_t)(t + 2) * kstep; const char* b3 = b2 + kstep;
            LDB(B0, 0, 0); SCHED; LDA(At, 0, 0); STAGE(SA(1, 1), a1 + hstep);
            WAIT_L(8); BAR; WAIT_L(0); MMA(0, 0, At, B0); BAR; SCHED;
            LDB(B1, 0, 1); STAGE(SB(0, 0), b2);
            BAR; WAIT_L(0); MMA(0, 1, At, B1); BAR;
            LDA(At, 0, 1); STAGE(SA(0, 0), a2);
            BAR; WAIT_L(0); MMA(1, 0, At, B0); BAR; SCHED;
            STAGE(SB(0, 1), b2 + hstep);
            WAIT_V(6); BAR; MMA(1, 1, At, B1); BAR;
            LDB(B0, 1, 0); SCHED; LDA(At, 1, 0); STAGE(SA(0, 1), a2 + hstep);
            WAIT_L(8); BAR; WAIT_L(0); MMA(0, 0, At, B0); BAR; SCHED;
            LDB(B1, 1, 1); STAGE(SB(1, 0), b3);
            BAR; WAIT_L(0); MMA(0, 1, At, B1); BAR;
            LDA(At, 1, 1); STAGE(SA(1, 0), a3);
            BAR; WAIT_L(0); MMA(1, 0, At, B0); BAR; SCHED;
            STAGE(SB(1, 1), b3 + hstep);
            WAIT_V(6); BAR; MMA(1, 1, At, B1); BAR;
        }
        { LDB(B0, 0, 0); LDA(At, 0, 0); STAGE(SA(1, 1), cA + hstep + (size_t)(nt - 1) * kstep);
          BAR; WAIT_L(0); MMA(0, 0, At, B0); BAR;
          LDB(B1, 0, 1); BAR; WAIT_L(0); MMA(0, 1, At, B1); BAR;
          LDA(At, 0, 1); WAIT_V(4); BAR; WAIT_L(0); MMA(1, 0, At, B0); MMA(1, 1, At, B1); BAR; }
        { LDB(B0, 1, 0); LDA(At, 1, 0); WAIT_V(2); BAR; WAIT_L(0); MMA(0, 0, At, B0); BAR;
          LDB(B1, 1, 1); WAIT_V(0); BAR; WAIT_L(0); MMA(0, 1, At, B1); BAR;
          LDA(At, 1, 1); BAR; WAIT_L(0); MMA(1, 0, At, B0); MMA(1, 1, At, B1); BAR; }
        if (wr == 0) BAR;
        epi(acc, brow, bcol, wr, wc, fr, fq);
        __syncthreads();
    }
#undef SA
#undef SB
#undef STAGE
#undef LDA
#undef LDB
#undef MMA
}

struct EpiIn {
    u16* H; const float2* RT; float* okp; float* ovp; float* oks; float* ovs; u16* KVS;
    DI void operator()(const f32x4 (&acc)[2][2][4][2], int brow, int bcol, int wr, int wc, int fr, int fq) const {
#pragma unroll
        for (int bj = 0; bj < 2; ++bj) {
            const int cb = bcol + bj * HALF;
            int type;
            if (cb < C_ZA) type = 0; else if (cb < C_FB) type = 1; else if (cb < C_ZB) type = 0; else if (cb < C_QC) type = 1;
            else if (cb < C_KC) type = 2; else if (cb == C_KC) type = 3; else if (cb == C_VC) type = 4; else type = 1;
#pragma unroll
            for (int ai = 0; ai < 2; ++ai)
#pragma unroll
                for (int m = 0; m < 4; ++m) {
                    const int row = brow + ai * HALF + wr * 64 + m * 16 + fr;
                    int posidx, kvo = -1; float* ko = nullptr; float* vo = nullptr; u16* kvs = nullptr;
                    if (row < NTOKP) { const int b = row >> 12, t = row & 4095; posidx = t;
                        if (t >= SEQ - 128) { kvo = (b * 128 + (t - (SEQ - 128))) * 128; ko = okp; vo = ovp; } }
                    else { const int s = row - NTOKP, sb = s >> 4, st = s & 15; posidx = 4096 + st; kvo = (sb * 16 + st) * 128; ko = oks; vo = ovs; kvs = KVS + (size_t)(sb * 144 + 128 + st) * 256; }
#pragma unroll
                    for (int n = 0; n < 2; ++n) {
                        const int cin = wc * 32 + n * 16 + fq * 4;
                        const int col0 = cb + cin;
                        f32x4 v = acc[ai][bj][m][n];
                        if (type == 1) { v[0] = silu_f(v[0]); v[1] = silu_f(v[1]); v[2] = silu_f(v[2]); v[3] = silu_f(v[3]); }
                        else if (type == 2 || type == 3) {
                            if ((wc & 1) == 0 && n == 0) {
#pragma unroll
                                for (int j = 0; j < 4; ++j) {
                                    const float pv = __shfl_xor(v[j], 32);
                                    const float2 cs = RT[posidx * 8 + (fq & 1) * 4 + j];
                                    v[j] = (fq < 2) ? (v[j] * cs.x - pv * cs.y) : (v[j] * cs.x + pv * cs.y);
                                }
                            }
                            if (type == 3) { if (kvo >= 0) *(f32x4*)(ko + kvo + cin) = v; }
                            else { v = v * 0.125f; }
                        } else if (type == 4) { if (kvo >= 0) *(f32x4*)(vo + kvo + cin) = v; }
                        u32x2 w; w.x = cvt_pk_bf16(v[0], v[1]); w.y = cvt_pk_bf16(v[2], v[3]);
                        *(u32x2*)(H + (size_t)row * INW + col0) = w;
                        if (type >= 3 && kvs) *(u32x2*)(kvs + (col0 - C_KC)) = w;
                    }
                }
        }
    }
};
struct EpiOut {
    float* Z; const u16* XB;
    DI void operator()(const f32x4 (&acc)[2][2][4][2], int brow, int bcol, int wr, int wc, int fr, int fq) const {
#pragma unroll
        for (int ai = 0; ai < 2; ++ai)
#pragma unroll
            for (int m = 0; m < 4; ++m) {
                const int row = brow + ai * HALF + wr * 64 + m * 16 + fr;
#pragma unroll
                for (int bj = 0; bj < 2; ++bj)
#pragma unroll
                    for (int n = 0; n < 2; ++n) {
                        const int col0 = bcol + bj * HALF + wc * 32 + n * 16 + fq * 4;
                        const u32x2 xw = *(const u32x2*)(XB + (size_t)row * DM + col0);
                        f32x4 v = acc[ai][bj][m][n];
                        v[0] += ALPHA * bflo(xw.x); v[1] += ALPHA * bfhi(xw.x); v[2] += ALPHA * bflo(xw.y); v[3] += ALPHA * bfhi(xw.y);
                        *(f32x4*)(Z + (size_t)row * DM + col0) = v;
                    }
            }
    }
};

DI void phase_prologue(const Params& p) {
    const int tid = threadIdx.x;
    const long gt = (long)blockIdx.x * 512 + tid, nth = (long)gridDim.x * 512;
    unsigned char* ws = p.ws;
    {
        u16* XB = (u16*)(ws + WS_XB);
        const long nv = (long)MTOT * DM / 8;
        for (long i = gt; i < nv; i += nth) {
            const long e = i * 8;
            const float* src = (e < (long)NTOKP * DM) ? (p.x_prompt + e) : (p.x_sample + (e - (long)NTOKP * DM));
            const f32x4 a = *(const f32x4*)src, b = *(const f32x4*)(src + 4);
            u32x4 o; o.x = cvt_pk_bf16(a[0], a[1]); o.y = cvt_pk_bf16(a[2], a[3]); o.z = cvt_pk_bf16(b[0], b[1]); o.w = cvt_pk_bf16(b[2], b[3]);
            *(u32x4*)(XB + e) = o;
        }
    }
    {
        float* tile = (float*)shm;
        const int T_IN = 16 * 48, T_OUT = 16 * 16, NT = 2 * T_IN + 2 * T_OUT;
        for (int it = blockIdx.x; it < NT; it += gridDim.x) {
            const float* W; u16* WT; int N, r = it;
            if (r < 2 * T_IN) { const int l = r / T_IN; r -= l * T_IN; W = p.w_in + (size_t)l * DM * INW; WT = (u16*)(ws + WS_WTIN) + (size_t)l * INW * DM; N = INW; }
            else { r -= 2 * T_IN; const int l = r / T_OUT; r -= l * T_OUT; W = p.w_out + (size_t)l * MIXW * DM; WT = (u16*)(ws + WS_WTOUT) + (size_t)l * DM * MIXW; N = DM; }
            const int nb = N / 64, k0 = (r / nb) * 64, n0 = (r % nb) * 64;
#pragma unroll
            for (int i = 0; i < 8; ++i) { const int idx = tid + i * 512, kk = idx >> 6, nn = idx & 63; tile[kk * 65 + nn] = W[(size_t)(k0 + kk) * N + n0 + nn]; }
            __syncthreads();
#pragma unroll
            for (int i = 0; i < 8; ++i) { const int idx = tid + i * 512, nn = idx >> 6, kk = idx & 63; WT[(size_t)(n0 + nn) * 1024 + k0 + kk] = f2bf(tile[kk * 65 + nn]); }
            __syncthreads();
        }
    }
    {
        u16* WSB = (u16*)(ws + WS_WSB);
        for (long i = gt; i < 2 * 4 * 128 * 128; i += nth) { const int jj = i & 127, ii = (i >> 7) & 127; WSB[i] = ((jj >> 6) <= (ii >> 6)) ? f2bf(p.w_s[i]) : (u16)0; }
    }
    {
        float2* RT = (float2*)(ws + WS_RT);
        for (long i = gt; i < 4112 * 8; i += nth) {
            const int pi = (int)(i >> 3), fi = (int)(i & 7);
            const int pos = pi < 4096 ? pi : 2048 + (pi - 4096);
            const float ang = (float)pos * p.inv[fi];
            double r = (double)ang * 0.15915494309189533577; r -= rint(r);
            const float rf = (float)r;
            RT[i] = make_float2(__builtin_amdgcn_cosf(rf), __builtin_amdgcn_sinf(rf));
        }
    }
    {
        u16* KVS = (u16*)(ws + WS_KVS);
        for (long i = gt; i < 2 * 16 * 128 * 256; i += nth) {
            const int c = i & 255, row = (i >> 8) & 127, lb = (int)(i >> 15);
            const float v = (c < 128) ? p.cache_k[((size_t)lb * 128 + row) * 128 + c] : p.cache_v[((size_t)lb * 128 + row) * 128 + (c - 128)];
            KVS[((size_t)lb * 144 + row) * 256 + c] = f2bf(v);
        }
    }
    {
        float* LB = (float*)(ws + WS_LB);
        for (long i = gt; i < 256; i += nth) {
            const float a = p.lb_param[i], b = p.lb_param[256 + i], m = fmaxf(a, b);
            const float ea = expf(a - m), eb = expf(b - m);
            LB[i] = 0.f; LB[256 + i] = eb / (ea + eb);
        }
    }
}

constexpr int VTS = 200;
DI void attn_unit(const u16* __restrict__ Q, int qstride, int nq, const u16* __restrict__ Kp, const u16* __restrict__ Vp, int kvstride, int nkeys,
                  const u16* __restrict__ Zg, int zstride, u16* __restrict__ Out, int ostride, const float* __restrict__ sinks4) {
    u16* VT = (u16*)shm;
    const int tid = threadIdx.x, wid = tid >> 6, lane = tid & 63, fr = lane & 15, fq = lane >> 4;
    const int nk32 = (nkeys + 31) & ~31;
    for (int idx = tid; idx < nk32 * 8; idx += 512) {
        const int key = idx >> 3, d0 = (idx & 7) * 8;
        u32x4 w = {0u, 0u, 0u, 0u};
        if (key < nkeys) w = *(const u32x4*)(Vp + (size_t)key * kvstride + d0);
        u16* dst = VT + d0 * VTS + key;
        dst[0 * VTS] = (u16)(w.x & 0xffff); dst[1 * VTS] = (u16)(w.x >> 16); dst[2 * VTS] = (u16)(w.y & 0xffff); dst[3 * VTS] = (u16)(w.y >> 16);
        dst[4 * VTS] = (u16)(w.z & 0xffff); dst[5 * VTS] = (u16)(w.z >> 16); dst[6 * VTS] = (u16)(w.w & 0xffff); dst[7 * VTS] = (u16)(w.w >> 16);
    }
    __syncthreads();
    const int r = wid >> 1, q0 = (wid & 1) * 32;
    if (q0 < nq) {
        bf16x8 bq[2][2];
#pragma unroll
        for (int qt = 0; qt < 2; ++qt)
#pragma unroll
            for (int ks = 0; ks < 2; ++ks) { const int qrow = min(q0 + qt * 16 + fr, nq - 1); bq[qt][ks] = *(const bf16x8*)(Q + (size_t)qrow * qstride + r * 64 + ks * 32 + fq * 8); }
        const int nkt = nk32 >> 4;
        f32x4 st[12][2];
#pragma unroll
        for (int kt = 0; kt < 12; ++kt) {
            st[kt][0] = (f32x4){0.f, 0.f, 0.f, 0.f}; st[kt][1] = (f32x4){0.f, 0.f, 0.f, 0.f};
            if (kt < nkt) {
                const int krow = min(kt * 16 + fr, nkeys - 1);
                const bf16x8 a0 = *(const bf16x8*)(Kp + (size_t)krow * kvstride + fq * 8), a1 = *(const bf16x8*)(Kp + (size_t)krow * kvstride + 32 + fq * 8);
#pragma unroll
                for (int qt = 0; qt < 2; ++qt) { st[kt][qt] = MFMA16(a0, bq[qt][0], st[kt][qt]); st[kt][qt] = MFMA16(a1, bq[qt][1], st[kt][qt]); }
            }
        }
        const float sink = sinks4[r];
        float inv_den[2];
        bf16x8 pb[2][6];
#pragma unroll
        for (int qt = 0; qt < 2; ++qt) {
            float mx = sink;
#pragma unroll
            for (int kt = 0; kt < 12; ++kt) if (kt < nkt) {
#pragma unroll
                for (int j = 0; j < 4; ++j) { const int key = kt * 16 + fq * 4 + j; float s = st[kt][qt][j]; if (key >= nkeys) s = -INFINITY; st[kt][qt][j] = s; mx = fmaxf(mx, s); }
            }
            mx = fmaxf(mx, __shfl_xor(mx, 16)); mx = fmaxf(mx, __shfl_xor(mx, 32));
            float sum = 0.f;
#pragma unroll
            for (int kt = 0; kt < 12; ++kt) if (kt < nkt) {
#pragma unroll
                for (int j = 0; j < 4; ++j) { const float e = __expf(st[kt][qt][j] - mx); st[kt][qt][j] = e; sum += e; }
            }
            sum += __shfl_xor(sum, 16); sum += __shfl_xor(sum, 32);
            inv_den[qt] = 1.f / (sum + __expf(sink - mx));
#pragma unroll
            for (int s2 = 0; s2 < 6; ++s2) {
                u32x4 w;
                w.x = cvt_pk_bf16(st[2 * s2][qt][0], st[2 * s2][qt][1]); w.y = cvt_pk_bf16(st[2 * s2][qt][2], st[2 * s2][qt][3]);
                w.z = cvt_pk_bf16(st[2 * s2 + 1][qt][0], st[2 * s2 + 1][qt][1]); w.w = cvt_pk_bf16(st[2 * s2 + 1][qt][2], st[2 * s2 + 1][qt][3]);
                pb[qt][s2] = __builtin_bit_cast(bf16x8, w);
            }
        }
        f32x4 o[4][2];
#pragma unroll
        for (int dt = 0; dt < 4; ++dt) { o[dt][0] = (f32x4){0.f, 0.f, 0.f, 0.f}; o[dt][1] = (f32x4){0.f, 0.f, 0.f, 0.f}; }
        const int nks = nk32 >> 5;
#pragma unroll
        for (int s2 = 0; s2 < 6; ++s2) if (s2 < nks) {
#pragma unroll
            for (int dt = 0; dt < 4; ++dt) {
                const u16* vr = VT + (dt * 16 + fr) * VTS + 32 * s2 + 4 * fq;
                const s16x4 lo = *(const s16x4*)vr, hi = *(const s16x4*)(vr + 16);
                const bf16x8 a = __builtin_shufflevector(lo, hi, 0, 1, 2, 3, 4, 5, 6, 7);
                o[dt][0] = MFMA16(a, pb[0][s2], o[dt][0]); o[dt][1] = MFMA16(a, pb[1][s2], o[dt][1]);
            }
        }
#pragma unroll
        for (int qt = 0; qt < 2; ++qt) {
            const int q = q0 + qt * 16 + fr;
            if (q < nq) {
#pragma unroll
                for (int dt = 0; dt < 4; ++dt) {
                    const int d = dt * 16 + fq * 4;
                    const u32x2 zw = *(const u32x2*)(Zg + (size_t)q * zstride + r * 64 + d);
                    const f32x4 ov = o[dt][qt] * inv_den[qt];
                    u32x2 w; w.x = cvt_pk_bf16(ov[0] * bflo(zw.x), ov[1] * bfhi(zw.x)); w.y = cvt_pk_bf16(ov[2] * bflo(zw.y), ov[3] * bfhi(zw.y));
                    *(u32x2*)(Out + (size_t)q * ostride + r * 64 + d) = w;
                }
            }
        }
    }
    __syncthreads();
}

constexpr int VS = 136;
DI void sgu_prompt_unit(const Params& p, int l, int unit) {
    unsigned char* ws = p.ws;
    const u16* H = (const u16*)(ws + WS_H); u16* MIX = (u16*)(ws + WS_MIX);
    const u16* WSB = (const u16*)(ws + WS_WSB) + (size_t)l * 4 * 128 * 128;
    u16* vnT = (u16*)shm;
    const int tid = threadIdx.x, wid = tid >> 6, lane = tid & 63, fr = lane & 15, fq = lane >> 4;
    const int T0 = unit * 128;
    {
        const f32x4 g = *(const f32x4*)(p.ln_v_g + l * 256 + lane * 4), bb = *(const f32x4*)(p.ln_v_b + l * 256 + lane * 4);
#pragma unroll 4
        for (int tt = 0; tt < 16; ++tt) {
            const int tok = wid * 16 + tt;
            const u32x2 w = *(const u32x2*)(H + (size_t)(T0 + tok) * INW + C_VA + lane * 4);
            float x0 = bflo(w.x), x1 = bfhi(w.x), x2 = bflo(w.y), x3 = bfhi(w.y);
            const float mu = wave_sum((x0 + x1) + (x2 + x3)) * (1.f / 256.f);
            x0 -= mu; x1 -= mu; x2 -= mu; x3 -= mu;
            const float var = wave_sum((x0 * x0 + x1 * x1) + (x2 * x2 + x3 * x3)) * (1.f / 256.f);
            const float rs = rsqrtf(var + 1e-5f);
            u16* dst = vnT + (lane * 4) * VS + tok;
            dst[0] = f2bf(x0 * rs * g[0] + bb[0]); dst[VS] = f2bf(x1 * rs * g[1] + bb[1]); dst[2 * VS] = f2bf(x2 * rs * g[2] + bb[2]); dst[3 * VS] = f2bf(x3 * rs * g[3] + bb[3]);
        }
    }
    __syncthreads();
    {
        const int g = wid >> 1, ih = wid & 1;
        f32x4 acc[4][4];
#pragma unroll
        for (int mm = 0; mm < 4; ++mm)
#pragma unroll
            for (int n = 0; n < 4; ++n) acc[mm][n] = (f32x4){0.f, 0.f, 0.f, 0.f};
        const int nks = ih ? 4 : 2;
#pragma unroll
        for (int ks = 0; ks < 4; ++ks) if (ks < nks) {
            bf16x8 af[4], bf_[4];
#pragma unroll
            for (int n = 0; n < 4; ++n) af[n] = *(const bf16x8*)(vnT + (g * 64 + n * 16 + fr) * VS + ks * 32 + fq * 8);
#pragma unroll
            for (int mm = 0; mm < 4; ++mm) bf_[mm] = *(const bf16x8*)(WSB + ((size_t)g * 128 + (ih * 4 + mm) * 16 + fr) * 128 + ks * 32 + fq * 8);
#pragma unroll
            for (int mm = 0; mm < 4; ++mm)
#pragma unroll
                for (int n = 0; n < 4; ++n) acc[mm][n] = MFMA16(af[n], bf_[mm], acc[mm][n]);
        }
#pragma unroll
        for (int mm = 0; mm < 4; ++mm) {
            const int i = (ih * 4 + mm) * 16 + fr;
            const float bias = p.b_s[(l * 4 + g) * 128 + i];
            const size_t rowH = (size_t)(T0 + i) * INW, rowM = (size_t)(T0 + i) * MIXW;
#pragma unroll
            for (int n = 0; n < 4; ++n) {
                const int ch = g * 64 + n * 16 + fq * 4;
                const u32x2 uw = *(const u32x2*)(H + rowH + C_UA + ch), zw = *(const u32x2*)(H + rowH + C_ZA + ch);
                const f32x4 a = acc[mm][n];
                u32x2 w;
                w.x = cvt_pk_bf16((a[0] + bias) * bflo(uw.x) * bflo(zw.x), (a[1] + bias) * bfhi(uw.x) * bfhi(zw.x));
                w.y = cvt_pk_bf16((a[2] + bias) * bflo(uw.y) * bflo(zw.y), (a[3] + bias) * bfhi(uw.y) * bfhi(zw.y));
                *(u32x2*)(MIX + rowM + ch) = w;
            }
        }
    }
    __syncthreads();
}

DI void sgu_sample_unit(const Params& p, int l, int b) {
    unsigned char* ws = p.ws;
    const u16* H = (const u16*)(ws + WS_H); u16* MIX = (u16*)(ws + WS_MIX);
    float* vn = (float*)shm;
    const int tid = threadIdx.x, wid = tid >> 6, lane = tid & 63;
    const int T0 = NTOKP + b * 16;
    const f32x4 g = *(const f32x4*)(p.ln_v_g + l * 256 + lane * 4), bb = *(const f32x4*)(p.ln_v_b + l * 256 + lane * 4);
    for (int tt = 0; tt < 2; ++tt) {
        const int tok = wid * 2 + tt;
        const u32x2 w = *(const u32x2*)(H + (size_t)(T0 + tok) * INW + C_VA + lane * 4);
        float x0 = bflo(w.x), x1 = bfhi(w.x), x2 = bflo(w.y), x3 = bfhi(w.y);
        const float mu = wave_sum((x0 + x1) + (x2 + x3)) * (1.f / 256.f);
        x0 -= mu; x1 -= mu; x2 -= mu; x3 -= mu;
        const float var = wave_sum((x0 * x0 + x1 * x1) + (x2 * x2 + x3 * x3)) * (1.f / 256.f);
        const float rs = rsqrtf(var + 1e-5f);
        f32x4 o; o[0] = x0 * rs * g[0] + bb[0]; o[1] = x1 * rs * g[1] + bb[1]; o[2] = x2 * rs * g[2] + bb[2]; o[3] = x3 * rs * g[3] + bb[3];
        *(f32x4*)(vn + tok * 256 + lane * 4) = o;
        *(f32x4*)(p.out + O_SV + ((size_t)(l * 16 + b) * 16 + tok) * 256 + lane * 4) = o;
    }
    __syncthreads();
    for (int e = 0; e < 8; ++e) {
        const int o = tid + 512 * e, i = o >> 8, ch = o & 255, g4 = ch >> 6;
        const float* wrow = p.w_s + ((size_t)(l * 4 + g4) * 128 + i) * 128;
        float s = p.b_s[(l * 4 + g4) * 128 + i];
        for (int j = 0; j < 16; ++j) s += wrow[j] * vn[j * 256 + ch];
        const size_t rowH = (size_t)(T0 + i) * INW;
        MIX[(size_t)(T0 + i) * MIXW + ch] = f2bf(s * bf2f(H[rowH + C_UA + ch]) * bf2f(H[rowH + C_ZA + ch]));
    }
    __syncthreads();
}

constexpr int HS = 72;
DI void hgrn_local_unit(const Params& p, int l, int u) {
    unsigned char* ws = p.ws;
    const u16* H = (const u16*)(ws + WS_H);
    float* UT = (float*)(ws + WS_UT); float* DEC = (float*)(ws + WS_DEC);
    const float* LB = (const float*)(ws + WS_LB) + l * 256;
    const int tid = threadIdx.x, wid = tid >> 6, lane = tid & 63, fr = lane & 15, fq = lane >> 4;
    const int hh = wid >> 1, half = wid & 1;
    const int T0 = (u < NCH) ? u * 64 : NTOKP + (u - NCH) * 16, len = (u < NCH) ? 64 : 16;
    u16* vT = (u16*)shm + hh * (2 * 64 * HS);
    u16* kT = vT + 64 * HS;
    float* tot = (float*)(shm + 4 * 2 * 64 * HS * 2);
    const float lb = LB[hh * 64 + lane];
    float lg[32], kk[32];
    float own = 0.f;
#pragma unroll
    for (int jj = 0; jj < 32; ++jj) {
        const int j = half * 32 + jj;
        float lgv = 0.f, kv = 0.f;
        if (j < len) {
            const float fb = bf2f(H[(size_t)(T0 + j) * INW + C_FB + hh * 64 + lane]);
            const float sg = __builtin_amdgcn_rcpf(1.f + __expf(-fb));
            const float f = lb + (1.f - lb) * sg;
            lgv = __logf(f); kv = (1.f - lb) * __builtin_amdgcn_rcpf(1.f + __expf(fb));
        }
        lg[jj] = lgv; kk[jj] = kv; own += lgv;
    }
    tot[(hh * 2 + half) * 64 + lane] = own;
    {
        unsigned pk[16];
#pragma unroll
        for (int jj = 0; jj < 32; jj += 2) {
            const int j = half * 32 + jj;
            const u16 a = (j < len) ? H[(size_t)(T0 + j) * INW + C_IB + hh * 64 + lane] : (u16)0;
            const u16 b = (j + 1 < len) ? H[(size_t)(T0 + j + 1) * INW + C_IB + hh * 64 + lane] : (u16)0;
            pk[jj >> 1] = (unsigned)a | ((unsigned)b << 16);
        }
#pragma unroll
        for (int q = 0; q < 4; ++q) { u32x4 w = {pk[4 * q], pk[4 * q + 1], pk[4 * q + 2], pk[4 * q + 3]}; *(u32x4*)(vT + lane * HS + half * 32 + q * 8) = w; }
    }
    __syncthreads();
    {
        const float other = tot[(hh * 2 + (1 - half)) * 64 + lane];
        float s = half ? 0.f : other;
        unsigned pk[16];
#pragma unroll
        for (int jj = 31; jj >= 0; jj -= 2) {
            const float k1 = kk[jj] * __expf(s); s += lg[jj];
            const float k0 = kk[jj - 1] * __expf(s); s += lg[jj - 1];
            pk[jj >> 1] = cvt_pk_bf16(k0, k1);
        }
        if (half == 0) DEC[((size_t)u * 4 + hh) * 64 + lane] = __expf(s);
#pragma unroll
        for (int q = 0; q < 4; ++q) { u32x4 w = {pk[4 * q], pk[4 * q + 1], pk[4 * q + 2], pk[4 * q + 3]}; *(u32x4*)(kT + lane * HS + half * 32 + q * 8) = w; }
    }
    __syncthreads();
    {
        f32x4 acc[2][4];
#pragma unroll
        for (int a = 0; a < 2; ++a)
#pragma unroll
            for (int kt = 0; kt < 4; ++kt) acc[a][kt] = (f32x4){0.f, 0.f, 0.f, 0.f};
#pragma unroll
        for (int ks = 0; ks < 2; ++ks) {
            bf16x8 av[2], bk[4];
#pragma unroll
            for (int a = 0; a < 2; ++a) av[a] = *(const bf16x8*)(vT + ((half * 2 + a) * 16 + fr) * HS + ks * 32 + fq * 8);
#pragma unroll
            for (int kt = 0; kt < 4; ++kt) bk[kt] = *(const bf16x8*)(kT + (kt * 16 + fr) * HS + ks * 32 + fq * 8);
#pragma unroll
            for (int a = 0; a < 2; ++a)
#pragma unroll
                for (int kt = 0; kt < 4; ++kt) acc[a][kt] = MFMA16(av[a], bk[kt], acc[a][kt]);
        }
        float* dst = UT + ((size_t)u * 4 + hh) * 4096;
#pragma unroll
        for (int a = 0; a < 2; ++a)
#pragma unroll
            for (int kt = 0; kt < 4; ++kt)
#pragma unroll
                for (int r = 0; r < 4; ++r) dst[((half * 2 + a) * 16 + fq * 4 + r) * 64 + kt * 16 + fr] = acc[a][kt][r];
    }
    __syncthreads();
}

DI void hgrn_scan_phase(const Params& p, int l) {
    unsigned char* ws = p.ws;
    const float* __restrict__ UT = (const float*)(ws + WS_UT); const float* __restrict__ DEC = (const float*)(ws + WS_DEC);
    u16* __restrict__ SBUF = (u16*)(ws + WS_SB);
    const long gt = (long)blockIdx.x * 512 + threadIdx.x, nth = (long)gridDim.x * 512;
    for (long item = gt; item < 128 * 4096; item += nth) {
        const int seq = (int)(item >> 12), e = (int)(item & 4095), k = e & 63, v = e >> 6;
        if (seq < 64) {
            const int b = seq >> 2, hh = seq & 3;
            float s = 0.f;
            for (int c0 = 0; c0 < 64; c0 += 16) {
                float uu[16], dd[16];
#pragma unroll
                for (int c = 0; c < 16; ++c) { const size_t ub = (size_t)(b * 64 + c0 + c) * 4 + hh; uu[c] = UT[ub * 4096 + e]; dd[c] = DEC[ub * 64 + k]; }
#pragma unroll
                for (int c = 0; c < 16; ++c) { const size_t ub = (size_t)(b * 64 + c0 + c) * 4 + hh; SBUF[ub * 4096 + e] = f2bf(s); s = dd[c] * s + uu[c]; }
            }
            p.out[O_HP + ((size_t)(l * 16 + b) * 4 + hh) * 4096 + k * 64 + v] = s;
        } else {
            const int b = (seq - 64) >> 2, hh = seq & 3;
            const size_t ub = (size_t)(NCH + b) * 4 + hh;
            const size_t so = ((size_t)(l * 16 + b) * 4 + hh) * 4096 + k * 64 + v;
            const float s = p.state_hgrn[so];
            SBUF[ub * 4096 + e] = f2bf(s);
            p.out[O_HS + so] = DEC[ub * 64 + k] * s + UT[ub * 4096 + e];
        }
    }
}

DI void hgrn_out_unit(const Params& p, int l, int u) {
    unsigned char* ws = p.ws;
    const u16* H = (const u16*)(ws + WS_H); u16* MIX = (u16*)(ws + WS_MIX);
    const u16* SBUF = (const u16*)(ws + WS_SB);
    const float* LB = (const float*)(ws + WS_LB) + l * 256;
    const int tid = threadIdx.x, wid = tid >> 6, lane = tid & 63, fr = lane & 15, fq = lane >> 4;
    const int hh = wid >> 1, half = wid & 1;
    const int T0 = (u < NCH) ? u * 64 : NTOKP + (u - NCH) * 16, len = (u < NCH) ? 64 : 16;
    u16* vT = (u16*)shm + hh * (4 * 64 * HS);
    u16* kh = vT + 64 * HS;
    u16* qh = kh + 64 * HS;
    u16* qt = qh + 64 * HS;
    float* tot = (float*)(shm + 4 * 4 * 64 * HS * 2);
    const float lb = LB[hh * 64 + lane];
    float pre[32], kk[32];
    float own = 0.f;
#pragma unroll
    for (int jj = 0; jj < 32; ++jj) {
        const int j = half * 32 + jj;
        float lgv = 0.f, kv = 0.f;
        if (j < len) {
            const float fb = bf2f(H[(size_t)(T0 + j) * INW + C_FB + hh * 64 + lane]);
            const float sg = __builtin_amdgcn_rcpf(1.f + __expf(-fb));
            const float f = lb + (1.f - lb) * sg;
            lgv = __logf(f); kv = (1.f - lb) * __builtin_amdgcn_rcpf(1.f + __expf(fb));
        }
        own += lgv; pre[jj] = own; kk[jj] = kv;
    }
    tot[(hh * 2 + half) * 64 + lane] = own;
    {
        unsigned pk[16];
#pragma unroll
        for (int jj = 0; jj < 32; jj += 2) {
            const int j = half * 32 + jj;
            const u16 a = (j < len) ? H[(size_t)(T0 + j) * INW + C_IB + hh * 64 + lane] : (u16)0;
            const u16 b = (j + 1 < len) ? H[(size_t)(T0 + j + 1) * INW + C_IB + hh * 64 + lane] : (u16)0;
            pk[jj >> 1] = (unsigned)a | ((unsigned)b << 16);
        }
#pragma unroll
        for (int q = 0; q < 4; ++q) { u32x4 w = {pk[4 * q], pk[4 * q + 1], pk[4 * q + 2], pk[4 * q + 3]}; *(u32x4*)(vT + lane * HS + half * 32 + q * 8) = w; }
    }
    __syncthreads();
    {
        const float other = tot[(hh * 2 + (1 - half)) * 64 + lane];
        const float gbase = half ? other : 0.f;
        const float eoff = half ? 0.f : own;
#pragma unroll
        for (int jj = 0; jj < 32; ++jj) {
            const int j = half * 32 + jj;
            const float q = (j < len) ? bf2f(H[(size_t)(T0 + j) * INW + C_QB + hh * 64 + lane]) : 0.f;
            const float e = pre[jj] - eoff;
            kh[j * HS + lane] = f2bf(kk[jj] * __expf(-e));
            qh[j * HS + lane] = f2bf(q * __expf(e));
            qt[j * HS + lane] = f2bf(q * __expf(pre[jj] + gbase));
        }
    }
    __syncthreads();
    {
        f32x4 at[2][4];
#pragma unroll
        for (int ii = 0; ii < 2; ++ii)
#pragma unroll
            for (int jt = 0; jt < 4; ++jt) at[ii][jt] = (f32x4){0.f, 0.f, 0.f, 0.f};
#pragma unroll
        for (int ks = 0; ks < 2; ++ks) {
            bf16x8 bqf[2];
#pragma unroll
            for (int ii = 0; ii < 2; ++ii) bqf[ii] = *(const bf16x8*)(qh + ((half * 2 + ii) * 16 + fr) * HS + ks * 32 + fq * 8);
#pragma unroll
            for (int jt = 0; jt < 4; ++jt) if (jt <= half * 2 + 1) {
                const bf16x8 ak = *(const bf16x8*)(kh + (jt * 16 + fr) * HS + ks * 32 + fq * 8);
#pragma unroll
                for (int ii = 0; ii < 2; ++ii) at[ii][jt] = MFMA16(ak, bqf[ii], at[ii][jt]);
            }
        }
        bf16x8 pb[2][2];
#pragma unroll
        for (int ii = 0; ii < 2; ++ii) {
            const int i = (half * 2 + ii) * 16 + fr;
#pragma unroll
            for (int jt = 0; jt < 4; ++jt)
#pragma unroll
                for (int r = 0; r < 4; ++r) { const int j = jt * 16 + fq * 4 + r; if (j > i) at[ii][jt][r] = 0.f; }
#pragma unroll
            for (int s2 = 0; s2 < 2; ++s2) {
                u32x4 w;
                w.x = cvt_pk_bf16(at[ii][2 * s2][0], at[ii][2 * s2][1]); w.y = cvt_pk_bf16(at[ii][2 * s2][2], at[ii][2 * s2][3]);
                w.z = cvt_pk_bf16(at[ii][2 * s2 + 1][0], at[ii][2 * s2 + 1][1]); w.w = cvt_pk_bf16(at[ii][2 * s2 + 1][2], at[ii][2 * s2 + 1][3]);
                pb[ii][s2] = __builtin_bit_cast(bf16x8, w);
            }
        }
        f32x4 o[4][2];
#pragma unroll
        for (int vt = 0; vt < 4; ++vt) { o[vt][0] = (f32x4){0.f, 0.f, 0.f, 0.f}; o[vt][1] = (f32x4){0.f, 0.f, 0.f, 0.f}; }
#pragma unroll
        for (int s2 = 0; s2 < 2; ++s2) if (s2 <= half) {
#pragma unroll
            for (int vt = 0; vt < 4; ++vt) {
                const u16* vr = vT + (vt * 16 + fr) * HS + 32 * s2 + 4 * fq;
                const s16x4 lo = *(const s16x4*)vr, hi = *(const s16x4*)(vr + 16);
                const bf16x8 a = __builtin_shufflevector(lo, hi, 0, 1, 2, 3, 4, 5, 6, 7);
                o[vt][0] = MFMA16(a, pb[0][s2], o[vt][0]); o[vt][1] = MFMA16(a, pb[1][s2], o[vt][1]);
            }
        }
        const u16* Sg = SBUF + ((size_t)u * 4 + hh) * 4096;
#pragma unroll
        for (int ks = 0; ks < 2; ++ks) {
            bf16x8 bqf[2];
#pragma unroll
            for (int ii = 0; ii < 2; ++ii) bqf[ii] = *(const bf16x8*)(qt + ((half * 2 + ii) * 16 + fr) * HS + ks * 32 + fq * 8);
#pragma unroll
            for (int vt = 0; vt < 4; ++vt) {
                const bf16x8 a = *(const bf16x8*)(Sg + (vt * 16 + fr) * 64 + ks * 32 + fq * 8);
                o[vt][0] = MFMA16(a, bqf[0], o[vt][0]); o[vt][1] = MFMA16(a, bqf[1], o[vt][1]);
            }
        }
#pragma unroll
        for (int ii = 0; ii < 2; ++ii) {
            float ss = 0.f;
#pragma unroll
            for (int vt = 0; vt < 4; ++vt) { const f32x4 x = o[vt][ii]; ss += (x[0] * x[0] + x[1] * x[1]) + (x[2] * x[2] + x[3] * x[3]); }
            ss += __shfl_xor(ss, 16); ss += __shfl_xor(ss, 32);
            const float rs = rsqrtf(ss * (1.f / 64.f) + 1e-6f);
            const int i = (half * 2 + ii) * 16 + fr;
            if (i < len) {
#pragma unroll
                for (int vt = 0; vt < 4; ++vt) {
                    const int v = vt * 16 + fq * 4;
                    const f32x4 gn = *(const f32x4*)(p.norm_b_g + l * 64 + v);
                    const u32x2 zw = *(const u32x2*)(H + (size_t)(T0 + i) * INW + C_ZB + hh * 64 + v);
                    const f32x4 x = o[vt][ii];
                    u32x2 w; w.x = cvt_pk_bf16(x[0] * rs * gn[0] * bflo(zw.x), x[1] * rs * gn[1] * bfhi(zw.x)); w.y = cvt_pk_bf16(x[2] * rs * gn[2] * bflo(zw.y), x[3] * rs * gn[3] * bfhi(zw.y));
                    *(u32x2*)(MIX + (size_t)(T0 + i) * MIXW + 256 + hh * 64 + v) = w;
                }
            }
        }
    }
    __syncthreads();
}

DI void ln_phase(const Params& p, int l) {
    unsigned char* ws = p.ws;
    const float* Z = (const float*)(ws + WS_H);
    u16* XB = (u16*)(ws + WS_XB);
    const int wid = threadIdx.x >> 6, lane = threadIdx.x & 63;
    f32x4 g[4], bb[4];
#pragma unroll
    for (int j = 0; j < 4; ++j) { g[j] = *(const f32x4*)(p.ln_g + l * DM + lane * 4 + 256 * j); bb[j] = *(const f32x4*)(p.ln_b + l * DM + lane * 4 + 256 * j); }
    for (int row = blockIdx.x * 8 + wid; row < MTOT; row += gridDim.x * 8) {
        const float* zr = Z + (size_t)row * DM + lane * 4;
        f32x4 v[4]; float s = 0.f;
#pragma unroll
        for (int j = 0; j < 4; ++j) { v[j] = *(const f32x4*)(zr + 256 * j); s += (v[j][0] + v[j][1]) + (v[j][2] + v[j][3]); }
        const float mu = wave_sum(s) * (1.f / DM);
        float s2 = 0.f;
#pragma unroll
        for (int j = 0; j < 4; ++j) { v[j] = v[j] - mu; s2 += (v[j][0] * v[j][0] + v[j][1] * v[j][1]) + (v[j][2] * v[j][2] + v[j][3] * v[j][3]); }
        const float rs = rsqrtf(wave_sum(s2) * (1.f / DM) + 1e-5f);
#pragma unroll
        for (int j = 0; j < 4; ++j) v[j] = v[j] * rs * g[j] + bb[j];
        if (l == 0) {
            u16* xr = XB + (size_t)row * DM + lane * 4;
#pragma unroll
            for (int j = 0; j < 4; ++j) { u32x2 w; w.x = cvt_pk_bf16(v[j][0], v[j][1]); w.y = cvt_pk_bf16(v[j][2], v[j][3]); *(u32x2*)(xr + 256 * j) = w; }
        } else {
            float* yr = p.out + (size_t)row * DM + lane * 4;
#pragma unroll
            for (int j = 0; j < 4; ++j) *(f32x4*)(yr + 256 * j) = v[j];
        }
    }
}

DI void phase_mix_a(const Params& p, int l) {
    unsigned char* ws = p.ws;
    const u16* H = (const u16*)(ws + WS_H); u16* MIX = (u16*)(ws + WS_MIX);
    const u16* KVS = (const u16*)(ws + WS_KVS) + (size_t)l * 16 * 144 * 256;
    constexpr int N_AT = 2048, N_HL = NUNIT, N_SG = 512, N_AS = 32, N_SS = 16;
    const int G = gridDim.x;
    int w = blockIdx.x;
    for (; w < N_AT; w += G) {
        const int r = w;
        const int g = r & 1, c = (r >> 1) & 63, b = r >> 7;
        const int c0 = max(c - 2, 0), nkeys = (c - c0 + 1) * 64;
        const size_t Tq = (size_t)b * SEQ + c * 64, Tk = (size_t)b * SEQ + c0 * 64;
        attn_unit(H + Tq * INW + C_QC + g * 256, INW, 64, H + Tk * INW + C_KC + g * 64, H + Tk * INW + C_VC + g * 64, INW, nkeys,
                  H + Tq * INW + C_ZC + g * 256, INW, MIX + Tq * MIXW + 512 + g * 256, MIXW, p.sinks + l * 8 + g * 4);
    }
    asm volatile("" ::: "memory");
    for (; w < N_AT + N_HL; w += G) hgrn_local_unit(p, l, w - N_AT);
    asm volatile("" ::: "memory");
    for (; w < N_AT + N_HL + N_SG; w += G) sgu_prompt_unit(p, l, w - N_AT - N_HL);
    asm volatile("" ::: "memory");
    for (; w < N_AT + N_HL + N_SG + N_AS; w += G) {
        const int r = w - (N_AT + N_HL + N_SG);
        const int g = r & 1, b = r >> 1;
        const size_t Tq = (size_t)NTOKP + b * 16;
        const u16* kv = KVS + (size_t)b * 144 * 256;
        attn_unit(H + Tq * INW + C_QC + g * 256, INW, 16, kv + g * 64, kv + 128 + g * 64, 256, 144,
                  H + Tq * INW + C_ZC + g * 256, INW, MIX + Tq * MIXW + 512 + g * 256, MIXW, p.sinks + l * 8 + g * 4);
    }
    asm volatile("" ::: "memory");
    for (; w < N_AT + N_HL + N_SG + N_AS + N_SS; w += G) sgu_sample_unit(p, l, w - (N_AT + N_HL + N_SG + N_AS));
}

#ifndef MK_SPLIT
__global__ void __launch_bounds__(512, 2) fwd_megakernel(Params p) {
    cg::grid_group grid = cg::this_grid();
    unsigned char* ws = p.ws;
    phase_prologue(p);
    grid.sync();
    for (int l = 0; l < 2; ++l) {
        {
            EpiIn e;
            e.H = (u16*)(ws + WS_H); e.RT = (const float2*)(ws + WS_RT);
            e.okp = p.out + O_KP + (size_t)l * 16 * 128 * 128; e.ovp = p.out + O_VP + (size_t)l * 16 * 128 * 128;
            e.oks = p.out + O_KS + (size_t)l * 16 * 16 * 128; e.ovs = p.out + O_VS + (size_t)l * 16 * 16 * 128;
            e.KVS = (u16*)(ws + WS_KVS) + (size_t)l * 16 * 144 * 256;
            gemm_phase((const u16*)(ws + WS_XB), (const u16*)(ws + WS_WTIN) + (size_t)l * INW * DM, MTOT, INW, DM, e);
        }
        grid.sync();
        phase_mix_a(p, l);
        grid.sync();
        hgrn_scan_phase(p, l);
        grid.sync();
        for (int u = blockIdx.x; u < NUNIT; u += gridDim.x) hgrn_out_unit(p, l, u);
        grid.sync();
        {
            EpiOut e; e.Z = (float*)(ws + WS_H); e.XB = (const u16*)(ws + WS_XB);
            gemm_phase((const u16*)(ws + WS_MIX), (const u16*)(ws + WS_WTOUT) + (size_t)l * DM * MIXW, MTOT, DM, MIXW, e);
        }
        grid.sync();
        ln_phase(p, l);
        if (l == 0) grid.sync();
    }
}

#endif

#ifdef MK_SPLIT
__global__ void __launch_bounds__(512, 2) k_prologue(Params p) { phase_prologue(p); }
__global__ void __launch_bounds__(512, 2) k_gemm_in(Params p, int l) {
    unsigned char* ws = p.ws;
    EpiIn e;
    e.H = (u16*)(ws + WS_H); e.RT = (const float2*)(ws + WS_RT);
    e.okp = p.out + O_KP + (size_t)l * 16 * 128 * 128; e.ovp = p.out + O_VP + (size_t)l * 16 * 128 * 128;
    e.oks = p.out + O_KS + (size_t)l * 16 * 16 * 128; e.ovs = p.out + O_VS + (size_t)l * 16 * 16 * 128;
    e.KVS = (u16*)(ws + WS_KVS) + (size_t)l * 16 * 144 * 256;
    gemm_phase((const u16*)(ws + WS_XB), (const u16*)(ws + WS_WTIN) + (size_t)l * INW * DM, MTOT, INW, DM, e);
}
__global__ void __launch_bounds__(512, 2) k_mix_a(Params p, int l) { phase_mix_a(p, l); }
__global__ void __launch_bounds__(512, 2) k_scan(Params p, int l) { hgrn_scan_phase(p, l); }
__global__ void __launch_bounds__(512, 2) k_hout(Params p, int l) { for (int u = blockIdx.x; u < NUNIT; u += gridDim.x) hgrn_out_unit(p, l, u); }
__global__ void __launch_bounds__(512, 2) k_gemm_out(Params p, int l) {
    unsigned char* ws = p.ws;
    EpiOut e; e.Z = (float*)(ws + WS_H); e.XB = (const u16*)(ws + WS_XB);
    gemm_phase((const u16*)(ws + WS_MIX), (const u16*)(ws + WS_WTOUT) + (size_t)l * DM * MIXW, MTOT, DM, MIXW, e);
}
__global__ void __launch_bounds__(512, 2) k_ln(Params p, int l) { ln_phase(p, l); }
#endif

extern "C" void kernel_launch(void* const* d_in, const int* in_sizes, int n_in, void* d_out, int out_size, void* d_ws, size_t ws_size, hipStream_t stream) {
    static int grid_blocks = 0;
    if (!grid_blocks) {
        int dev = 0, cus = 0, per_cu = 0;
        (void)hipGetDevice(&dev);
        (void)hipDeviceGetAttribute(&cus, hipDeviceAttributeMultiprocessorCount, dev);
#ifndef MK_SPLIT
        (void)hipFuncSetAttribute((const void*)fwd_megakernel, hipFuncAttributeMaxDynamicSharedMemorySize, LDS_BYTES);
        (void)hipOccupancyMaxActiveBlocksPerMultiprocessor(&per_cu, (const void*)fwd_megakernel, 512, LDS_BYTES);
#endif
        if (per_cu < 1) { fprintf(stderr, "occupancy query returned %d\n", per_cu); per_cu = 1; }
        grid_blocks = cus * per_cu;
        if (ws_size < WS_END) fprintf(stderr, "workspace too small: %zu < %zu\n", ws_size, (size_t)WS_END);
    }
    Params p{};
    p.x_prompt = (const float*)d_in[0]; p.x_sample = (const float*)d_in[1]; p.cache_k = (const float*)d_in[2]; p.cache_v = (const float*)d_in[3];
    p.state_hgrn = (const float*)d_in[4]; p.w_in = (const float*)d_in[5]; p.ln_v_g = (const float*)d_in[6]; p.ln_v_b = (const float*)d_in[7];
    p.w_s = (const float*)d_in[8]; p.b_s = (const float*)d_in[9]; p.lb_param = (const float*)d_in[10]; p.norm_b_g = (const float*)d_in[11];
    p.sinks = (const float*)d_in[12]; p.w_out = (const float*)d_in[13]; p.ln_g = (const float*)d_in[14]; p.ln_b = (const float*)d_in[15];
    p.out = (float*)d_out; p.ws = (unsigned char*)d_ws;
    for (int i = 0; i < 8; ++i) p.inv[i] = powf(500000.0f, -(float)(2 * i) / 16.0f);
#ifdef MK_SPLIT
    {
        static bool attr_done = false;
        if (!attr_done) {
            (void)hipFuncSetAttribute((const void*)k_prologue, hipFuncAttributeMaxDynamicSharedMemorySize, LDS_BYTES);
            (void)hipFuncSetAttribute((const void*)k_gemm_in, hipFuncAttributeMaxDynamicSharedMemorySize, LDS_BYTES);
            (void)hipFuncSetAttribute((const void*)k_mix_a, hipFuncAttributeMaxDynamicSharedMemorySize, LDS_BYTES);
            (void)hipFuncSetAttribute((const void*)k_scan, hipFuncAttributeMaxDynamicSharedMemorySize, LDS_BYTES);
            (void)hipFuncSetAttribute((const void*)k_hout, hipFuncAttributeMaxDynamicSharedMemorySize, LDS_BYTES);
            (void)hipFuncSetAttribute((const void*)k_gemm_out, hipFuncAttributeMaxDynamicSharedMemorySize, LDS_BYTES);
            (void)hipFuncSetAttribute((const void*)k_ln, hipFuncAttributeMaxDynamicSharedMemorySize, LDS_BYTES);
            attr_done = true;
        }
        const int G = 256;
        k_prologue<<<G, 512, LDS_BYTES, stream>>>(p);
        for (int l = 0; l < 2; ++l) {
            k_gemm_in<<<G, 512, LDS_BYTES, stream>>>(p, l);
            k_mix_a<<<G, 512, LDS_BYTES, stream>>>(p, l);
            k_scan<<<G, 512, LDS_BYTES, stream>>>(p, l);
            k_hout<<<G, 512, LDS_BYTES, stream>>>(p, l);
            k_gemm_out<<<G, 512, LDS_BYTES, stream>>>(p, l);
            k_ln<<<G, 512, LDS_BYTES, stream>>>(p, l);
        }
    }
#else
    void* args[] = {&p};
    hipError_t e = hipLaunchCooperativeKernel((const void*)fwd_megakernel, dim3(grid_blocks), dim3(512), args, LDS_BYTES, stream);
    if (e != hipSuccess) fprintf(stderr, "cooperative launch failed: %s (grid %d)\n", hipGetErrorString(e), grid_blocks);
#endif
}
```

```cpp
#include <hip/hip_runtime.h>
#include <hip/hip_cooperative_groups.h>
#ifndef REP_PRO
#define REP_PRO 1
#endif
#ifndef REP_G1
#define REP_G1 1
#endif
#ifndef REP_MIXA
#define REP_MIXA 1
#endif
#ifndef REP_SCAN
#define REP_SCAN 1
#endif
#ifndef REP_HOUT
#define REP_HOUT 1
#endif
#ifndef REP_G2
#define REP_G2 1
#endif
#ifndef REP_LN
#define REP_LN 1
#endif
#include <cstdio>
#include <cmath>
namespace cg = cooperative_groups;

typedef unsigned short u16;
typedef short bf16x8 __attribute__((ext_vector_type(8)));
typedef short s16x4 __attribute__((ext_vector_type(4)));
typedef float f32x4 __attribute__((ext_vector_type(4)));
typedef unsigned u32x2 __attribute__((ext_vector_type(2)));
typedef unsigned u32x4 __attribute__((ext_vector_type(4)));
#define DI __device__ __forceinline__

constexpr int DM = 1024, NB = 16, SEQ = 4096, NTOKP = NB * SEQ, NTOKS = 256, MTOT = NTOKP + NTOKS;
constexpr int INW = 3072, MIXW = 1024;
constexpr int NCH = 1024, NUNIT = NCH + 16;
constexpr float ALPHA = 1.41421356237309515f;
constexpr int LDS_BYTES = 155648;

constexpr int C_UA = 0, C_VA = 256, C_ZA = 512, C_QB = 768, C_FB = 1024, C_IB = 1280, C_ZB = 1536, C_QC = 1792, C_KC = 2304, C_VC = 2432, C_ZC = 2560;

constexpr size_t WS_WTIN = 0;
constexpr size_t WS_WTOUT = WS_WTIN + 2ull * INW * DM * 2;
constexpr size_t WS_XB = WS_WTOUT + 2ull * DM * DM * 2;
constexpr size_t WS_H = WS_XB + (size_t)MTOT * DM * 2;
constexpr size_t WS_MIX = WS_H + (size_t)MTOT * INW * 2;
constexpr size_t WS_UT = WS_MIX + (size_t)MTOT * MIXW * 2;
constexpr size_t WS_SB = WS_UT + (size_t)NUNIT * 4 * 4096 * 4;
constexpr size_t WS_DEC = WS_SB + (size_t)NUNIT * 4 * 4096 * 2;
constexpr size_t WS_WSB = WS_DEC + (size_t)NUNIT * 4 * 64 * 4;
constexpr size_t WS_RT = WS_WSB + 2ull * 4 * 128 * 128 * 2;
constexpr size_t WS_KVS = WS_RT + 4112ull * 8 * 8;
constexpr size_t WS_LB = WS_KVS + 2ull * 16 * 144 * 256 * 2;
constexpr size_t WS_BAR = WS_LB + 2ull * 256 * 4;
constexpr size_t WS_END = WS_BAR + 16384;

constexpr size_t O_YP = 0;
constexpr size_t O_YS = O_YP + (size_t)NTOKP * DM;
constexpr size_t O_KP = O_YS + (size_t)NTOKS * DM;
constexpr size_t O_VP = O_KP + 2ull * 16 * 128 * 128;
constexpr size_t O_HP = O_VP + 2ull * 16 * 128 * 128;
constexpr size_t O_KS = O_HP + 2ull * 16 * 4 * 4096;
constexpr size_t O_VS = O_KS + 2ull * 16 * 16 * 128;
constexpr size_t O_HS = O_VS + 2ull * 16 * 16 * 128;
constexpr size_t O_SV = O_HS + 2ull * 16 * 4 * 4096;

struct Params {
    const float* x_prompt; const float* x_sample; const float* cache_k; const float* cache_v; const float* state_hgrn;
    const float* w_in; const float* ln_v_g; const float* ln_v_b; const float* w_s; const float* b_s; const float* lb_param;
    const float* norm_b_g; const float* sinks; const float* w_out; const float* ln_g; const float* ln_b;
    float* out; unsigned char* ws;
    float inv[8];
};

extern __shared__ __attribute__((aligned(16))) unsigned char shm[];

DI unsigned cvt_pk_bf16(float lo, float hi) { unsigned r; asm volatile("v_cvt_pk_bf16_f32 %0, %1, %2" : "=v"(r) : "v"(lo), "v"(hi)); return r; }
DI u16 f2bf(float x) { return (u16)(cvt_pk_bf16(x, 0.f) & 0xffffu); }
DI size_t hidx(size_t row, int col) { return (size_t)(col >> 8) * ((size_t)MTOT * 256) + row * 256 + (size_t)(col & 255); }
DI float bf2f(u16 v) { return __uint_as_float(((unsigned)v) << 16); }
DI unsigned f2h(float x) { return (unsigned)__builtin_bit_cast(u16, (_Float16)x); }
DI float h2f(u16 b) { return (float)__builtin_bit_cast(_Float16, b); }
DI float bflo(unsigned w) { return __uint_as_float(w << 16); }
DI float bfhi(unsigned w) { return __uint_as_float(w & 0xffff0000u); }
DI float silu_f(float x) { return x * __builtin_amdgcn_rcpf(1.f + __expf(-x)); }
DI float wave_sum(float v) {
#pragma unroll
    for (int o = 1; o < 64; o <<= 1) v += __shfl_xor(v, o);
    return v;
}
DI int tid_opaque() { int t = threadIdx.x; asm volatile("" : "+v"(t)); return t; }
DI s16x4 tr_read4(const u16* p) { return __builtin_amdgcn_ds_read_tr16_b64_v4i16((__attribute__((address_space(3))) s16x4*)p); }
#define MFMA16(a, b, c) __builtin_amdgcn_mfma_f32_16x16x32_bf16((a), (b), (c), 0, 0, 0)


#define XB_TMO      128
#define XB_XCNT(j)  (256  + 64 * (j))
#define XB_XSUB(j)  (1280 + 64 * (j))
#define XB_XGEN(j)  (2304 + 64 * (j))
#define XB_TOP      3328
#define XB_TOPGEN   3392
#define XCD_BAR_WORDS 3456
#define XB_SPIN_CAP (1u << 22)
#define LAS __attribute__((address_space(3)))
DI unsigned xb_ld(unsigned* p) { return __hip_atomic_load(p, __ATOMIC_RELAXED, __HIP_MEMORY_SCOPE_AGENT); }
DI unsigned xb_add(unsigned* p, unsigned v) { return __hip_atomic_fetch_add(p, v, __ATOMIC_RELAXED, __HIP_MEMORY_SCOPE_AGENT); }
DI unsigned xb_xcc_id() { return (unsigned)__builtin_amdgcn_s_getreg((3 << 11) | 20) & 0xFu; }
#define XB_SPIN(cond, bar) do { unsigned _sp = 0; while (cond) { __builtin_amdgcn_s_sleep(1); \
    if ((++_sp & 255u) == 0u) { if (xb_ld(&(bar)[XB_TMO])) break; if (_sp > XB_SPIN_CAP) { atomicAdd(&(bar)[XB_TMO], 1u); break; } } } } while (0)
struct XcdBarrier { unsigned* bar; unsigned x; volatile LAS unsigned* st; };
DI XcdBarrier xcd_barrier_post(unsigned* bar, volatile LAS unsigned* st) {
    XcdBarrier b; b.bar = bar; b.x = xb_xcc_id(); b.st = st;
    if (threadIdx.x == 0) (void)xb_add(&bar[XB_XCNT(b.x)], 1u);
    return b;
}
DI void xcd_barrier_complete(unsigned* bar, unsigned x, unsigned& nloc, unsigned& nx) {
    const unsigned G = gridDim.x * gridDim.y * gridDim.z;
    unsigned sum, cnt, mine, sp = 0u;
    for (;;) {
        sum = 0u; cnt = 0u; mine = 0u;
#pragma unroll
        for (unsigned j = 0; j < 16; ++j) { const unsigned c = xb_ld(&bar[XB_XCNT(j)]); sum += c; cnt += (c > 0u) ? 1u : 0u; mine = (j == x) ? c : mine; }
        if (sum == G) break;
        __builtin_amdgcn_s_sleep(1);
        if ((++sp & 255u) == 0u) { if (xb_ld(&bar[XB_TMO])) break; if (sp > XB_SPIN_CAP) { atomicAdd(&bar[XB_TMO], 1u); break; } }
    }
    nloc = mine > 0u ? mine : 1u; nx = cnt > 0u ? cnt : 1u;
}
DI void xcd_barrier(const XcdBarrier& b) {
    asm volatile("s_waitcnt vmcnt(0)" ::: "memory");
    __syncthreads();
    if (threadIdx.x == 0) {
        unsigned* bar = b.bar;
        __builtin_amdgcn_s_waitcnt(0);
        unsigned nloc = b.st[0], nx = b.st[1];
        if (nloc == 0u) { xcd_barrier_complete(bar, b.x, nloc, nx); b.st[0] = nloc; b.st[1] = nx; }
        const unsigned old = xb_add(&bar[XB_XSUB(b.x)], 1u);
        const unsigned gen = old / nloc;
        if (old + 1u == (gen + 1u) * nloc) {
            __builtin_amdgcn_fence(__ATOMIC_RELEASE, "agent");
            asm volatile("s_waitcnt vmcnt(0)" ::: "memory");
            const unsigned og = xb_add(&bar[XB_TOP], 1u);
            const unsigned tg = og / nx;
            if (og + 1u == (tg + 1u) * nx) xb_add(&bar[XB_TOPGEN], 1u);
            else XB_SPIN(xb_ld(&bar[XB_TOPGEN]) == tg, bar);
            __builtin_amdgcn_fence(__ATOMIC_ACQUIRE, "agent");
            xb_add(&bar[XB_XGEN(b.x)], 1u);
            asm volatile("s_waitcnt vmcnt(0)" ::: "memory");
        } else {
            XB_SPIN(xb_ld(&bar[XB_XGEN(b.x)]) == gen, bar);
            __builtin_amdgcn_fence(__ATOMIC_ACQUIRE, "agent");
            asm volatile("s_waitcnt vmcnt(0)" ::: "memory");
        }
    }
    __syncthreads();
}

constexpr int BM = 256, BK = 64, HALF = 128, NXCD = 8, WGM = 8, HT = HALF * BK;
DI int lds_byte(int r, int c) { int st = (r >> 4) * 2 + (c >> 5), rr = r & 15, cc = c & 31, ob = rr * 64 + cc * 2; return st * 1024 + (ob ^ (((ob >> 9) & 1) << 5)); }
DI void stage_rc(int b, int& R, int& C) { int st = b / 1024, sb = b % 1024, swz = sb ^ (((sb >> 9) & 1) << 5); R = (st >> 1) * 16 + swz / 64; C = (st & 1) * 32 + (swz % 64) / 2; }

DI int perm32(int rho) { const int n = rho >> 4, i = rho & 15; return 8 * (i >> 2) + 4 * n + (i & 3); }
struct Unit { int pm, pn; };
struct StaticOrder {
    int nM, nN, nwg, G, c, pm0, wgm;
    DI void init(int nM_, int nN_, int G_, int c_, int pm0_, int wgm_ = WGM) { nM = nM_; nN = nN_; nwg = nM * nN; G = G_; c = c_; pm0 = pm0_; wgm = wgm_; }
    DI bool next(int i, Unit& u) const {
        const long L = (long)i * G + c; if (c >= G || L >= nwg) return false;
        int wgid = (int)L; { const int q = nwg / NXCD, r = nwg % NXCD, xcd = wgid % NXCD, off = wgid / NXCD; wgid = (xcd < r ? xcd * (q + 1) : r * (q + 1) + (xcd - r) * q) + off; }
        const int nig = wgm * nN, gid = wgid / nig, fm = gid * wgm, gsz = (nM - fm) < wgm ? (nM - fm) : wgm;
        u.pm = pm0 + fm + ((wgid % nig) % gsz); u.pn = (wgid % nig) / gsz; return true;
    }
};
template <class Epi, class Sched>
DI void gemm_phase(const u16* __restrict__ A, const u16* __restrict__ Bt, const Sched& S, const Epi& E) {
    LAS unsigned char* lds = (LAS unsigned char*)shm;
    constexpr int K = 1024, nt = K / BK, HTB = HT * 2;
    const int tid = tid_opaque(), wid = __builtin_amdgcn_readfirstlane(tid >> 6), lane = tid & 63, wr = wid >> 2, wc = wid & 3, fr = lane & 15, fq = lane >> 4;
    unsigned voffA[2], voffB[2];
#pragma unroll
    for (int i = 0; i < 2; ++i) { int R, C; stage_rc(tid * 16 + i * 8192, R, C); const int Rb = (R & ~31) + perm32(R & 31);
        voffA[i] = (unsigned)(R * K + C) * 2u; voffB[i] = (unsigned)(Rb * K + C) * 2u; }
    const size_t kstep = (size_t)(BK * 2), hstep = (size_t)HALF * K * 2, tstep = 2 * hstep;
    const unsigned ldsw = (unsigned)wid * 1024u;
    const int aoff = lds_byte(wr * 64 + fr, fq * 8), boff = lds_byte(wc * 32 + fr, fq * 8);
#define SA(b, h) (((b) * 2 + (h)) * HTB)
#define SB(b, h) ((4 + (b) * 2 + (h)) * HTB)
#define STAGE(bufoff, gbase, voff) do { _Pragma("unroll") for (int _i = 0; _i < 2; ++_i) \
    __builtin_amdgcn_global_load_lds((const unsigned*)((const char*)(gbase) + (voff)[_i]), (LAS unsigned*)(lds + (bufoff) + ldsw + _i * 8192), 16, 0, 0); } while (0)
#define LDA(dst, b, h) do { _Pragma("unroll") for (int m = 0; m < 4; ++m) _Pragma("unroll") for (int k = 0; k < 2; ++k) dst[m][k] = *(const LAS bf16x8*)(lds + SA(b, h) + aoff + m * 2048 + k * 1024); } while (0)
#define LDB(dst, b, h) do { _Pragma("unroll") for (int n = 0; n < 2; ++n) _Pragma("unroll") for (int k = 0; k < 2; ++k) dst[n][k] = *(const LAS bf16x8*)(lds + SB(b, h) + boff + n * 2048 + k * 1024); } while (0)
#define MMA(ai, bj, At, Bt_) do { __builtin_amdgcn_s_setprio(1); _Pragma("unroll") for (int m = 0; m < 4; ++m) _Pragma("unroll") for (int n = 0; n < 2; ++n) _Pragma("unroll") for (int k = 0; k < 2; ++k) \
      acc[ai][bj][m][n] = MFMA16(Bt_[n][k], At[m][k], acc[ai][bj][m][n]); \
    __builtin_amdgcn_s_setprio(0); } while (0)
#define WAIT_V(n) asm volatile("s_waitcnt vmcnt(" #n ")" ::: "memory")
#define WAIT_L(n) asm volatile("s_waitcnt lgkmcnt(" #n ")" ::: "memory")
#define BAR __builtin_amdgcn_s_barrier()
#define SCHED __builtin_amdgcn_sched_barrier(0)
    Unit cur, nxt; int ui = 0;
    if (!S.next(0, cur)) return;
    f32x4 acc[2][2][4][2];
#pragma unroll
    for (int a = 0; a < 2; ++a)
#pragma unroll
        for (int b = 0; b < 2; ++b)
#pragma unroll
            for (int m = 0; m < 4; ++m)
#pragma unroll
                for (int n = 0; n < 2; ++n) acc[a][b][m][n] = (f32x4){0.f, 0.f, 0.f, 0.f};
    bf16x8 At[4][2], B0[2][2], B1[2][2];
    const char* cA = (const char*)A + (size_t)cur.pm * tstep; const char* cB = (const char*)Bt + (size_t)cur.pn * tstep;
    STAGE(SB(0, 0), cB, voffB); STAGE(SB(0, 1), cB + hstep, voffB); STAGE(SA(0, 0), cA, voffA); STAGE(SA(0, 1), cA + hstep, voffA);
    if (wr == 1) BAR;
    WAIT_V(2); BAR;
    STAGE(SB(1, 0), cB + kstep, voffB); STAGE(SA(1, 0), cA + kstep, voffA); STAGE(SB(1, 1), cB + hstep + kstep, voffB);
    WAIT_V(6); BAR;
    for (;;) {
        const bool has_next = S.next(ui + 1, nxt);
        const char* nA = has_next ? (const char*)A + (size_t)nxt.pm * tstep : cA; const char* nB = has_next ? (const char*)Bt + (size_t)nxt.pn * tstep : cB;
        for (int t = 0; t < nt; t += 2) {
            const bool last = (t == nt - 2);
            const char* a1 = cA + (size_t)(t + 1) * kstep;
            const char* a2 = last ? nA : cA + (size_t)(t + 2) * kstep; const char* b2 = last ? nB : cB + (size_t)(t + 2) * kstep;
            const char* a3 = a2 + kstep; const char* b3 = b2 + kstep;
            LDB(B0, 0, 0); LDB(B1, 0, 1); SCHED; LDA(At, 0, 0); STAGE(SA(1, 1), a1 + hstep, voffA);
            WAIT_V(8); WAIT_L(0); BAR; MMA(0, 0, At, B0); MMA(0, 1, At, B1); BAR; SCHED;
            LDA(At, 0, 1); STAGE(SB(0, 0), b2, voffB); STAGE(SB(0, 1), b2 + hstep, voffB); STAGE(SA(0, 0), a2, voffA);
            WAIT_V(8); WAIT_L(0); BAR; MMA(1, 0, At, B0); MMA(1, 1, At, B1); BAR; SCHED;
            LDB(B0, 1, 0); LDB(B1, 1, 1); SCHED; LDA(At, 1, 0); STAGE(SA(0, 1), a2 + hstep, voffA);
            WAIT_V(8); WAIT_L(0); BAR; MMA(0, 0, At, B0); MMA(0, 1, At, B1); BAR; SCHED;
            LDA(At, 1, 1); STAGE(SB(1, 0), b3, voffB); STAGE(SB(1, 1), b3 + hstep, voffB); STAGE(SA(1, 0), a3, voffA);
            WAIT_V(8); WAIT_L(0); BAR; MMA(1, 0, At, B0); MMA(1, 1, At, B1); BAR; SCHED;
        }
        if (wr == 0) BAR;
        E(acc, cur.pm * BM, cur.pn * BM, wr, wc, fr, fq);
        if (!has_next) break;
#pragma unroll
        for (int a = 0; a < 2; ++a)
#pragma unroll
            for (int b = 0; b < 2; ++b)
#pragma unroll
                for (int m = 0; m < 4; ++m)
#pragma unroll
                    for (int n = 0; n < 2; ++n) acc[a][b][m][n] = (f32x4){0.f, 0.f, 0.f, 0.f};
        cur = nxt; cA = nA; cB = nB; ++ui;
        if (wr == 1) BAR;
    }
    WAIT_V(0);
    BAR;
    __syncthreads();
#undef SA
#undef SB
#undef STAGE
#undef LDA
#undef LDB
#undef MMA
}

struct EpiIn {
    unsigned char* ws; float* out; int l;
    DI void operator()(const f32x4 (&acc)[2][2][4][2], int brow, int bcol, int wr, int wc, int fr, int fq) const {
        int ll = l; asm volatile("" : "+s"(ll));
        u16* H = (u16*)(ws + WS_H); const float* RT = (const float*)(ws + WS_RT);
        float* okp = out + O_KP + (size_t)ll * 16 * 128 * 128; float* ovp = out + O_VP + (size_t)ll * 16 * 128 * 128;
        float* oks = out + O_KS + (size_t)ll * 16 * 16 * 128; float* ovs = out + O_VS + (size_t)ll * 16 * 16 * 128;
        u16* KVS = (u16*)(ws + WS_KVS) + (size_t)ll * 16 * 144 * 256;
        int type[2];
#pragma unroll
        for (int bj = 0; bj < 2; ++bj) {
            const int cb = bcol + bj * HALF; int ty;
            if (cb < C_ZA) ty = 0; else if (cb < C_FB) ty = 1; else if (cb < C_IB) ty = 5; else if (cb < C_ZB) ty = 0; else if (cb < C_QC) ty = 1;
            else if (cb < C_KC) ty = 2; else if (cb == C_KC) ty = 3; else if (cb == C_VC) ty = 4; else ty = 1;
            type[bj] = ty;
        }
        const int cin = wc * 32 + fq * 8;
        f32x4 lbv[2][2];
#pragma unroll
        for (int bj = 0; bj < 2; ++bj) {
            lbv[bj][0] = (f32x4){0.f, 0.f, 0.f, 0.f}; lbv[bj][1] = (f32x4){0.f, 0.f, 0.f, 0.f};
            if (type[bj] == 5) { const float* lbp = (const float*)(ws + WS_LB) + ll * 256 + (bcol + bj * HALF - C_FB) + cin; lbv[bj][0] = *(const f32x4*)lbp; lbv[bj][1] = *(const f32x4*)(lbp + 4); }
        }
#pragma unroll
        for (int ai = 0; ai < 2; ++ai)
#pragma unroll
            for (int m = 0; m < 4; ++m) {
                const int row = brow + ai * HALF + wr * 64 + m * 16 + fr;
                int posidx, kvo = -1; float* ko = nullptr; float* vo = nullptr; u16* kvs = nullptr;
                if (row < NTOKP) { const int b = row >> 12, t = row & 4095; posidx = t;
                    if (t >= SEQ - 128) { kvo = (b * 128 + (t - (SEQ - 128))) * 128; ko = okp; vo = ovp; } }
                else { const int s = row - NTOKP, sb = s >> 4, st = s & 15; posidx = 4096 + st; kvo = (sb * 16 + st) * 128; ko = oks; vo = ovs; kvs = KVS + (size_t)(sb * 144 + 128 + st) * 256; }
#pragma unroll
                for (int bj = 0; bj < 2; ++bj) {
                    const int cb = bcol + bj * HALF, ty = type[bj];
                    f32x4 v0 = acc[ai][bj][m][0], v1 = acc[ai][bj][m][1];
                    if (ty == 1) {
#pragma unroll
                        for (int j = 0; j < 4; ++j) { v0[j] = silu_f(v0[j]); v1[j] = silu_f(v1[j]); }
                    } else if (ty == 5) {
                        const f32x4 l0 = lbv[bj][0], l1 = lbv[bj][1];
#pragma unroll
                        for (int j = 0; j < 4; ++j) {
                            const float t0 = __expf(-v0[j]), t1 = __expf(-v1[j]);
                            const float s0 = __builtin_amdgcn_rcpf(1.f + t0), s1 = __builtin_amdgcn_rcpf(1.f + t1);
                            const float k0 = (1.f - l0[j]) * t0 * s0, k1 = (1.f - l1[j]) * t1 * s1;
                            const float f0 = l0[j] + (1.f - l0[j]) * s0, f1 = l1[j] + (1.f - l1[j]) * s1;
                            v0[j] = (k0 <= 0.5f) ? k0 : -f0; v1[j] = (k1 <= 0.5f) ? k1 : -f1;
                        }
                    } else if (ty == 2 || ty == 3) {
                        if ((wc & 1) == 0) {
                            const f32x4 c0 = *(const f32x4*)(RT + (size_t)posidx * 16), c1 = *(const f32x4*)(RT + (size_t)posidx * 16 + 4), c2 = *(const f32x4*)(RT + (size_t)posidx * 16 + 8), c3 = *(const f32x4*)(RT + (size_t)posidx * 16 + 12);
                            const float cs[8] = {c0[0], c0[2], c1[0], c1[2], c2[0], c2[2], c3[0], c3[2]}, sn[8] = {c0[1], c0[3], c1[1], c1[3], c2[1], c2[3], c3[1], c3[3]};
#pragma unroll
                            for (int e = 0; e < 8; ++e) {
                                const float mine = (e < 4) ? v0[e & 3] : v1[e & 3];
                                const float pv = __shfl_xor(mine, 16);
                                const float rot = (fq == 0) ? (mine * cs[e] - pv * sn[e]) : (mine * cs[e] + pv * sn[e]);
                                const float res = (fq < 2) ? rot : mine;
                                if (e < 4) v0[e & 3] = res; else v1[e & 3] = res;
                            }
                        }
                        if (ty == 3) { if (kvo >= 0) { *(f32x4*)(ko + kvo + cin) = v0; *(f32x4*)(ko + kvo + cin + 4) = v1; } }
                        else { v0 = v0 * 0.18033688011112042f; v1 = v1 * 0.18033688011112042f; }
                    } else if (ty == 4) { if (kvo >= 0) { *(f32x4*)(vo + kvo + cin) = v0; *(f32x4*)(vo + kvo + cin + 4) = v1; } }
                    u32x4 w; w.x = cvt_pk_bf16(v0[0], v0[1]); w.y = cvt_pk_bf16(v0[2], v0[3]); w.z = cvt_pk_bf16(v1[0], v1[1]); w.w = cvt_pk_bf16(v1[2], v1[3]);
                    if (ty == 5) {
                        w.x = f2h(v0[0]) | (f2h(v0[1]) << 16); w.y = f2h(v0[2]) | (f2h(v0[3]) << 16); w.z = f2h(v1[0]) | (f2h(v1[1]) << 16); w.w = f2h(v1[2]) | (f2h(v1[3]) << 16);
                    }
                    __builtin_nontemporal_store(w, (u32x4*)(H + hidx((size_t)row, cb + cin)));
                    if ((ty == 3 || ty == 4) && kvs) *(u32x4*)(kvs + (cb + cin - C_KC)) = w;
                }
                asm volatile("" ::: "memory");
            }
    }
};
struct EpiOut {
    unsigned char* ws;
    DI void operator()(const f32x4 (&acc)[2][2][4][2], int brow, int bcol, int wr, int wc, int fr, int fq) const {
        size_t zo = WS_H; asm volatile("" : "+s"(zo));
        u16* Z = (u16*)(ws + zo); const u16* XB = (const u16*)(ws + zo - WS_H + WS_XB);
        u32x4 xw[2][4][2];
#pragma unroll
        for (int ai = 0; ai < 2; ++ai)
#pragma unroll
            for (int m = 0; m < 4; ++m)
#pragma unroll
                for (int bj = 0; bj < 2; ++bj)
                    xw[ai][m][bj] = *(const u32x4*)(XB + (size_t)(brow + ai * HALF + wr * 64 + m * 16 + fr) * DM + bcol + bj * HALF + wc * 32 + fq * 8);
#pragma unroll
        for (int ai = 0; ai < 2; ++ai)
#pragma unroll
            for (int m = 0; m < 4; ++m) {
                const int row = brow + ai * HALF + wr * 64 + m * 16 + fr;
#pragma unroll
                for (int bj = 0; bj < 2; ++bj) {
                    const int col0 = bcol + bj * HALF + wc * 32 + fq * 8;
                    const u32x4 x4 = xw[ai][m][bj];
                    f32x4 v0 = acc[ai][bj][m][0], v1 = acc[ai][bj][m][1];
                    v0[0] += ALPHA * bflo(x4.x); v0[1] += ALPHA * bfhi(x4.x); v0[2] += ALPHA * bflo(x4.y); v0[3] += ALPHA * bfhi(x4.y);
                    v1[0] += ALPHA * bflo(x4.z); v1[1] += ALPHA * bfhi(x4.z); v1[2] += ALPHA * bflo(x4.w); v1[3] += ALPHA * bfhi(x4.w);
                    u32x4 w; w.x = cvt_pk_bf16(v0[0], v0[1]); w.y = cvt_pk_bf16(v0[2], v0[3]); w.z = cvt_pk_bf16(v1[0], v1[1]); w.w = cvt_pk_bf16(v1[2], v1[3]);
                    __builtin_nontemporal_store(w, (u32x4*)(Z + (size_t)row * DM + col0));
                }
            }
    }
};

DI void phase_prologue(const Params& p) {
    const int tid = tid_opaque();
    const long gt = (long)blockIdx.x * 512 + tid, nth = (long)gridDim.x * 512;
    unsigned char* ws = p.ws;
    const int NTW = (gridDim.x >= 256) ? 48 : 0;
    const bool do_cvt = (NTW == 0) || ((int)blockIdx.x >= NTW), do_tr = (NTW == 0) || ((int)blockIdx.x < NTW);
    const long gtc = (long)((int)blockIdx.x - NTW) * 512 + tid, nthc = (long)((int)gridDim.x - NTW) * 512;
    if (do_cvt) {
        u16* XB = (u16*)(ws + WS_XB);
        const long nv = (long)MTOT * DM / 8;
        const long nth = nthc;
        for (long i0 = gtc; i0 < nv; i0 += 4 * nth) {
            f32x4 a[4], b[4];
#pragma unroll
            for (int k = 0; k < 4; ++k) {
                const long i = i0 + k * nth;
                const long e = (i < nv ? i : i0) * 8;
                const float* sp = (e < (long)NTOKP * DM) ? (p.x_prompt + e) : (p.x_sample + (e - (long)NTOKP * DM));
                a[k] = __builtin_nontemporal_load((const f32x4*)sp); b[k] = __builtin_nontemporal_load((const f32x4*)(sp + 4));
            }
#pragma unroll
            for (int k = 0; k < 4; ++k) {
                const long i = i0 + k * nth;
                if (i < nv) {
                    u32x4 o; o.x = cvt_pk_bf16(a[k][0], a[k][1]); o.y = cvt_pk_bf16(a[k][2], a[k][3]); o.z = cvt_pk_bf16(b[k][0], b[k][1]); o.w = cvt_pk_bf16(b[k][2], b[k][3]);
                    *(u32x4*)(XB + i * 8) = o;
                }
            }
        }
    }
    if (do_tr) {
        float* tile = (float*)shm;
        const int T_IN = 16 * 48, T_OUT = 16 * 16, NT = 2 * T_IN + 2 * T_OUT;
        const int trs = NTW ? NTW : (int)gridDim.x;
        for (int it = blockIdx.x; it < NT; it += trs) {
            const float* W; u16* WT; int N, r = it;
            if (r < 2 * T_IN) { const int l = r / T_IN; r -= l * T_IN; W = p.w_in + (size_t)l * DM * INW; WT = (u16*)(ws + WS_WTIN) + (size_t)l * INW * DM; N = INW; }
            else { r -= 2 * T_IN; const int l = r / T_OUT; r -= l * T_OUT; W = p.w_out + (size_t)l * MIXW * DM; WT = (u16*)(ws + WS_WTOUT) + (size_t)l * DM * MIXW; N = DM; }
            const int nb = N / 64, k0 = (r / nb) * 64, n0 = (r % nb) * 64;
#pragma unroll
            for (int i = 0; i < 8; ++i) { const int idx = tid + i * 512, kk = idx >> 6, nn = idx & 63; tile[kk * 65 + nn] = W[(size_t)(k0 + kk) * N + n0 + nn]; }
            __syncthreads();
#pragma unroll
            for (int i = 0; i < 8; ++i) { const int idx = tid + i * 512, nn = idx >> 6, kk = idx & 63; WT[(size_t)(n0 + nn) * 1024 + k0 + kk] = f2bf(tile[kk * 65 + nn]); }
            __syncthreads();
        }
    }
    {
        u16* WSB = (u16*)(ws + WS_WSB);
        for (long i = gt; i < 2 * 4 * 128 * 128; i += nth) { const int jj = i & 127, ii = (i >> 7) & 127; WSB[i] = ((jj >> 6) <= (ii >> 6)) ? f2bf(p.w_s[i]) : (u16)0; }
    }
    {
        float2* RT = (float2*)(ws + WS_RT);
        for (long i = gt; i < 4112 * 8; i += nth) {
            const int pi = (int)(i >> 3), fi = (int)(i & 7);
            const int pos = pi < 4096 ? pi : 2048 + (pi - 4096);
            const float ang = (float)pos * p.inv[fi];
            double r = (double)ang * 0.15915494309189533577; r -= rint(r);
            const float rf = (float)r;
            RT[i] = make_float2(__builtin_amdgcn_cosf(rf), __builtin_amdgcn_sinf(rf));
        }
    }
    {
        u16* KVS = (u16*)(ws + WS_KVS);
        for (long i = gt; i < 2 * 16 * 128 * 256; i += nth) {
            const int c = i & 255, row = (i >> 8) & 127, lb = (int)(i >> 15);
            const float v = (c < 128) ? p.cache_k[((size_t)lb * 128 + row) * 128 + c] : p.cache_v[((size_t)lb * 128 + row) * 128 + (c - 128)];
            KVS[((size_t)lb * 144 + row) * 256 + c] = f2bf(v);
        }
    }
    {
        float* LB = (float*)(ws + WS_LB);
        for (long i = gt; i < 256; i += nth) {
            const float a = p.lb_param[i], b = p.lb_param[256 + i], m = fmaxf(a, b);
            const float ea = expf(a - m), eb = expf(b - m);
            LB[i] = 0.f; LB[256 + i] = eb / (ea + eb);
        }
    }
}

constexpr int VROW = 72;
DI void attn_unit(const u16* __restrict__ Q, int qstride, int nq, const u16* __restrict__ Kp, const u16* __restrict__ Vp, int kvstride, int nkeys,
                  const u16* __restrict__ Zg, int zstride, u16* __restrict__ Out, int ostride, const float* __restrict__ sinks4) {
    u16* Vl = (u16*)shm;
    const int tid = tid_opaque(), wid = __builtin_amdgcn_readfirstlane(tid >> 6), lane = tid & 63, fr = lane & 15, fq = lane >> 4;
    const int nk32 = (nkeys + 31) & ~31, nkt = nk32 >> 4, nks = nk32 >> 5;
    const int r = wid >> 1, q0 = (wid & 1) * 32;
    const bool active = q0 < nq;
    u32x4 vreg[3];
#pragma unroll
    for (int i = 0; i < 3; ++i) {
        const int idx = tid + i * 512, key = idx >> 3, d0 = (idx & 7) * 8;
        vreg[i] = (u32x4){0u, 0u, 0u, 0u};
        if (key < nkeys) vreg[i] = *(const u32x4*)(Vp + (size_t)key * kvstride + d0);
    }
    bf16x8 bq[2][2], ak[12][2];
    if (active) {
#pragma unroll
        for (int qt = 0; qt < 2; ++qt)
#pragma unroll
            for (int ks = 0; ks < 2; ++ks) { const int qrow = min(q0 + qt * 16 + fr, nq - 1); bq[qt][ks] = *(const bf16x8*)(Q + (size_t)qrow * qstride + r * 64 + ks * 32 + fq * 8); }
#pragma unroll
        for (int kt = 0; kt < 12; ++kt) if (kt < nkt) {
            const int krow = min(kt * 16 + fr, nkeys - 1);
            ak[kt][0] = *(const bf16x8*)(Kp + (size_t)krow * kvstride + fq * 8); ak[kt][1] = *(const bf16x8*)(Kp + (size_t)krow * kvstride + 32 + fq * 8);
        }
    }
#pragma unroll
    for (int i = 0; i < 3; ++i) {
        const int idx = tid + i * 512, key = idx >> 3, d0 = (idx & 7) * 8;
        if (key < nk32) *(u32x4*)(Vl + key * VROW + d0) = vreg[i];
    }
    __syncthreads();
    if (active) {
        f32x4 st[12][2];
#pragma unroll
        for (int kt = 0; kt < 12; ++kt) {
            st[kt][0] = (f32x4){0.f, 0.f, 0.f, 0.f}; st[kt][1] = (f32x4){0.f, 0.f, 0.f, 0.f};
            if (kt < nkt) {
#pragma unroll
                for (int qt = 0; qt < 2; ++qt) { st[kt][qt] = MFMA16(ak[kt][0], bq[qt][0], st[kt][qt]); st[kt][qt] = MFMA16(ak[kt][1], bq[qt][1], st[kt][qt]); }
            }
        }
        u32x2 zw[2][4];
#pragma unroll
        for (int qt = 0; qt < 2; ++qt) {
            const int q = min(q0 + qt * 16 + fr, nq - 1);
#pragma unroll
            for (int dt = 0; dt < 4; ++dt) zw[qt][dt] = *(const u32x2*)(Zg + (size_t)q * zstride + r * 64 + dt * 16 + fq * 4);
        }
        const float sink = sinks4[r] * 1.4426950408889634f;
        float inv_den[2];
        bf16x8 pb[2][6];
#pragma unroll
        for (int qt = 0; qt < 2; ++qt) {
            float mx = sink;
#pragma unroll
            for (int kt = 0; kt < 12; ++kt) if (kt < nkt) {
#pragma unroll
                for (int j = 0; j < 4; ++j) { const int key = kt * 16 + fq * 4 + j; float s = st[kt][qt][j]; if (key >= nkeys) s = -INFINITY; st[kt][qt][j] = s; mx = fmaxf(mx, s); }
            }
            mx = fmaxf(mx, __shfl_xor(mx, 16)); mx = fmaxf(mx, __shfl_xor(mx, 32));
            float sum = 0.f;
#pragma unroll
            for (int kt = 0; kt < 12; ++kt) if (kt < nkt) {
#pragma unroll
                for (int j = 0; j < 4; ++j) { const float e = __builtin_amdgcn_exp2f(st[kt][qt][j] - mx); st[kt][qt][j] = e; sum += e; }
            }
            sum += __shfl_xor(sum, 16); sum += __shfl_xor(sum, 32);
            inv_den[qt] = 1.f / (sum + __builtin_amdgcn_exp2f(sink - mx));
#pragma unroll
            for (int s2 = 0; s2 < 6; ++s2) {
                u32x4 w;
                w.x = cvt_pk_bf16(st[2 * s2][qt][0], st[2 * s2][qt][1]); w.y = cvt_pk_bf16(st[2 * s2][qt][2], st[2 * s2][qt][3]);
                w.z = cvt_pk_bf16(st[2 * s2 + 1][qt][0], st[2 * s2 + 1][qt][1]); w.w = cvt_pk_bf16(st[2 * s2 + 1][qt][2], st[2 * s2 + 1][qt][3]);
                pb[qt][s2] = __builtin_bit_cast(bf16x8, w);
            }
        }
        f32x4 o[4][2];
#pragma unroll
        for (int dt = 0; dt < 4; ++dt) { o[dt][0] = (f32x4){0.f, 0.f, 0.f, 0.f}; o[dt][1] = (f32x4){0.f, 0.f, 0.f, 0.f}; }
#pragma unroll
        for (int s2 = 0; s2 < 6; ++s2) if (s2 < nks) {
#pragma unroll
            for (int dt = 0; dt < 4; ++dt) {
                const u16* vr = Vl + (32 * s2 + 4 * fq + (fr >> 2)) * VROW + dt * 16 + 4 * (fr & 3);
                const s16x4 lo = tr_read4(vr), hi = tr_read4(vr + 16 * VROW);
                const bf16x8 a = __builtin_shufflevector(lo, hi, 0, 1, 2, 3, 4, 5, 6, 7);
                o[dt][0] = MFMA16(a, pb[0][s2], o[dt][0]); o[dt][1] = MFMA16(a, pb[1][s2], o[dt][1]);
            }
        }
#pragma unroll
        for (int qt = 0; qt < 2; ++qt) {
            const int q = q0 + qt * 16 + fr;
            if (q < nq) {
#pragma unroll
                for (int dt = 0; dt < 4; ++dt) {
                    const int d = dt * 16 + fq * 4;
                    const u32x2 z2 = zw[qt][dt];
                    const f32x4 ov = o[dt][qt] * inv_den[qt];
                    u32x2 w; w.x = cvt_pk_bf16(ov[0] * bflo(z2.x), ov[1] * bfhi(z2.x)); w.y = cvt_pk_bf16(ov[2] * bflo(z2.y), ov[3] * bfhi(z2.y));
                    *(u32x2*)(Out + (size_t)q * ostride + r * 64 + d) = w;
                }
            }
        }
    }
    __syncthreads();
}

DI void attn_run(const Params& p, int l, int run) {
    unsigned char* ws = p.ws;
    const u16* H = (const u16*)(ws + WS_H); u16* MIX = (u16*)(ws + WS_MIX);
    u16* Kl = (u16*)shm; u16* Vl = Kl + 4 * 64 * VROW;
    const int tid = tid_opaque(), wid = __builtin_amdgcn_readfirstlane(tid >> 6), lane = tid & 63, fr = lane & 15, fq = lane >> 4;
    const int r = wid >> 1, q0 = (wid & 1) * 32;
    const int b = run >> 4, g = (run >> 3) & 1, c0 = (run & 7) * 8;
    const size_t rb = (size_t)b * SEQ;
    u16* Mb = MIX + (size_t)b * SEQ * MIXW;
    const int lkey = tid >> 3, ld0 = (tid & 7) * 8;
    const float sink = p.sinks[l * 8 + g * 4 + r] * 1.4426950408889634f;
    {
        u32x4 kv3[3], vv3[3];
#pragma unroll
        for (int i = 0; i < 3; ++i) {
            const int ch = c0 - 2 + i;
            kv3[i] = (u32x4){0u, 0u, 0u, 0u}; vv3[i] = (u32x4){0u, 0u, 0u, 0u};
            if (ch >= 0) { const size_t rr = rb + ch * 64 + lkey; kv3[i] = *(const u32x4*)(H + hidx(rr, C_KC + g * 64 + ld0)); vv3[i] = *(const u32x4*)(H + hidx(rr, C_VC + g * 64 + ld0)); }
        }
#pragma unroll
        for (int i = 0; i < 3; ++i) {
            const int ch = c0 - 2 + i;
            if (ch >= 0) { *(u32x4*)(Kl + ((ch & 3) * 64 + lkey) * VROW + ld0) = kv3[i]; *(u32x4*)(Vl + ((ch & 3) * 64 + lkey) * VROW + ld0) = vv3[i]; }
        }
    }
    bf16x8 bq[2][2];
#pragma unroll
    for (int qt = 0; qt < 2; ++qt)
#pragma unroll
        for (int ks = 0; ks < 2; ++ks) bq[qt][ks] = *(const bf16x8*)(H + hidx(rb + c0 * 64 + q0 + qt * 16 + fr, C_QC + g * 256 + r * 64 + ks * 32 + fq * 8));
    __syncthreads();
#pragma unroll 1
    for (int u = 0; u < 8; ++u) {
        const int c = c0 + u;
        const int nch = min(c + 1, 3), cf = c - nch + 1, nkt = nch * 4;
        u32x4 kn = {0u, 0u, 0u, 0u}, vn = {0u, 0u, 0u, 0u}; bf16x8 bqn[2][2];
        if (u < 7) {
            const size_t rr = rb + (c + 1) * 64 + lkey;
            kn = *(const u32x4*)(H + hidx(rr, C_KC + g * 64 + ld0)); vn = *(const u32x4*)(H + hidx(rr, C_VC + g * 64 + ld0));
#pragma unroll
            for (int qt = 0; qt < 2; ++qt)
#pragma unroll
                for (int ks = 0; ks < 2; ++ks) bqn[qt][ks] = *(const bf16x8*)(H + hidx(rb + (c + 1) * 64 + q0 + qt * 16 + fr, C_QC + g * 256 + r * 64 + ks * 32 + fq * 8));
        } else {
#pragma unroll
            for (int qt = 0; qt < 2; ++qt)
#pragma unroll
                for (int ks = 0; ks < 2; ++ks) bqn[qt][ks] = bq[qt][ks];
        }
        u32x2 zw[2][4];
#pragma unroll
        for (int qt = 0; qt < 2; ++qt)
#pragma unroll
            for (int dt = 0; dt < 4; ++dt) zw[qt][dt] = *(const u32x2*)(H + hidx(rb + c * 64 + q0 + qt * 16 + fr, C_ZC + g * 256 + r * 64 + dt * 16 + fq * 4));
        f32x4 st[12][2];
#pragma unroll
        for (int kt = 0; kt < 12; ++kt) {
            st[kt][0] = (f32x4){0.f, 0.f, 0.f, 0.f}; st[kt][1] = (f32x4){0.f, 0.f, 0.f, 0.f};
            if (kt < nkt) {
                const int row = (((cf + (kt >> 2)) & 3) * 64 + (kt & 3) * 16 + fr);
                const bf16x8 a0 = *(const bf16x8*)(Kl + row * VROW + fq * 8), a1 = *(const bf16x8*)(Kl + row * VROW + 32 + fq * 8);
#pragma unroll
                for (int qt = 0; qt < 2; ++qt) { st[kt][qt] = MFMA16(a0, bq[qt][0], st[kt][qt]); st[kt][qt] = MFMA16(a1, bq[qt][1], st[kt][qt]); }
            }
        }
        float inv_den[2];
        bf16x8 pb[2][6];
#pragma unroll
        for (int qt = 0; qt < 2; ++qt) {
            float mx = sink;
#pragma unroll
            for (int kt = 0; kt < 12; ++kt) if (kt < nkt) {
#pragma unroll
                for (int j = 0; j < 4; ++j) mx = fmaxf(mx, st[kt][qt][j]);
            }
            mx = fmaxf(mx, __shfl_xor(mx, 16)); mx = fmaxf(mx, __shfl_xor(mx, 32));
            float sum = 0.f;
#pragma unroll
            for (int kt = 0; kt < 12; ++kt) {
                if (kt < nkt) {
#pragma unroll
                    for (int j = 0; j < 4; ++j) { const float e = __builtin_amdgcn_exp2f(st[kt][qt][j] - mx); st[kt][qt][j] = e; sum += e; }
                }
            }
            sum += __shfl_xor(sum, 16); sum += __shfl_xor(sum, 32);
            inv_den[qt] = 1.f / (sum + __builtin_amdgcn_exp2f(sink - mx));
#pragma unroll
            for (int s2 = 0; s2 < 6; ++s2) {
                u32x4 w;
                w.x = cvt_pk_bf16(st[2 * s2][qt][0], st[2 * s2][qt][1]); w.y = cvt_pk_bf16(st[2 * s2][qt][2], st[2 * s2][qt][3]);
                w.z = cvt_pk_bf16(st[2 * s2 + 1][qt][0], st[2 * s2 + 1][qt][1]); w.w = cvt_pk_bf16(st[2 * s2 + 1][qt][2], st[2 * s2 + 1][qt][3]);
                pb[qt][s2] = __builtin_bit_cast(bf16x8, w);
            }
        }
        f32x4 o[4][2];
#pragma unroll
        for (int dt = 0; dt < 4; ++dt) { o[dt][0] = (f32x4){0.f, 0.f, 0.f, 0.f}; o[dt][1] = (f32x4){0.f, 0.f, 0.f, 0.f}; }
#pragma unroll
        for (int s2 = 0; s2 < 6; ++s2) if (s2 < nch * 2) {
            const int rowb = ((cf + (s2 >> 1)) & 3) * 64 + (s2 & 1) * 32;
#pragma unroll
            for (int dt = 0; dt < 4; ++dt) {
                const u16* vr = Vl + (rowb + 4 * fq + (fr >> 2)) * VROW + dt * 16 + 4 * (fr & 3);
                const s16x4 lo = tr_read4(vr), hi = tr_read4(vr + 16 * VROW);
                const bf16x8 a = __builtin_shufflevector(lo, hi, 0, 1, 2, 3, 4, 5, 6, 7);
                o[dt][0] = MFMA16(a, pb[0][s2], o[dt][0]); o[dt][1] = MFMA16(a, pb[1][s2], o[dt][1]);
            }
        }
#pragma unroll
        for (int qt = 0; qt < 2; ++qt) {
            u16* orow = Mb + (size_t)(c * 64 + q0 + qt * 16 + fr) * MIXW + 512 + g * 256 + r * 64;
#pragma unroll
            for (int dt = 0; dt < 4; ++dt) {
                const u32x2 z2 = zw[qt][dt];
                const f32x4 ov = o[dt][qt] * inv_den[qt];
                u32x2 w; w.x = cvt_pk_bf16(ov[0] * bflo(z2.x), ov[1] * bfhi(z2.x)); w.y = cvt_pk_bf16(ov[2] * bflo(z2.y), ov[3] * bfhi(z2.y));
                *(u32x2*)(orow + dt * 16 + fq * 4) = w;
            }
        }
        if (u < 7) {
            *(u32x4*)(Kl + (((c + 1) & 3) * 64 + lkey) * VROW + ld0) = kn; *(u32x4*)(Vl + (((c + 1) & 3) * 64 + lkey) * VROW + ld0) = vn;
        }
#pragma unroll
        for (int qt = 0; qt < 2; ++qt)
#pragma unroll
            for (int ks = 0; ks < 2; ++ks) bq[qt][ks] = bqn[qt][ks];
        __syncthreads();
    }
}

constexpr int VS2 = 272;
DI void sgu_prompt_unit(const Params& p, int l, int unit) {
    unsigned char* ws = p.ws;
    const u16* H = (const u16*)(ws + WS_H); u16* MIX = (u16*)(ws + WS_MIX);
    const u16* WSB = (const u16*)(ws + WS_WSB) + (size_t)l * 4 * 128 * 128;
    u16* vn = (u16*)shm;
    const int tid = tid_opaque(), wid = __builtin_amdgcn_readfirstlane(tid >> 6), lane = tid & 63, fr = lane & 15, fq = lane >> 4;
    const int T0 = unit * 128;
    const int g = wid >> 1, ih = wid & 1;
    const int nks = ih ? 4 : 2;
    const int tok = wid * 16 + (lane >> 2), part = lane & 3;
    u32x4 vraw[8];
#pragma unroll
    for (int j = 0; j < 8; ++j) vraw[j] = *(const u32x4*)(H + hidx((size_t)(T0 + tok), C_VA + j * 32 + part * 8));
    bf16x8 wf[4][4];
#pragma unroll
    for (int ks = 0; ks < 4; ++ks) if (ks < nks) {
#pragma unroll
        for (int mm = 0; mm < 4; ++mm) wf[ks][mm] = *(const bf16x8*)(WSB + ((size_t)g * 128 + (ih * 4 + mm) * 16 + fr) * 128 + ks * 32 + fq * 8);
    }
    {
        float s = 0.f, s2 = 0.f;
#pragma unroll
        for (int j = 0; j < 8; ++j) {
            const u32x4 w = vraw[j];
            const float x0 = bflo(w.x), x1 = bfhi(w.x), x2 = bflo(w.y), x3 = bfhi(w.y), x4 = bflo(w.z), x5 = bfhi(w.z), x6 = bflo(w.w), x7 = bfhi(w.w);
            s += ((x0 + x1) + (x2 + x3)) + ((x4 + x5) + (x6 + x7));
            s2 += ((x0 * x0 + x1 * x1) + (x2 * x2 + x3 * x3)) + ((x4 * x4 + x5 * x5) + (x6 * x6 + x7 * x7));
        }
        s += __shfl_xor(s, 1); s += __shfl_xor(s, 2); s2 += __shfl_xor(s2, 1); s2 += __shfl_xor(s2, 2);
        const float mu = s * (1.f / 256.f);
        const float var = fmaxf(s2 * (1.f / 256.f) - mu * mu, 0.f);
        const float rs = rsqrtf(var + 1e-5f);
#pragma unroll
        for (int j = 0; j < 8; ++j) {
            const int ch = j * 32 + part * 8;
            const f32x4 g0 = *(const f32x4*)(p.ln_v_g + l * 256 + ch), g1 = *(const f32x4*)(p.ln_v_g + l * 256 + ch + 4);
            const f32x4 b0 = *(const f32x4*)(p.ln_v_b + l * 256 + ch), b1 = *(const f32x4*)(p.ln_v_b + l * 256 + ch + 4);
            const u32x4 w = vraw[j];
            u32x4 o;
            o.x = cvt_pk_bf16((bflo(w.x) - mu) * rs * g0[0] + b0[0], (bfhi(w.x) - mu) * rs * g0[1] + b0[1]);
            o.y = cvt_pk_bf16((bflo(w.y) - mu) * rs * g0[2] + b0[2], (bfhi(w.y) - mu) * rs * g0[3] + b0[3]);
            o.z = cvt_pk_bf16((bflo(w.z) - mu) * rs * g1[0] + b1[0], (bfhi(w.z) - mu) * rs * g1[1] + b1[1]);
            o.w = cvt_pk_bf16((bflo(w.w) - mu) * rs * g1[2] + b1[2], (bfhi(w.w) - mu) * rs * g1[3] + b1[3]);
            *(u32x4*)(vn + tok * VS2 + ch) = o;
        }
    }
    __syncthreads();
    {
        u32x2 uw[4][4], zw[4][4];
#pragma unroll
        for (int mm = 0; mm < 4; ++mm) {
            const size_t rowH = (size_t)(T0 + (ih * 4 + mm) * 16 + fr);
#pragma unroll
            for (int n = 0; n < 4; ++n) { const int ch = g * 64 + n * 16 + fq * 4; uw[mm][n] = *(const u32x2*)(H + hidx(rowH, C_UA + ch)); zw[mm][n] = *(const u32x2*)(H + hidx(rowH, C_ZA + ch)); }
        }
        f32x4 acc[4][4];
#pragma unroll
        for (int mm = 0; mm < 4; ++mm)
#pragma unroll
            for (int n = 0; n < 4; ++n) acc[mm][n] = (f32x4){0.f, 0.f, 0.f, 0.f};
#pragma unroll
        for (int ks = 0; ks < 4; ++ks) if (ks < nks) {
            bf16x8 af[4];
#pragma unroll
            for (int n = 0; n < 4; ++n) {
                const u16* vr = vn + (ks * 32 + fq * 8 + (fr >> 2)) * VS2 + g * 64 + n * 16 + 4 * (fr & 3);
                const s16x4 lo = tr_read4(vr), hi = tr_read4(vr + 4 * VS2);
                af[n] = __builtin_shufflevector(lo, hi, 0, 1, 2, 3, 4, 5, 6, 7);
            }
#pragma unroll
            for (int mm = 0; mm < 4; ++mm)
#pragma unroll
                for (int n = 0; n < 4; ++n) acc[mm][n] = MFMA16(af[n], wf[ks][mm], acc[mm][n]);
        }
#pragma unroll
        for (int mm = 0; mm < 4; ++mm) {
            const int i = (ih * 4 + mm) * 16 + fr;
            const float bias = p.b_s[(l * 4 + g) * 128 + i];
            const size_t rowM = (size_t)(T0 + i) * MIXW;
#pragma unroll
            for (int n = 0; n < 4; ++n) {
                const int ch = g * 64 + n * 16 + fq * 4;
                const u32x2 u2 = uw[mm][n], z2 = zw[mm][n];
                const f32x4 a = acc[mm][n];
                u32x2 w;
                w.x = cvt_pk_bf16((a[0] + bias) * bflo(u2.x) * bflo(z2.x), (a[1] + bias) * bfhi(u2.x) * bfhi(z2.x));
                w.y = cvt_pk_bf16((a[2] + bias) * bflo(u2.y) * bflo(z2.y), (a[3] + bias) * bfhi(u2.y) * bfhi(z2.y));
                *(u32x2*)(MIX + rowM + ch) = w;
            }
        }
    }
    __syncthreads();
}

DI void sgu_sample_unit(const Params& p, int l, int b) {
    unsigned char* ws = p.ws;
    const u16* H = (const u16*)(ws + WS_H); u16* MIX = (u16*)(ws + WS_MIX);
    float* vn = (float*)shm;
    const int tid = tid_opaque(), wid = __builtin_amdgcn_readfirstlane(tid >> 6), lane = tid & 63;
    const int T0 = NTOKP + b * 16;
    const f32x4 g = *(const f32x4*)(p.ln_v_g + l * 256 + lane * 4), bb = *(const f32x4*)(p.ln_v_b + l * 256 + lane * 4);
    for (int tt = 0; tt < 2; ++tt) {
        const int tok = wid * 2 + tt;
        const u32x2 w = *(const u32x2*)(H + hidx((size_t)(T0 + tok), C_VA + lane * 4));
        float x0 = bflo(w.x), x1 = bfhi(w.x), x2 = bflo(w.y), x3 = bfhi(w.y);
        const float mu = wave_sum((x0 + x1) + (x2 + x3)) * (1.f / 256.f);
        x0 -= mu; x1 -= mu; x2 -= mu; x3 -= mu;
        const float var = wave_sum((x0 * x0 + x1 * x1) + (x2 * x2 + x3 * x3)) * (1.f / 256.f);
        const float rs = rsqrtf(var + 1e-5f);
        f32x4 o; o[0] = x0 * rs * g[0] + bb[0]; o[1] = x1 * rs * g[1] + bb[1]; o[2] = x2 * rs * g[2] + bb[2]; o[3] = x3 * rs * g[3] + bb[3];
        *(f32x4*)(vn + tok * 256 + lane * 4) = o;
        *(f32x4*)(p.out + O_SV + ((size_t)(l * 16 + b) * 16 + tok) * 256 + lane * 4) = o;
    }
    __syncthreads();
    for (int e = 0; e < 8; ++e) {
        const int o = tid + 512 * e, i = o >> 8, ch = o & 255, g4 = ch >> 6;
        const float* wrow = p.w_s + ((size_t)(l * 4 + g4) * 128 + i) * 128;
        float s = p.b_s[(l * 4 + g4) * 128 + i];
        for (int j = 0; j < 16; ++j) s += wrow[j] * vn[j * 256 + ch];
        const size_t rowH = (size_t)(T0 + i);
        MIX[(size_t)(T0 + i) * MIXW + ch] = f2bf(s * bf2f(H[hidx(rowH, C_UA + ch)]) * bf2f(H[hidx(rowH, C_ZA + ch)]));
    }
    __syncthreads();
}

constexpr int HS = 72;
struct HgIn { u32x4 fb[4], q[4], v[4]; };
template <bool NEEDQ>
DI void hg_load(HgIn& x, const u16* __restrict__ H, int u, int hh, int half, int lane) {
    const int T0 = (u < NCH) ? u * 64 : NTOKP + (u - NCH) * 16, len = (u < NCH) ? 64 : 16;
#pragma unroll
    for (int i = 0; i < 4; ++i) {
        const int idx = half * 64 + lane + i * 128, j = idx >> 3, c8 = idx & 7;
        x.fb[i] = (u32x4){0u, 0u, 0u, 0u}; x.v[i] = (u32x4){0u, 0u, 0u, 0u}; x.q[i] = (u32x4){0u, 0u, 0u, 0u};
        if (j < len) {
            const size_t rr = (size_t)(T0 + j); const int cc = hh * 64 + c8 * 8;
            x.fb[i] = *(const u32x4*)(H + hidx(rr, C_FB + cc)); x.v[i] = *(const u32x4*)(H + hidx(rr, C_IB + cc));
            if (NEEDQ) x.q[i] = *(const u32x4*)(H + hidx(rr, C_QB + cc));
        }
    }
}
DI void hgrn_local_body(const Params& p, int l, int u, const HgIn& x) {
    unsigned char* ws = p.ws;
    u16* UT = (u16*)(ws + WS_UT); float* DEC = (float*)(ws + WS_DEC);
    const float* LB = (const float*)(ws + WS_LB) + l * 256;
    const int tid = tid_opaque(), wid = __builtin_amdgcn_readfirstlane(tid >> 6), lane = tid & 63, fr = lane & 15, fq = lane >> 4;
    const int hh = wid >> 1, half = wid & 1;
    const int len = (u < NCH) ? 64 : 16;
    u16* vN = (u16*)shm + hh * (3 * 64 * HS);
    u16* kT = vN + 64 * HS;
    u16* fN = kT + 64 * HS;
    float* tot = (float*)(shm + 4 * 3 * 64 * HS * 2);
#pragma unroll
    for (int i = 0; i < 4; ++i) { const int idx = half * 64 + lane + i * 128, j = idx >> 3, c8 = idx & 7; *(u32x4*)(vN + j * HS + c8 * 8) = x.v[i]; *(u32x4*)(fN + j * HS + c8 * 8) = x.fb[i]; }
    __syncthreads();
    const float lb = LB[hh * 64 + lane];
    float fg[32], kk[32];
    float own = 1.f;
#pragma unroll
    for (int jj = 0; jj < 32; ++jj) {
        const int j = half * 32 + jj;
        const float gv = h2f(fN[j * HS + lane]);
        const float kv = (gv >= 0.f) ? gv : 1.f + gv, fv = (gv >= 0.f) ? 1.f - gv : -gv;
        fg[jj] = fv; kk[jj] = kv; own *= fv;
    }
    tot[(hh * 2 + half) * 64 + lane] = own;
    __syncthreads();
    {
        const float other = tot[(hh * 2 + (1 - half)) * 64 + lane];
        float s = half ? 1.f : other;
        unsigned pk[16];
#pragma unroll
        for (int jj = 31; jj >= 0; jj -= 2) {
            const float k1 = kk[jj] * s; s *= fg[jj];
            const float k0 = kk[jj - 1] * s; s *= fg[jj - 1];
            pk[jj >> 1] = cvt_pk_bf16(k0, k1);
        }
        if (half == 0) { const float dk = s; if (u < NCH) DEC[((size_t)u * 4 + hh) * 64 + lane] = dk; else tot[512 + hh * 64 + lane] = dk; }
#pragma unroll
        for (int q = 0; q < 4; ++q) { u32x4 w = {pk[4 * q], pk[4 * q + 1], pk[4 * q + 2], pk[4 * q + 3]}; *(u32x4*)(kT + lane * HS + half * 32 + q * 8) = w; }
    }
    __syncthreads();
    {
        f32x4 acc[2][4];
#pragma unroll
        for (int a = 0; a < 2; ++a)
#pragma unroll
            for (int kt = 0; kt < 4; ++kt) acc[a][kt] = (f32x4){0.f, 0.f, 0.f, 0.f};
#pragma unroll
        for (int ks = 0; ks < 2; ++ks) {
            bf16x8 av[2], bk[4];
#pragma unroll
            for (int a = 0; a < 2; ++a) {
                const u16* vr = vN + (ks * 32 + fq * 8 + (fr >> 2)) * HS + (half * 2 + a) * 16 + 4 * (fr & 3);
                const s16x4 lo = tr_read4(vr), hi = tr_read4(vr + 4 * HS);
                av[a] = __builtin_shufflevector(lo, hi, 0, 1, 2, 3, 4, 5, 6, 7);
            }
#pragma unroll
            for (int kt = 0; kt < 4; ++kt) bk[kt] = *(const bf16x8*)(kT + (kt * 16 + fr) * HS + ks * 32 + fq * 8);
#pragma unroll
            for (int a = 0; a < 2; ++a)
#pragma unroll
                for (int kt = 0; kt < 4; ++kt) acc[a][kt] = MFMA16(bk[kt], av[a], acc[a][kt]);
        }
        if (u < NCH) {
            u16* dst = UT + ((size_t)u * 4 + hh) * 4096;
#pragma unroll
            for (int a = 0; a < 2; ++a)
#pragma unroll
                for (int kt = 0; kt < 4; ++kt) {
                    u32x2 w; w.x = cvt_pk_bf16(acc[a][kt][0], acc[a][kt][1]); w.y = cvt_pk_bf16(acc[a][kt][2], acc[a][kt][3]);
                    *(u32x2*)(dst + ((half * 2 + a) * 16 + fr) * 64 + kt * 16 + fq * 4) = w;
                }
        } else {
            const size_t so = ((size_t)(l * 16 + (u - NCH)) * 4 + hh) * 4096;
#pragma unroll
            for (int kt = 0; kt < 4; ++kt)
#pragma unroll
                for (int r = 0; r < 4; ++r) {
                    const int k = kt * 16 + fq * 4 + r;
                    const float dk = tot[512 + hh * 64 + k];
#pragma unroll
                    for (int a = 0; a < 2; ++a) {
                        const int v = (half * 2 + a) * 16 + fr;
                        p.out[O_HS + so + k * 64 + v] = p.state_hgrn[so + k * 64 + v] * dk + acc[a][kt][r];
                    }
                }
        }
    }
    __syncthreads();
}
DI void hgrn_local_run(const Params& p, int l, int u0, int n) {
    const u16* H = (const u16*)(p.ws + WS_H);
    const int tid = tid_opaque(), wid = __builtin_amdgcn_readfirstlane(tid >> 6), lane = tid & 63;
    const int hh = wid >> 1, half = wid & 1;
    HgIn cur; hg_load<false>(cur, H, u0, hh, half, lane);
#pragma unroll 1
    for (int i = 0; i < n; ++i) {
        HgIn nxt = cur;
        if (i + 1 < n) hg_load<false>(nxt, H, u0 + i + 1, hh, half, lane);
        hgrn_local_body(p, l, u0 + i, cur);
        cur = nxt;
    }
}

DI void hgrn_scan_phase(const Params& p, int l, int wgi, int nwg) {
    unsigned char* ws = p.ws;
    const u16* __restrict__ UT = (const u16*)(ws + WS_UT); const float* __restrict__ DEC = (const float*)(ws + WS_DEC);
    u16* __restrict__ SBUF = (u16*)(ws + WS_SB);
    const long gt = (long)wgi * 512 + tid_opaque(), nth = (long)nwg * 512;
    for (long item = gt; item < 128 * 4096; item += nth) {
        const int seq = (int)(item >> 12), e = (int)(item & 4095), k = e & 63, v = e >> 6;
        if (seq < 64) {
            const int b = seq >> 2, hh = seq & 3;
            float s = 0.f;
            for (int c0 = 0; c0 < 64; c0 += 16) {
                float uu[16], dd[16];
#pragma unroll
                for (int c = 0; c < 16; ++c) { const size_t ub = (size_t)(b * 64 + c0 + c) * 4 + hh; uu[c] = bf2f(UT[ub * 4096 + e]); dd[c] = DEC[ub * 64 + k]; }
#pragma unroll
                for (int c = 0; c < 16; ++c) { const size_t ub = (size_t)(b * 64 + c0 + c) * 4 + hh; SBUF[ub * 4096 + e] = f2bf(s); s = dd[c] * s + uu[c]; }
            }
            p.out[O_HP + ((size_t)(l * 16 + b) * 4 + hh) * 4096 + k * 64 + v] = s;
        } else {
            const int b = (seq - 64) >> 2, hh = seq & 3;
            const size_t ub = (size_t)(NCH + b) * 4 + hh;
            SBUF[ub * 4096 + e] = f2bf(p.state_hgrn[((size_t)(l * 16 + b) * 4 + hh) * 4096 + k * 64 + v]);
        }
    }
}

DI void hgrn_out_body(const Params& p, int l, int u, const HgIn& x) {
    unsigned char* ws = p.ws;
    const u16* H = (const u16*)(ws + WS_H); u16* MIX = (u16*)(ws + WS_MIX);
    const u16* SBUF = (const u16*)(ws + WS_SB);
    const float* LB = (const float*)(ws + WS_LB) + l * 256;
    const int tid = tid_opaque(), wid = __builtin_amdgcn_readfirstlane(tid >> 6), lane = tid & 63, fr = lane & 15, fq = lane >> 4;
    const int hh = wid >> 1, half = wid & 1;
    const int T0 = (u < NCH) ? u * 64 : NTOKP + (u - NCH) * 16, len = (u < NCH) ? 64 : 16;
    u16* vN = (u16*)shm + hh * (4 * 64 * HS);
    u16* kh = vN + 64 * HS;
    u16* qh = kh + 64 * HS;
    u16* qt = qh + 64 * HS;
    float* tot = (float*)(shm + 4 * 4 * 64 * HS * 2);
#pragma unroll
    for (int i = 0; i < 4; ++i) {
        const int idx = half * 64 + lane + i * 128, j = idx >> 3, c8 = idx & 7;
        *(u32x4*)(vN + j * HS + c8 * 8) = x.v[i]; *(u32x4*)(kh + j * HS + c8 * 8) = x.fb[i]; *(u32x4*)(qh + j * HS + c8 * 8) = x.q[i];
    }
    bf16x8 sfr[2][4];
    {
        const u16* Sg = SBUF + ((size_t)u * 4 + hh) * 4096;
#pragma unroll
        for (int ks = 0; ks < 2; ++ks)
#pragma unroll
            for (int vt = 0; vt < 4; ++vt) sfr[ks][vt] = *(const bf16x8*)(Sg + (vt * 16 + fr) * 64 + ks * 32 + fq * 8);
    }
    u32x2 zw[2][4];
#pragma unroll
    for (int ii = 0; ii < 2; ++ii) {
        const int i = min((half * 2 + ii) * 16 + fr, len - 1);
#pragma unroll
        for (int vt = 0; vt < 4; ++vt) zw[ii][vt] = *(const u32x2*)(H + hidx((size_t)(T0 + i), C_ZB + hh * 64 + vt * 16 + fq * 4));
    }
    __syncthreads();
    const float lb = LB[hh * 64 + lane];
    float fg[32], kk[32];
    float own = 1.f;
#pragma unroll
    for (int jj = 0; jj < 32; ++jj) {
        const int j = half * 32 + jj;
        const float gv = h2f(kh[j * HS + lane]);
        const float kv = (gv >= 0.f) ? gv : 1.f + gv, fv = (gv >= 0.f) ? 1.f - gv : -gv;
        own *= fv; fg[jj] = fv; kk[jj] = kv;
    }
    tot[(hh * 2 + half) * 64 + lane] = own;
    float qhv[32];
    if (half) {
        float D = 1.f;
#pragma unroll
        for (int jj = 0; jj < 32; ++jj) {
            const int j = 32 + jj;
            D *= fg[jj];
            const float qv = bf2f(qh[j * HS + lane]) * D;
            qhv[jj] = qv;
            kh[j * HS + lane] = f2bf(kk[jj] * __builtin_amdgcn_rcpf(D));
            qh[j * HS + lane] = f2bf(qv);
        }
    } else {
        float R = 1.f;
#pragma unroll
        for (int jj = 31; jj >= 0; --jj) {
            const int j = jj;
            const float qv = bf2f(qh[j * HS + lane]) * __builtin_amdgcn_rcpf(R);
            qhv[jj] = qv;
            kh[j * HS + lane] = f2bf(kk[jj] * R);
            qh[j * HS + lane] = f2bf(qv);
            R *= fg[jj];
        }
    }
    __syncthreads();
    {
        const float other = tot[(hh * 2 + (1 - half)) * 64 + lane];
        const float C = half ? other : own;
#pragma unroll
        for (int jj = 0; jj < 32; ++jj) { const int j = half * 32 + jj; qt[j * HS + lane] = f2bf(qhv[jj] * C); }
    }
    {
        f32x4 at[2][4];
#pragma unroll
        for (int ii = 0; ii < 2; ++ii)
#pragma unroll
            for (int jt = 0; jt < 4; ++jt) at[ii][jt] = (f32x4){0.f, 0.f, 0.f, 0.f};
#pragma unroll
        for (int ks = 0; ks < 2; ++ks) {
            bf16x8 bqf[2];
#pragma unroll
            for (int ii = 0; ii < 2; ++ii) bqf[ii] = *(const bf16x8*)(qh + ((half * 2 + ii) * 16 + fr) * HS + ks * 32 + fq * 8);
#pragma unroll
            for (int jt = 0; jt < 4; ++jt) if (jt <= half * 2 + 1) {
                const bf16x8 ak = *(const bf16x8*)(kh + (jt * 16 + fr) * HS + ks * 32 + fq * 8);
#pragma unroll
                for (int ii = 0; ii < 2; ++ii) at[ii][jt] = MFMA16(ak, bqf[ii], at[ii][jt]);
            }
        }
        bf16x8 pb[2][2];
#pragma unroll
        for (int ii = 0; ii < 2; ++ii) {
            const int i = (half * 2 + ii) * 16 + fr;
#pragma unroll
            for (int jt = 0; jt < 4; ++jt)
#pragma unroll
                for (int r = 0; r < 4; ++r) { const int j = jt * 16 + fq * 4 + r; if (j > i) at[ii][jt][r] = 0.f; }
#pragma unroll
            for (int s2 = 0; s2 < 2; ++s2) {
                u32x4 w;
                w.x = cvt_pk_bf16(at[ii][2 * s2][0], at[ii][2 * s2][1]); w.y = cvt_pk_bf16(at[ii][2 * s2][2], at[ii][2 * s2][3]);
                w.z = cvt_pk_bf16(at[ii][2 * s2 + 1][0], at[ii][2 * s2 + 1][1]); w.w = cvt_pk_bf16(at[ii][2 * s2 + 1][2], at[ii][2 * s2 + 1][3]);
                pb[ii][s2] = __builtin_bit_cast(bf16x8, w);
            }
        }
        f32x4 o[4][2];
#pragma unroll
        for (int vt = 0; vt < 4; ++vt) { o[vt][0] = (f32x4){0.f, 0.f, 0.f, 0.f}; o[vt][1] = (f32x4){0.f, 0.f, 0.f, 0.f}; }
#pragma unroll
        for (int s2 = 0; s2 < 2; ++s2) if (s2 <= half) {
#pragma unroll
            for (int vt = 0; vt < 4; ++vt) {
                const u16* vr = vN + (32 * s2 + 4 * fq + (fr >> 2)) * HS + vt * 16 + 4 * (fr & 3);
                const s16x4 lo = tr_read4(vr), hi = tr_read4(vr + 16 * HS);
                const bf16x8 a = __builtin_shufflevector(lo, hi, 0, 1, 2, 3, 4, 5, 6, 7);
                o[vt][0] = MFMA16(a, pb[0][s2], o[vt][0]); o[vt][1] = MFMA16(a, pb[1][s2], o[vt][1]);
            }
        }
        __syncthreads();
#pragma unroll
        for (int ks = 0; ks < 2; ++ks) {
            bf16x8 bqf[2];
#pragma unroll
            for (int ii = 0; ii < 2; ++ii) bqf[ii] = *(const bf16x8*)(qt + ((half * 2 + ii) * 16 + fr) * HS + ks * 32 + fq * 8);
#pragma unroll
            for (int vt = 0; vt < 4; ++vt) { o[vt][0] = MFMA16(sfr[ks][vt], bqf[0], o[vt][0]); o[vt][1] = MFMA16(sfr[ks][vt], bqf[1], o[vt][1]); }
        }
#pragma unroll
        for (int ii = 0; ii < 2; ++ii) {
            float ss = 0.f;
#pragma unroll
            for (int vt = 0; vt < 4; ++vt) { const f32x4 xx = o[vt][ii]; ss += (xx[0] * xx[0] + xx[1] * xx[1]) + (xx[2] * xx[2] + xx[3] * xx[3]); }
            ss += __shfl_xor(ss, 16); ss += __shfl_xor(ss, 32);
            const float rs = rsqrtf(ss * (1.f / 64.f) + 1e-6f);
            const int i = (half * 2 + ii) * 16 + fr;
            if (i < len) {
#pragma unroll
                for (int vt = 0; vt < 4; ++vt) {
                    const int v = vt * 16 + fq * 4;
                    const f32x4 gn = *(const f32x4*)(p.norm_b_g + l * 64 + v);
                    const u32x2 z2 = zw[ii][vt];
                    const f32x4 xx = o[vt][ii];
                    u32x2 w; w.x = cvt_pk_bf16(xx[0] * rs * gn[0] * bflo(z2.x), xx[1] * rs * gn[1] * bfhi(z2.x)); w.y = cvt_pk_bf16(xx[2] * rs * gn[2] * bflo(z2.y), xx[3] * rs * gn[3] * bfhi(z2.y));
                    *(u32x2*)(MIX + (size_t)(T0 + i) * MIXW + 256 + hh * 64 + v) = w;
                }
            }
        }
    }
}
DI void hgrn_out_run(const Params& p, int l, int u0, int n) {
    const u16* H = (const u16*)(p.ws + WS_H);
    const int tid = tid_opaque(), wid = __builtin_amdgcn_readfirstlane(tid >> 6), lane = tid & 63;
    const int hh = wid >> 1, half = wid & 1;
    HgIn cur; hg_load<true>(cur, H, u0, hh, half, lane);
#pragma unroll 1
    for (int i = 0; i < n; ++i) {
        HgIn nxt = cur;
        if (i + 1 < n) hg_load<true>(nxt, H, u0 + i + 1, hh, half, lane);
        hgrn_out_body(p, l, u0 + i, cur);
        cur = nxt;
    }
    __syncthreads();
}

DI void ln_phase(const Params& p, int l, int row0, int row1, int wgi, int nwg) {
    unsigned char* ws = p.ws;
    const u16* Z = (const u16*)(ws + WS_H);
    u16* XB = (u16*)(ws + WS_XB);
    const int tid = tid_opaque(), wid = __builtin_amdgcn_readfirstlane(tid >> 6), lane = tid & 63;
    f32x4 g[4], bb[4];
#pragma unroll
    for (int j = 0; j < 2; ++j) {
        g[2 * j] = *(const f32x4*)(p.ln_g + l * DM + lane * 8 + 512 * j); g[2 * j + 1] = *(const f32x4*)(p.ln_g + l * DM + lane * 8 + 512 * j + 4);
        bb[2 * j] = *(const f32x4*)(p.ln_b + l * DM + lane * 8 + 512 * j); bb[2 * j + 1] = *(const f32x4*)(p.ln_b + l * DM + lane * 8 + 512 * j + 4);
    }
    const int stride = nwg * 8;
    for (int rowa = row0 + wgi * 8 + wid; rowa < row1; rowa += 2 * stride) {
        const int rowb = rowa + stride;
        const bool hasb = rowb < row1;
        const u16* za = Z + (size_t)rowa * DM + lane * 8;
        const u16* zb = Z + (size_t)(hasb ? rowb : rowa) * DM + lane * 8;
        const u32x4 wa0 = *(const u32x4*)za, wa1 = *(const u32x4*)(za + 512), wb0 = *(const u32x4*)zb, wb1 = *(const u32x4*)(zb + 512);
#pragma unroll
        for (int rr = 0; rr < 2; ++rr) {
            if (rr == 1 && !hasb) break;
            const int row = rr ? rowb : rowa;
            const u32x4 w0 = rr ? wb0 : wa0, w1 = rr ? wb1 : wa1;
            f32x4 v[4];
            v[0] = (f32x4){bflo(w0.x), bfhi(w0.x), bflo(w0.y), bfhi(w0.y)}; v[1] = (f32x4){bflo(w0.z), bfhi(w0.z), bflo(w0.w), bfhi(w0.w)};
            v[2] = (f32x4){bflo(w1.x), bfhi(w1.x), bflo(w1.y), bfhi(w1.y)}; v[3] = (f32x4){bflo(w1.z), bfhi(w1.z), bflo(w1.w), bfhi(w1.w)};
            float s = 0.f;
#pragma unroll
            for (int j = 0; j < 4; ++j) s += (v[j][0] + v[j][1]) + (v[j][2] + v[j][3]);
            const float mu = wave_sum(s) * (1.f / DM);
            float s2 = 0.f;
#pragma unroll
            for (int j = 0; j < 4; ++j) { v[j] = v[j] - mu; s2 += (v[j][0] * v[j][0] + v[j][1] * v[j][1]) + (v[j][2] * v[j][2] + v[j][3] * v[j][3]); }
            const float rs = rsqrtf(wave_sum(s2) * (1.f / DM) + 1e-5f);
#pragma unroll
            for (int j = 0; j < 4; ++j) v[j] = v[j] * rs * g[j] + bb[j];
            if (l == 0) {
                u16* xr = XB + (size_t)row * DM + lane * 8;
#pragma unroll
                for (int j = 0; j < 2; ++j) {
                    u32x4 w; w.x = cvt_pk_bf16(v[2 * j][0], v[2 * j][1]); w.y = cvt_pk_bf16(v[2 * j][2], v[2 * j][3]); w.z = cvt_pk_bf16(v[2 * j + 1][0], v[2 * j + 1][1]); w.w = cvt_pk_bf16(v[2 * j + 1][2], v[2 * j + 1][3]);
                    *(u32x4*)(xr + 512 * j) = w;
                }
            } else {
                float* yr = p.out + (size_t)row * DM + lane * 8;
#pragma unroll
                for (int j = 0; j < 2; ++j) { __builtin_nontemporal_store(v[2 * j], (f32x4*)(yr + 512 * j)); __builtin_nontemporal_store(v[2 * j + 1], (f32x4*)(yr + 512 * j + 4)); }
            }
        }
    }
}

DI void phase_mix_a(const Params& p, int l) {
    unsigned char* ws = p.ws;
    const u16* H = (const u16*)(ws + WS_H); u16* MIX = (u16*)(ws + WS_MIX);
    constexpr int N_AT = 256, N_HL = NCH, N_SG = 512;
    const int G = gridDim.x;
    int w = blockIdx.x;
    for (; w < N_AT; w += G) attn_run(p, l, w);
    asm volatile("" ::: "memory");
    for (; w < N_AT + N_HL / 4; w += G) hgrn_local_run(p, l, (w - N_AT) * 4, 4);
    asm volatile("" ::: "memory");
    for (; w < N_AT + N_HL / 4 + N_SG; w += G) sgu_prompt_unit(p, l, w - N_AT - N_HL / 4);
}

DI void phase_mix_b(const Params& p, int l) {
    unsigned char* ws = p.ws;
    const u16* H = (const u16*)(ws + WS_H); u16* MIX = (u16*)(ws + WS_MIX);
    const u16* KVS = (const u16*)(ws + WS_KVS) + (size_t)l * 16 * 144 * 256;
    constexpr int N_HO = NCH / 4 + 16, N_HL = 16, N_AS = 32, N_SS = 16;
    const int G = gridDim.x;
    int w = blockIdx.x;
    for (; w < N_HO; w += G) { if (w < NCH / 4) hgrn_out_run(p, l, w * 4, 4); else hgrn_out_run(p, l, NCH + (w - NCH / 4), 1); }
    asm volatile("" ::: "memory");
    for (; w < N_HO + N_HL; w += G) hgrn_local_run(p, l, NCH + (w - N_HO), 1);
    asm volatile("" ::: "memory");
    for (; w < N_HO + N_HL + N_AS; w += G) {
        const int r = w - (N_HO + N_HL);
        const int g = r & 1, b = r >> 1;
        const size_t Tq = (size_t)NTOKP + b * 16;
        const u16* kv = KVS + (size_t)b * 144 * 256;
        attn_unit(H + hidx(Tq, C_QC + g * 256), 256, 16, kv + g * 64, kv + 128 + g * 64, 256, 144,
                  H + hidx(Tq, C_ZC + g * 256), 256, MIX + Tq * MIXW + 512 + g * 256, MIXW, p.sinks + l * 8 + g * 4);
    }
    asm volatile("" ::: "memory");
    for (; w < N_HO + N_HL + N_AS + N_SS; w += G) sgu_sample_unit(p, l, w - (N_HO + N_HL + N_AS));
}

__global__ void __launch_bounds__(512, 2) fwd_megakernel(Params p) {
    cg::grid_group grid = cg::this_grid();
    unsigned char* ws = p.ws;
    volatile LAS unsigned* st = (volatile LAS unsigned*)((LAS unsigned char*)shm + (LDS_BYTES - 16));
    if (threadIdx.x == 0) { st[0] = 0u; st[1] = 0u; }
    __syncthreads();
    XcdBarrier xb = xcd_barrier_post((unsigned*)(ws + WS_BAR), st);
    for (int rep = 0; rep < REP_PRO; ++rep) { phase_prologue(p); if (rep + 1 < REP_PRO) xcd_barrier(xb); }
    grid.sync();
    const int G = gridDim.x, wg = blockIdx.x;
#pragma unroll 1
    for (int l = 0; l < 2; ++l) {
#pragma unroll 1
        for (int rep = 0; rep < REP_G1; ++rep) {
            EpiIn e; e.ws = ws; e.out = p.out; e.l = l;
            #ifndef G1_WGM
#define G1_WGM 8
#endif
            StaticOrder so; so.init(NTOKP / BM, INW / BM, G, wg, 0, G1_WGM);
            gemm_phase((const u16*)(ws + WS_XB), (const u16*)(ws + WS_WTIN) + (size_t)l * INW * DM, so, e);
            xcd_barrier(xb);
        }
#pragma unroll 1
        for (int rep = 0; rep < REP_MIXA; ++rep) { phase_mix_a(p, l); xcd_barrier(xb); }
#pragma unroll 1
        for (int rep = 0; rep < REP_SCAN; ++rep) {
            if (wg < 12) {
                EpiIn e; e.ws = ws; e.out = p.out; e.l = l;
                StaticOrder so; so.init(1, INW / BM, 12, wg, NTOKP / BM);
                gemm_phase((const u16*)(ws + WS_XB), (const u16*)(ws + WS_WTIN) + (size_t)l * INW * DM, so, e);
            } else hgrn_scan_phase(p, l, wg - 12, G - 12);
            xcd_barrier(xb);
        }
#pragma unroll 1
        for (int rep = 0; rep < REP_HOUT; ++rep) { phase_mix_b(p, l); xcd_barrier(xb); }
#pragma unroll 1
        for (int rep = 0; rep < REP_G2; ++rep) {
            EpiOut e; e.ws = ws;
            StaticOrder so; so.init(NTOKP / BM, DM / BM, G, wg, 0);
            gemm_phase((const u16*)(ws + WS_MIX), (const u16*)(ws + WS_WTOUT) + (size_t)l * DM * MIXW, so, e);
            xcd_barrier(xb);
        }
#pragma unroll 1
        for (int rep = 0; rep < REP_LN; ++rep) {
            if (wg < 4) {
                EpiOut e; e.ws = ws;
                StaticOrder so; so.init(1, DM / BM, 4, wg, NTOKP / BM);
                gemm_phase((const u16*)(ws + WS_MIX), (const u16*)(ws + WS_WTOUT) + (size_t)l * DM * MIXW, so, e);
            } else ln_phase(p, l, 0, NTOKP, wg - 4, G - 4);
            xcd_barrier(xb);
        }
        if (wg < 32) ln_phase(p, l, NTOKP, MTOT, wg, 32);
    }
}


extern "C" void kernel_launch(void* const* d_in, const int* in_sizes, int n_in, void* d_out, int out_size, void* d_ws, size_t ws_size, hipStream_t stream) {
    static int grid_blocks = 0;
    if (!grid_blocks) {
        int dev = 0, cus = 0, per_cu = 0;
        (void)hipGetDevice(&dev);
        (void)hipDeviceGetAttribute(&cus, hipDeviceAttributeMultiprocessorCount, dev);
        (void)hipFuncSetAttribute((const void*)fwd_megakernel, hipFuncAttributeMaxDynamicSharedMemorySize, LDS_BYTES);
        (void)hipOccupancyMaxActiveBlocksPerMultiprocessor(&per_cu, (const void*)fwd_megakernel, 512, LDS_BYTES);
        if (per_cu < 1) { fprintf(stderr, "occupancy query returned %d\n", per_cu); per_cu = 1; }
        grid_blocks = cus * per_cu;
        if (ws_size < WS_END) fprintf(stderr, "workspace too small: %zu < %zu\n", ws_size, (size_t)WS_END);
    }
    Params p{};
    p.x_prompt = (const float*)d_in[0]; p.x_sample = (const float*)d_in[1]; p.cache_k = (const float*)d_in[2]; p.cache_v = (const float*)d_in[3];
    p.state_hgrn = (const float*)d_in[4]; p.w_in = (const float*)d_in[5]; p.ln_v_g = (const float*)d_in[6]; p.ln_v_b = (const float*)d_in[7];
    p.w_s = (const float*)d_in[8]; p.b_s = (const float*)d_in[9]; p.lb_param = (const float*)d_in[10]; p.norm_b_g = (const float*)d_in[11];
    p.sinks = (const float*)d_in[12]; p.w_out = (const float*)d_in[13]; p.ln_g = (const float*)d_in[14]; p.ln_b = (const float*)d_in[15];
    p.out = (float*)d_out; p.ws = (unsigned char*)d_ws;
    for (int i = 0; i < 8; ++i) p.inv[i] = powf(500000.0f, -(float)(2 * i) / 16.0f);
    (void)hipMemsetAsync((unsigned char*)d_ws + WS_BAR, 0, 16384, stream);
    void* args[] = {&p};
    hipError_t e = hipLaunchCooperativeKernel((const void*)fwd_megakernel, dim3(grid_blocks), dim3(512), args, LDS_BYTES, stream);
    if (e != hipSuccess) fprintf(stderr, "cooperative launch failed: %s (grid %d)\n", hipGetErrorString(e), grid_blocks);
}
```

```cpp
#include <hip/hip_runtime.h>
#include <hip/hip_cooperative_groups.h>
#ifndef REP_PRO
#define REP_PRO 1
#endif
#ifndef REP_G1
#define REP_G1 1
#endif
#ifndef REP_MIXA
#define REP_MIXA 1
#endif
#ifndef REP_SCAN
#define REP_SCAN 1
#endif
#ifndef REP_HOUT
#define REP_HOUT 1
#endif
#ifndef REP_G2
#define REP_G2 1
#endif
#ifndef REP_LN
#define REP_LN 1
#endif
#include <cstdio>
#include <cmath>
namespace cg = cooperative_groups;

typedef unsigned short u16;
typedef short bf16x8 __attribute__((ext_vector_type(8)));
typedef short s16x4 __attribute__((ext_vector_type(4)));
typedef float f32x4 __attribute__((ext_vector_type(4)));
typedef unsigned u32x2 __attribute__((ext_vector_type(2)));
typedef unsigned u32x4 __attribute__((ext_vector_type(4)));
#define DI __device__ __forceinline__

constexpr int DM = 1024, NB = 16, SEQ = 4096, NTOKP = NB * SEQ, NTOKS = 256, MTOT = NTOKP + NTOKS;
constexpr int INW = 3072, MIXW = 1024;
constexpr int NCH = 1024, NUNIT = NCH + 16;
constexpr float ALPHA = 1.41421356237309515f;
constexpr int LDS_BYTES = 155648;

constexpr int C_UA = 0, C_VA = 256, C_ZA = 512, C_QB = 768, C_FB = 1024, C_IB = 1280, C_ZB = 1536, C_QC = 1792, C_KC = 2304, C_VC = 2432, C_ZC = 2560;

constexpr size_t WS_WTIN = 0;
constexpr size_t WS_WTOUT = WS_WTIN + 2ull * INW * DM * 2;
constexpr size_t WS_XB = WS_WTOUT + 2ull * DM * DM * 2;
constexpr size_t WS_H = WS_XB + (size_t)MTOT * DM * 2;
constexpr size_t WS_MIX = WS_H + (size_t)MTOT * INW * 2;
constexpr size_t WS_UT = WS_MIX + (size_t)MTOT * MIXW * 2;
constexpr size_t WS_SB = WS_UT + (size_t)NUNIT * 4 * 4096 * 4;
constexpr size_t WS_DEC = WS_SB + (size_t)NUNIT * 4 * 4096 * 2;
constexpr size_t WS_WSB = WS_DEC + (size_t)NUNIT * 4 * 64 * 4;
constexpr size_t WS_RT = WS_WSB + 2ull * 4 * 128 * 128 * 2;
constexpr size_t WS_KVS = WS_RT + 4112ull * 8 * 8;
constexpr size_t WS_LB = WS_KVS + 2ull * 16 * 144 * 256 * 2;
constexpr size_t WS_BAR = WS_LB + 2ull * 256 * 4;
constexpr size_t WS_END = WS_BAR + 16384;

constexpr size_t O_YP = 0;
constexpr size_t O_YS = O_YP + (size_t)NTOKP * DM;
constexpr size_t O_KP = O_YS + (size_t)NTOKS * DM;
constexpr size_t O_VP = O_KP + 2ull * 16 * 128 * 128;
constexpr size_t O_HP = O_VP + 2ull * 16 * 128 * 128;
constexpr size_t O_KS = O_HP + 2ull * 16 * 4 * 4096;
constexpr size_t O_VS = O_KS + 2ull * 16 * 16 * 128;
constexpr size_t O_HS = O_VS + 2ull * 16 * 16 * 128;
constexpr size_t O_SV = O_HS + 2ull * 16 * 4 * 4096;

struct Params {
    const float* x_prompt; const float* x_sample; const float* cache_k; const float* cache_v; const float* state_hgrn;
    const float* w_in; const float* ln_v_g; const float* ln_v_b; const float* w_s; const float* b_s; const float* lb_param;
    const float* norm_b_g; const float* sinks; const float* w_out; const float* ln_g; const float* ln_b;
    float* out; unsigned char* ws;
    float inv[8];
};

extern __shared__ __attribute__((aligned(16))) unsigned char shm[];

DI unsigned cvt_pk_bf16(float lo, float hi) { unsigned r; asm volatile("v_cvt_pk_bf16_f32 %0, %1, %2" : "=v"(r) : "v"(lo), "v"(hi)); return r; }
DI u16 f2bf(float x) { return (u16)(cvt_pk_bf16(x, 0.f) & 0xffffu); }
DI float bf2f(u16 v) { return __uint_as_float(((unsigned)v) << 16); }
DI unsigned f2h(float x) { return (unsigned)__builtin_bit_cast(u16, (_Float16)x); }
DI float h2f(u16 b) { return (float)__builtin_bit_cast(_Float16, b); }
DI float bflo(unsigned w) { return __uint_as_float(w << 16); }
DI float bfhi(unsigned w) { return __uint_as_float(w & 0xffff0000u); }
DI float silu_f(float x) { return x * __builtin_amdgcn_rcpf(1.f + __expf(-x)); }
DI float wave_sum(float v) {
#pragma unroll
    for (int o = 1; o < 64; o <<= 1) v += __shfl_xor(v, o);
    return v;
}
DI int tid_opaque() { int t = threadIdx.x; asm volatile("" : "+v"(t)); return t; }
DI s16x4 tr_read4(const u16* p) { return __builtin_amdgcn_ds_read_tr16_b64_v4i16((__attribute__((address_space(3))) s16x4*)p); }
#define MFMA16(a, b, c) __builtin_amdgcn_mfma_f32_16x16x32_bf16((a), (b), (c), 0, 0, 0)


#define XB_TMO      128
#define XB_XCNT(j)  (256  + 64 * (j))
#define XB_XSUB(j)  (1280 + 64 * (j))
#define XB_XGEN(j)  (2304 + 64 * (j))
#define XB_TOP      3328
#define XB_TOPGEN   3392
#define XCD_BAR_WORDS 3456
#define XB_SPIN_CAP (1u << 22)
#define LAS __attribute__((address_space(3)))
DI unsigned xb_ld(unsigned* p) { return __hip_atomic_load(p, __ATOMIC_RELAXED, __HIP_MEMORY_SCOPE_AGENT); }
DI unsigned xb_add(unsigned* p, unsigned v) { return __hip_atomic_fetch_add(p, v, __ATOMIC_RELAXED, __HIP_MEMORY_SCOPE_AGENT); }
DI unsigned xb_xcc_id() { return (unsigned)__builtin_amdgcn_s_getreg((3 << 11) | 20) & 0xFu; }
#define XB_SPIN(cond, bar) do { unsigned _sp = 0; while (cond) { __builtin_amdgcn_s_sleep(1); \
    if ((++_sp & 255u) == 0u) { if (xb_ld(&(bar)[XB_TMO])) break; if (_sp > XB_SPIN_CAP) { atomicAdd(&(bar)[XB_TMO], 1u); break; } } } } while (0)
struct XcdBarrier { unsigned* bar; unsigned x; volatile LAS unsigned* st; };
DI XcdBarrier xcd_barrier_post(unsigned* bar, volatile LAS unsigned* st) {
    XcdBarrier b; b.bar = bar; b.x = xb_xcc_id(); b.st = st;
    if (threadIdx.x == 0) (void)xb_add(&bar[XB_XCNT(b.x)], 1u);
    return b;
}
DI void xcd_barrier_complete(unsigned* bar, unsigned x, unsigned& nloc, unsigned& nx) {
    const unsigned G = gridDim.x * gridDim.y * gridDim.z;
    unsigned sum, cnt, mine, sp = 0u;
    for (;;) {
        sum = 0u; cnt = 0u; mine = 0u;
#pragma unroll
        for (unsigned j = 0; j < 16; ++j) { const unsigned c = xb_ld(&bar[XB_XCNT(j)]); sum += c; cnt += (c > 0u) ? 1u : 0u; mine = (j == x) ? c : mine; }
        if (sum == G) break;
        __builtin_amdgcn_s_sleep(1);
        if ((++sp & 255u) == 0u) { if (xb_ld(&bar[XB_TMO])) break; if (sp > XB_SPIN_CAP) { atomicAdd(&bar[XB_TMO], 1u); break; } }
    }
    nloc = mine > 0u ? mine : 1u; nx = cnt > 0u ? cnt : 1u;
}
DI void xcd_barrier(const XcdBarrier& b) {
    asm volatile("s_waitcnt vmcnt(0)" ::: "memory");
    __syncthreads();
    if (threadIdx.x == 0) {
        unsigned* bar = b.bar;
        __builtin_amdgcn_s_waitcnt(0);
        unsigned nloc = b.st[0], nx = b.st[1];
        if (nloc == 0u) { xcd_barrier_complete(bar, b.x, nloc, nx); b.st[0] = nloc; b.st[1] = nx; }
        const unsigned old = xb_add(&bar[XB_XSUB(b.x)], 1u);
        const unsigned gen = old / nloc;
        if (old + 1u == (gen + 1u) * nloc) {
            __builtin_amdgcn_fence(__ATOMIC_RELEASE, "agent");
            asm volatile("s_waitcnt vmcnt(0)" ::: "memory");
            const unsigned og = xb_add(&bar[XB_TOP], 1u);
            const unsigned tg = og / nx;
            if (og + 1u == (tg + 1u) * nx) xb_add(&bar[XB_TOPGEN], 1u);
            else XB_SPIN(xb_ld(&bar[XB_TOPGEN]) == tg, bar);
            __builtin_amdgcn_fence(__ATOMIC_ACQUIRE, "agent");
            xb_add(&bar[XB_XGEN(b.x)], 1u);
            asm volatile("s_waitcnt vmcnt(0)" ::: "memory");
        } else {
            XB_SPIN(xb_ld(&bar[XB_XGEN(b.x)]) == gen, bar);
            __builtin_amdgcn_fence(__ATOMIC_ACQUIRE, "agent");
            asm volatile("s_waitcnt vmcnt(0)" ::: "memory");
        }
    }
    __syncthreads();
}

constexpr int BM = 256, BK = 64, HALF = 128, NXCD = 8, WGM = 8, HT = HALF * BK;
DI int lds_byte(int r, int c) { int st = (r >> 4) * 2 + (c >> 5), rr = r & 15, cc = c & 31, ob = rr * 64 + cc * 2; return st * 1024 + (ob ^ (((ob >> 9) & 1) << 5)); }
DI void stage_rc(int b, int& R, int& C) { int st = b / 1024, sb = b % 1024, swz = sb ^ (((sb >> 9) & 1) << 5); R = (st >> 1) * 16 + swz / 64; C = (st & 1) * 32 + (swz % 64) / 2; }

DI int perm32(int rho) { const int n = rho >> 4, i = rho & 15; return 8 * (i >> 2) + 4 * n + (i & 3); }
struct Unit { int pm, pn; };
struct StaticOrder {
    int nM, nN, nwg, G, c, pm0, wgm;
    DI void init(int nM_, int nN_, int G_, int c_, int pm0_, int wgm_ = WGM) { nM = nM_; nN = nN_; nwg = nM * nN; G = G_; c = c_; pm0 = pm0_; wgm = wgm_; }
    DI bool next(int i, Unit& u) const {
        const long L = (long)i * G + c; if (c >= G || L >= nwg) return false;
        int wgid = (int)L; { const int q = nwg / NXCD, r = nwg % NXCD, xcd = wgid % NXCD, off = wgid / NXCD; wgid = (xcd < r ? xcd * (q + 1) : r * (q + 1) + (xcd - r) * q) + off; }
        const int nig = wgm * nN, gid = wgid / nig, fm = gid * wgm, gsz = (nM - fm) < wgm ? (nM - fm) : wgm;
        u.pm = pm0 + fm + ((wgid % nig) % gsz); u.pn = (wgid % nig) / gsz; return true;
    }
};
template <class Epi, class Sched>
DI void gemm_phase(const u16* __restrict__ A, const u16* __restrict__ Bt, const Sched& S, const Epi& E) {
    LAS unsigned char* lds = (LAS unsigned char*)shm;
    constexpr int K = 1024, nt = K / BK, HTB = HT * 2;
    const int tid = tid_opaque(), wid = __builtin_amdgcn_readfirstlane(tid >> 6), lane = tid & 63, wr = wid >> 2, wc = wid & 3, fr = lane & 15, fq = lane >> 4;
    unsigned voffA[2], voffB[2];
#pragma unroll
    for (int i = 0; i < 2; ++i) { int R, C; stage_rc(tid * 16 + i * 8192, R, C); const int Rb = (R & ~31) + perm32(R & 31);
        voffA[i] = (unsigned)(R * K + C) * 2u; voffB[i] = (unsigned)(Rb * K + C) * 2u; }
    const size_t kstep = (size_t)(BK * 2), hstep = (size_t)HALF * K * 2, tstep = 2 * hstep;
    const unsigned ldsw = (unsigned)wid * 1024u;
    const int aoff = lds_byte(wr * 64 + fr, fq * 8), boff = lds_byte(wc * 32 + fr, fq * 8);
#define SA(b, h) (((b) * 2 + (h)) * HTB)
#define SB(b, h) ((4 + (b) * 2 + (h)) * HTB)
#define STAGE(bufoff, gbase, voff) do { _Pragma("unroll") for (int _i = 0; _i < 2; ++_i) \
    __builtin_amdgcn_global_load_lds((const unsigned*)((const char*)(gbase) + (voff)[_i]), (LAS unsigned*)(lds + (bufoff) + ldsw + _i * 8192), 16, 0, 0); } while (0)
#define LDA(dst, b, h) do { _Pragma("unroll") for (int m = 0; m < 4; ++m) _Pragma("unroll") for (int k = 0; k < 2; ++k) dst[m][k] = *(const LAS bf16x8*)(lds + SA(b, h) + aoff + m * 2048 + k * 1024); } while (0)
#define LDB(dst, b, h) do { _Pragma("unroll") for (int n = 0; n < 2; ++n) _Pragma("unroll") for (int k = 0; k < 2; ++k) dst[n][k] = *(const LAS bf16x8*)(lds + SB(b, h) + boff + n * 2048 + k * 1024); } while (0)
#define MMA(ai, bj, At, Bt_) do { __builtin_amdgcn_s_setprio(1); _Pragma("unroll") for (int m = 0; m < 4; ++m) _Pragma("unroll") for (int n = 0; n < 2; ++n) _Pragma("unroll") for (int k = 0; k < 2; ++k) \
      acc[ai][bj][m][n] = MFMA16(Bt_[n][k], At[m][k], acc[ai][bj][m][n]); \
    __builtin_amdgcn_s_setprio(0); } while (0)
#define WAIT_V(n) asm volatile("s_waitcnt vmcnt(" #n ")" ::: "memory")
#define WAIT_L(n) asm volatile("s_waitcnt lgkmcnt(" #n ")" ::: "memory")
#define BAR __builtin_amdgcn_s_barrier()
#define SCHED __builtin_amdgcn_sched_barrier(0)
    Unit cur, nxt; int ui = 0;
    if (!S.next(0, cur)) return;
    f32x4 acc[2][2][4][2];
#pragma unroll
    for (int a = 0; a < 2; ++a)
#pragma unroll
        for (int b = 0; b < 2; ++b)
#pragma unroll
            for (int m = 0; m < 4; ++m)
#pragma unroll
                for (int n = 0; n < 2; ++n) acc[a][b][m][n] = (f32x4){0.f, 0.f, 0.f, 0.f};
    bf16x8 At[4][2], B0[2][2], B1[2][2];
    const char* cA = (const char*)A + (size_t)cur.pm * tstep; const char* cB = (const char*)Bt + (size_t)cur.pn * tstep;
    STAGE(SB(0, 0), cB, voffB); STAGE(SB(0, 1), cB + hstep, voffB); STAGE(SA(0, 0), cA, voffA); STAGE(SA(0, 1), cA + hstep, voffA);
    if (wr == 1) BAR;
    WAIT_V(2); BAR;
    STAGE(SB(1, 0), cB + kstep, voffB); STAGE(SA(1, 0), cA + kstep, voffA); STAGE(SB(1, 1), cB + hstep + kstep, voffB);
    WAIT_V(6); BAR;
    for (;;) {
        const bool has_next = S.next(ui + 1, nxt);
        const char* nA = has_next ? (const char*)A + (size_t)nxt.pm * tstep : cA; const char* nB = has_next ? (const char*)Bt + (size_t)nxt.pn * tstep : cB;
        for (int t = 0; t < nt; t += 2) {
            const bool last = (t == nt - 2);
            const char* a1 = cA + (size_t)(t + 1) * kstep;
            const char* a2 = last ? nA : cA + (size_t)(t + 2) * kstep; const char* b2 = last ? nB : cB + (size_t)(t + 2) * kstep;
            const char* a3 = a2 + kstep; const char* b3 = b2 + kstep;
            LDB(B0, 0, 0); LDB(B1, 0, 1); SCHED; LDA(At, 0, 0); STAGE(SA(1, 1), a1 + hstep, voffA);
            WAIT_V(8); WAIT_L(0); BAR; MMA(0, 0, At, B0); MMA(0, 1, At, B1); BAR; SCHED;
            LDA(At, 0, 1); STAGE(SB(0, 0), b2, voffB); STAGE(SB(0, 1), b2 + hstep, voffB); STAGE(SA(0, 0), a2, voffA);
            WAIT_V(8); WAIT_L(0); BAR; MMA(1, 0, At, B0); MMA(1, 1, At, B1); BAR; SCHED;
            LDB(B0, 1, 0); LDB(B1, 1, 1); SCHED; LDA(At, 1, 0); STAGE(SA(0, 1), a2 + hstep, voffA);
            WAIT_V(8); WAIT_L(0); BAR; MMA(0, 0, At, B0); MMA(0, 1, At, B1); BAR; SCHED;
            LDA(At, 1, 1); STAGE(SB(1, 0), b3, voffB); STAGE(SB(1, 1), b3 + hstep, voffB); STAGE(SA(1, 0), a3, voffA);
            WAIT_V(8); WAIT_L(0); BAR; MMA(1, 0, At, B0); MMA(1, 1, At, B1); BAR; SCHED;
        }
        if (wr == 0) BAR;
        E(acc, cur.pm * BM, cur.pn * BM, wr, wc, fr, fq);
        if (!has_next) break;
#pragma unroll
        for (int a = 0; a < 2; ++a)
#pragma unroll
            for (int b = 0; b < 2; ++b)
#pragma unroll
                for (int m = 0; m < 4; ++m)
#pragma unroll
                    for (int n = 0; n < 2; ++n) acc[a][b][m][n] = (f32x4){0.f, 0.f, 0.f, 0.f};
        cur = nxt; cA = nA; cB = nB; ++ui;
        if (wr == 1) BAR;
    }
    WAIT_V(0);
    BAR;
    __syncthreads();
#undef SA
#undef SB
#undef STAGE
#undef LDA
#undef LDB
#undef MMA
}

struct EpiIn {
    unsigned char* ws; float* out; int l;
    DI void operator()(const f32x4 (&acc)[2][2][4][2], int brow, int bcol, int wr, int wc, int fr, int fq) const {
        int ll = l; asm volatile("" : "+s"(ll));
        u16* H = (u16*)(ws + WS_H); const float* RT = (const float*)(ws + WS_RT);
        float* okp = out + O_KP + (size_t)ll * 16 * 128 * 128; float* ovp = out + O_VP + (size_t)ll * 16 * 128 * 128;
        float* oks = out + O_KS + (size_t)ll * 16 * 16 * 128; float* ovs = out + O_VS + (size_t)ll * 16 * 16 * 128;
        u16* KVS = (u16*)(ws + WS_KVS) + (size_t)ll * 16 * 144 * 256;
        int type[2];
#pragma unroll
        for (int bj = 0; bj < 2; ++bj) {
            const int cb = bcol + bj * HALF; int ty;
            if (cb < C_ZA) ty = 0; else if (cb < C_FB) ty = 1; else if (cb < C_IB) ty = 5; else if (cb < C_ZB) ty = 0; else if (cb < C_QC) ty = 1;
            else if (cb < C_KC) ty = 2; else if (cb == C_KC) ty = 3; else if (cb == C_VC) ty = 4; else ty = 1;
            type[bj] = ty;
        }
        const int cin = wc * 32 + fq * 8;
        f32x4 lbv[2][2];
#pragma unroll
        for (int bj = 0; bj < 2; ++bj) {
            lbv[bj][0] = (f32x4){0.f, 0.f, 0.f, 0.f}; lbv[bj][1] = (f32x4){0.f, 0.f, 0.f, 0.f};
            if (type[bj] == 5) { const float* lbp = (const float*)(ws + WS_LB) + ll * 256 + (bcol + bj * HALF - C_FB) + cin; lbv[bj][0] = *(const f32x4*)lbp; lbv[bj][1] = *(const f32x4*)(lbp + 4); }
        }
#pragma unroll
        for (int ai = 0; ai < 2; ++ai)
#pragma unroll
            for (int m = 0; m < 4; ++m) {
                const int row = brow + ai * HALF + wr * 64 + m * 16 + fr;
                int posidx, kvo = -1; float* ko = nullptr; float* vo = nullptr; u16* kvs = nullptr;
                if (row < NTOKP) { const int b = row >> 12, t = row & 4095; posidx = t;
                    if (t >= SEQ - 128) { kvo = (b * 128 + (t - (SEQ - 128))) * 128; ko = okp; vo = ovp; } }
                else { const int s = row - NTOKP, sb = s >> 4, st = s & 15; posidx = 4096 + st; kvo = (sb * 16 + st) * 128; ko = oks; vo = ovs; kvs = KVS + (size_t)(sb * 144 + 128 + st) * 256; }
                u16* hrow = H + (size_t)row * INW;
#pragma unroll
                for (int bj = 0; bj < 2; ++bj) {
                    const int cb = bcol + bj * HALF, ty = type[bj];
                    f32x4 v0 = acc[ai][bj][m][0], v1 = acc[ai][bj][m][1];
                    if (ty == 1) {
#pragma unroll
                        for (int j = 0; j < 4; ++j) { v0[j] = silu_f(v0[j]); v1[j] = silu_f(v1[j]); }
                    } else if (ty == 5) {
                        const f32x4 l0 = lbv[bj][0], l1 = lbv[bj][1];
#pragma unroll
                        for (int j = 0; j < 4; ++j) {
                            const float t0 = __expf(-v0[j]), t1 = __expf(-v1[j]);
                            const float s0 = __builtin_amdgcn_rcpf(1.f + t0), s1 = __builtin_amdgcn_rcpf(1.f + t1);
                            const float k0 = (1.f - l0[j]) * t0 * s0, k1 = (1.f - l1[j]) * t1 * s1;
                            const float f0 = l0[j] + (1.f - l0[j]) * s0, f1 = l1[j] + (1.f - l1[j]) * s1;
                            v0[j] = (k0 <= 0.5f) ? k0 : -f0; v1[j] = (k1 <= 0.5f) ? k1 : -f1;
                        }
                    } else if (ty == 2 || ty == 3) {
                        if ((wc & 1) == 0) {
                            const f32x4 c0 = *(const f32x4*)(RT + (size_t)posidx * 16), c1 = *(const f32x4*)(RT + (size_t)posidx * 16 + 4), c2 = *(const f32x4*)(RT + (size_t)posidx * 16 + 8), c3 = *(const f32x4*)(RT + (size_t)posidx * 16 + 12);
                            const float cs[8] = {c0[0], c0[2], c1[0], c1[2], c2[0], c2[2], c3[0], c3[2]}, sn[8] = {c0[1], c0[3], c1[1], c1[3], c2[1], c2[3], c3[1], c3[3]};
#pragma unroll
                            for (int e = 0; e < 8; ++e) {
                                const float mine = (e < 4) ? v0[e & 3] : v1[e & 3];
                                const float pv = __shfl_xor(mine, 16);
                                const float rot = (fq == 0) ? (mine * cs[e] - pv * sn[e]) : (mine * cs[e] + pv * sn[e]);
                                const float res = (fq < 2) ? rot : mine;
                                if (e < 4) v0[e & 3] = res; else v1[e & 3] = res;
                            }
                        }
                        if (ty == 3) { if (kvo >= 0) { *(f32x4*)(ko + kvo + cin) = v0; *(f32x4*)(ko + kvo + cin + 4) = v1; } }
                        else { v0 = v0 * 0.18033688011112042f; v1 = v1 * 0.18033688011112042f; }
                    } else if (ty == 4) { if (kvo >= 0) { *(f32x4*)(vo + kvo + cin) = v0; *(f32x4*)(vo + kvo + cin + 4) = v1; } }
                    u32x4 w; w.x = cvt_pk_bf16(v0[0], v0[1]); w.y = cvt_pk_bf16(v0[2], v0[3]); w.z = cvt_pk_bf16(v1[0], v1[1]); w.w = cvt_pk_bf16(v1[2], v1[3]);
                    if (ty == 5) {
                        w.x = f2h(v0[0]) | (f2h(v0[1]) << 16); w.y = f2h(v0[2]) | (f2h(v0[3]) << 16); w.z = f2h(v1[0]) | (f2h(v1[1]) << 16); w.w = f2h(v1[2]) | (f2h(v1[3]) << 16);
                    }
                    __builtin_nontemporal_store(w, (u32x4*)(hrow + cb + cin));
                    if ((ty == 3 || ty == 4) && kvs) *(u32x4*)(kvs + (cb + cin - C_KC)) = w;
                }
                asm volatile("" ::: "memory");
            }
    }
};
struct EpiOut {
    unsigned char* ws;
    DI void operator()(const f32x4 (&acc)[2][2][4][2], int brow, int bcol, int wr, int wc, int fr, int fq) const {
        size_t zo = WS_H; asm volatile("" : "+s"(zo));
        u16* Z = (u16*)(ws + zo); const u16* XB = (const u16*)(ws + zo - WS_H + WS_XB);
        u32x4 xw[2][4][2];
#pragma unroll
        for (int ai = 0; ai < 2; ++ai)
#pragma unroll
            for (int m = 0; m < 4; ++m)
#pragma unroll
                for (int bj = 0; bj < 2; ++bj)
                    xw[ai][m][bj] = *(const u32x4*)(XB + (size_t)(brow + ai * HALF + wr * 64 + m * 16 + fr) * DM + bcol + bj * HALF + wc * 32 + fq * 8);
#pragma unroll
        for (int ai = 0; ai < 2; ++ai)
#pragma unroll
            for (int m = 0; m < 4; ++m) {
                const int row = brow + ai * HALF + wr * 64 + m * 16 + fr;
#pragma unroll
                for (int bj = 0; bj < 2; ++bj) {
                    const int col0 = bcol + bj * HALF + wc * 32 + fq * 8;
                    const u32x4 x4 = xw[ai][m][bj];
                    f32x4 v0 = acc[ai][bj][m][0], v1 = acc[ai][bj][m][1];
                    v0[0] += ALPHA * bflo(x4.x); v0[1] += ALPHA * bfhi(x4.x); v0[2] += ALPHA * bflo(x4.y); v0[3] += ALPHA * bfhi(x4.y);
                    v1[0] += ALPHA * bflo(x4.z); v1[1] += ALPHA * bfhi(x4.z); v1[2] += ALPHA * bflo(x4.w); v1[3] += ALPHA * bfhi(x4.w);
                    u32x4 w; w.x = cvt_pk_bf16(v0[0], v0[1]); w.y = cvt_pk_bf16(v0[2], v0[3]); w.z = cvt_pk_bf16(v1[0], v1[1]); w.w = cvt_pk_bf16(v1[2], v1[3]);
                    __builtin_nontemporal_store(w, (u32x4*)(Z + (size_t)row * DM + col0));
                }
            }
    }
};

DI void phase_prologue(const Params& p) {
    const int tid = tid_opaque();
    const long gt = (long)blockIdx.x * 512 + tid, nth = (long)gridDim.x * 512;
    unsigned char* ws = p.ws;
    const int NTW = (gridDim.x >= 256) ? 48 : 0;
    const bool do_cvt = (NTW == 0) || ((int)blockIdx.x >= NTW), do_tr = (NTW == 0) || ((int)blockIdx.x < NTW);
    const long gtc = (long)((int)blockIdx.x - NTW) * 512 + tid, nthc = (long)((int)gridDim.x - NTW) * 512;
    if (do_cvt) {
        u16* XB = (u16*)(ws + WS_XB);
        const long nv = (long)MTOT * DM / 8;
        const long nth = nthc;
        for (long i0 = gtc; i0 < nv; i0 += 4 * nth) {
            f32x4 a[4], b[4];
#pragma unroll
            for (int k = 0; k < 4; ++k) {
                const long i = i0 + k * nth;
                const long e = (i < nv ? i : i0) * 8;
                const float* sp = (e < (long)NTOKP * DM) ? (p.x_prompt + e) : (p.x_sample + (e - (long)NTOKP * DM));
                a[k] = __builtin_nontemporal_load((const f32x4*)sp); b[k] = __builtin_nontemporal_load((const f32x4*)(sp + 4));
            }
#pragma unroll
            for (int k = 0; k < 4; ++k) {
                const long i = i0 + k * nth;
                if (i < nv) {
                    u32x4 o; o.x = cvt_pk_bf16(a[k][0], a[k][1]); o.y = cvt_pk_bf16(a[k][2], a[k][3]); o.z = cvt_pk_bf16(b[k][0], b[k][1]); o.w = cvt_pk_bf16(b[k][2], b[k][3]);
                    *(u32x4*)(XB + i * 8) = o;
                }
            }
        }
    }
    if (do_tr) {
        float* tile = (float*)shm;
        const int T_IN = 16 * 48, T_OUT = 16 * 16, NT = 2 * T_IN + 2 * T_OUT;
        const int trs = NTW ? NTW : (int)gridDim.x;
        for (int it = blockIdx.x; it < NT; it += trs) {
            const float* W; u16* WT; int N, r = it;
            if (r < 2 * T_IN) { const int l = r / T_IN; r -= l * T_IN; W = p.w_in + (size_t)l * DM * INW; WT = (u16*)(ws + WS_WTIN) + (size_t)l * INW * DM; N = INW; }
            else { r -= 2 * T_IN; const int l = r / T_OUT; r -= l * T_OUT; W = p.w_out + (size_t)l * MIXW * DM; WT = (u16*)(ws + WS_WTOUT) + (size_t)l * DM * MIXW; N = DM; }
            const int nb = N / 64, k0 = (r / nb) * 64, n0 = (r % nb) * 64;
#pragma unroll
            for (int i = 0; i < 8; ++i) { const int idx = tid + i * 512, kk = idx >> 6, nn = idx & 63; tile[kk * 65 + nn] = W[(size_t)(k0 + kk) * N + n0 + nn]; }
            __syncthreads();
#pragma unroll
            for (int i = 0; i < 8; ++i) { const int idx = tid + i * 512, nn = idx >> 6, kk = idx & 63; WT[(size_t)(n0 + nn) * 1024 + k0 + kk] = f2bf(tile[kk * 65 + nn]); }
            __syncthreads();
        }
    }
    {
        u16* WSB = (u16*)(ws + WS_WSB);
        for (long i = gt; i < 2 * 4 * 128 * 128; i += nth) { const int jj = i & 127, ii = (i >> 7) & 127; WSB[i] = ((jj >> 6) <= (ii >> 6)) ? f2bf(p.w_s[i]) : (u16)0; }
    }
    {
        float2* RT = (float2*)(ws + WS_RT);
        for (long i = gt; i < 4112 * 8; i += nth) {
            const int pi = (int)(i >> 3), fi = (int)(i & 7);
            const int pos = pi < 4096 ? pi : 2048 + (pi - 4096);
            const float ang = (float)pos * p.inv[fi];
            double r = (double)ang * 0.15915494309189533577; r -= rint(r);
            const float rf = (float)r;
            RT[i] = make_float2(__builtin_amdgcn_cosf(rf), __builtin_amdgcn_sinf(rf));
        }
    }
    {
        u16* KVS = (u16*)(ws + WS_KVS);
        for (long i = gt; i < 2 * 16 * 128 * 256; i += nth) {
            const int c = i & 255, row = (i >> 8) & 127, lb = (int)(i >> 15);
            const float v = (c < 128) ? p.cache_k[((size_t)lb * 128 + row) * 128 + c] : p.cache_v[((size_t)lb * 128 + row) * 128 + (c - 128)];
            KVS[((size_t)lb * 144 + row) * 256 + c] = f2bf(v);
        }
    }
    {
        float* LB = (float*)(ws + WS_LB);
        for (long i = gt; i < 256; i += nth) {
            const float a = p.lb_param[i], b = p.lb_param[256 + i], m = fmaxf(a, b);
            const float ea = expf(a - m), eb = expf(b - m);
            LB[i] = 0.f; LB[256 + i] = eb / (ea + eb);
        }
    }
}

constexpr int VROW = 72;
DI void attn_unit(const u16* __restrict__ Q, int qstride, int nq, const u16* __restrict__ Kp, const u16* __restrict__ Vp, int kvstride, int nkeys,
                  const u16* __restrict__ Zg, int zstride, u16* __restrict__ Out, int ostride, const float* __restrict__ sinks4) {
    u16* Vl = (u16*)shm;
    const int tid = tid_opaque(), wid = __builtin_amdgcn_readfirstlane(tid >> 6), lane = tid & 63, fr = lane & 15, fq = lane >> 4;
    const int nk32 = (nkeys + 31) & ~31, nkt = nk32 >> 4, nks = nk32 >> 5;
    const int r = wid >> 1, q0 = (wid & 1) * 32;
    const bool active = q0 < nq;
    u32x4 vreg[3];
#pragma unroll
    for (int i = 0; i < 3; ++i) {
        const int idx = tid + i * 512, key = idx >> 3, d0 = (idx & 7) * 8;
        vreg[i] = (u32x4){0u, 0u, 0u, 0u};
        if (key < nkeys) vreg[i] = *(const u32x4*)(Vp + (size_t)key * kvstride + d0);
    }
    bf16x8 bq[2][2], ak[12][2];
    if (active) {
#pragma unroll
        for (int qt = 0; qt < 2; ++qt)
#pragma unroll
            for (int ks = 0; ks < 2; ++ks) { const int qrow = min(q0 + qt * 16 + fr, nq - 1); bq[qt][ks] = *(const bf16x8*)(Q + (size_t)qrow * qstride + r * 64 + ks * 32 + fq * 8); }
#pragma unroll
        for (int kt = 0; kt < 12; ++kt) if (kt < nkt) {
            const int krow = min(kt * 16 + fr, nkeys - 1);
            ak[kt][0] = *(const bf16x8*)(Kp + (size_t)krow * kvstride + fq * 8); ak[kt][1] = *(const bf16x8*)(Kp + (size_t)krow * kvstride + 32 + fq * 8);
        }
    }
#pragma unroll
    for (int i = 0; i < 3; ++i) {
        const int idx = tid + i * 512, key = idx >> 3, d0 = (idx & 7) * 8;
        if (key < nk32) *(u32x4*)(Vl + key * VROW + d0) = vreg[i];
    }
    __syncthreads();
    if (active) {
        f32x4 st[12][2];
#pragma unroll
        for (int kt = 0; kt < 12; ++kt) {
            st[kt][0] = (f32x4){0.f, 0.f, 0.f, 0.f}; st[kt][1] = (f32x4){0.f, 0.f, 0.f, 0.f};
            if (kt < nkt) {
#pragma unroll
                for (int qt = 0; qt < 2; ++qt) { st[kt][qt] = MFMA16(ak[kt][0], bq[qt][0], st[kt][qt]); st[kt][qt] = MFMA16(ak[kt][1], bq[qt][1], st[kt][qt]); }
            }
        }
        u32x2 zw[2][4];
#pragma unroll
        for (int qt = 0; qt < 2; ++qt) {
            const int q = min(q0 + qt * 16 + fr, nq - 1);
#pragma unroll
            for (int dt = 0; dt < 4; ++dt) zw[qt][dt] = *(const u32x2*)(Zg + (size_t)q * zstride + r * 64 + dt * 16 + fq * 4);
        }
        const float sink = sinks4[r] * 1.4426950408889634f;
        float inv_den[2];
        bf16x8 pb[2][6];
#pragma unroll
        for (int qt = 0; qt < 2; ++qt) {
            float mx = sink;
#pragma unroll
            for (int kt = 0; kt < 12; ++kt) if (kt < nkt) {
#pragma unroll
                for (int j = 0; j < 4; ++j) { const int key = kt * 16 + fq * 4 + j; float s = st[kt][qt][j]; if (key >= nkeys) s = -INFINITY; st[kt][qt][j] = s; mx = fmaxf(mx, s); }
            }
            mx = fmaxf(mx, __shfl_xor(mx, 16)); mx = fmaxf(mx, __shfl_xor(mx, 32));
            float sum = 0.f;
#pragma unroll
            for (int kt = 0; kt < 12; ++kt) if (kt < nkt) {
#pragma unroll
                for (int j = 0; j < 4; ++j) { const float e = __builtin_amdgcn_exp2f(st[kt][qt][j] - mx); st[kt][qt][j] = e; sum += e; }
            }
            sum += __shfl_xor(sum, 16); sum += __shfl_xor(sum, 32);
            inv_den[qt] = 1.f / (sum + __builtin_amdgcn_exp2f(sink - mx));
#pragma unroll
            for (int s2 = 0; s2 < 6; ++s2) {
                u32x4 w;
                w.x = cvt_pk_bf16(st[2 * s2][qt][0], st[2 * s2][qt][1]); w.y = cvt_pk_bf16(st[2 * s2][qt][2], st[2 * s2][qt][3]);
                w.z = cvt_pk_bf16(st[2 * s2 + 1][qt][0], st[2 * s2 + 1][qt][1]); w.w = cvt_pk_bf16(st[2 * s2 + 1][qt][2], st[2 * s2 + 1][qt][3]);
                pb[qt][s2] = __builtin_bit_cast(bf16x8, w);
            }
        }
        f32x4 o[4][2];
#pragma unroll
        for (int dt = 0; dt < 4; ++dt) { o[dt][0] = (f32x4){0.f, 0.f, 0.f, 0.f}; o[dt][1] = (f32x4){0.f, 0.f, 0.f, 0.f}; }
#pragma unroll
        for (int s2 = 0; s2 < 6; ++s2) if (s2 < nks) {
#pragma unroll
            for (int dt = 0; dt < 4; ++dt) {
                const u16* vr = Vl + (32 * s2 + 4 * fq + (fr >> 2)) * VROW + dt * 16 + 4 * (fr & 3);
                const s16x4 lo = tr_read4(vr), hi = tr_read4(vr + 16 * VROW);
                const bf16x8 a = __builtin_shufflevector(lo, hi, 0, 1, 2, 3, 4, 5, 6, 7);
                o[dt][0] = MFMA16(a, pb[0][s2], o[dt][0]); o[dt][1] = MFMA16(a, pb[1][s2], o[dt][1]);
            }
        }
#pragma unroll
        for (int qt = 0; qt < 2; ++qt) {
            const int q = q0 + qt * 16 + fr;
            if (q < nq) {
#pragma unroll
                for (int dt = 0; dt < 4; ++dt) {
                    const int d = dt * 16 + fq * 4;
                    const u32x2 z2 = zw[qt][dt];
                    const f32x4 ov = o[dt][qt] * inv_den[qt];
                    u32x2 w; w.x = cvt_pk_bf16(ov[0] * bflo(z2.x), ov[1] * bfhi(z2.x)); w.y = cvt_pk_bf16(ov[2] * bflo(z2.y), ov[3] * bfhi(z2.y));
                    *(u32x2*)(Out + (size_t)q * ostride + r * 64 + d) = w;
                }
            }
        }
    }
    __syncthreads();
}

DI void attn_run(const Params& p, int l, int run) {
    unsigned char* ws = p.ws;
    const u16* H = (const u16*)(ws + WS_H); u16* MIX = (u16*)(ws + WS_MIX);
    u16* Kl = (u16*)shm; u16* Vl = Kl + 4 * 64 * VROW;
    const int tid = tid_opaque(), wid = __builtin_amdgcn_readfirstlane(tid >> 6), lane = tid & 63, fr = lane & 15, fq = lane >> 4;
    const int r = wid >> 1, q0 = (wid & 1) * 32;
    const int b = run >> 4, g = (run >> 3) & 1, c0 = (run & 7) * 8;
    const u16* Hb = H + (size_t)b * SEQ * INW;
    u16* Mb = MIX + (size_t)b * SEQ * MIXW;
    const int lkey = tid >> 3, ld0 = (tid & 7) * 8;
    const float sink = p.sinks[l * 8 + g * 4 + r] * 1.4426950408889634f;
    {
        u32x4 kv3[3], vv3[3];
#pragma unroll
        for (int i = 0; i < 3; ++i) {
            const int ch = c0 - 2 + i;
            kv3[i] = (u32x4){0u, 0u, 0u, 0u}; vv3[i] = (u32x4){0u, 0u, 0u, 0u};
            if (ch >= 0) { const u16* srow = Hb + (size_t)(ch * 64 + lkey) * INW; kv3[i] = *(const u32x4*)(srow + C_KC + g * 64 + ld0); vv3[i] = *(const u32x4*)(srow + C_VC + g * 64 + ld0); }
        }
#pragma unroll
        for (int i = 0; i < 3; ++i) {
            const int ch = c0 - 2 + i;
            if (ch >= 0) { *(u32x4*)(Kl + ((ch & 3) * 64 + lkey) * VROW + ld0) = kv3[i]; *(u32x4*)(Vl + ((ch & 3) * 64 + lkey) * VROW + ld0) = vv3[i]; }
        }
    }
    bf16x8 bq[2][2];
#pragma unroll
    for (int qt = 0; qt < 2; ++qt)
#pragma unroll
        for (int ks = 0; ks < 2; ++ks) bq[qt][ks] = *(const bf16x8*)(Hb + (size_t)(c0 * 64 + q0 + qt * 16 + fr) * INW + C_QC + g * 256 + r * 64 + ks * 32 + fq * 8);
    __syncthreads();
#pragma unroll 1
    for (int u = 0; u < 8; ++u) {
        const int c = c0 + u;
        const int nch = min(c + 1, 3), cf = c - nch + 1, nkt = nch * 4;
        u32x4 kn = {0u, 0u, 0u, 0u}, vn = {0u, 0u, 0u, 0u}; bf16x8 bqn[2][2];
        if (u < 7) {
            const u16* srow = Hb + (size_t)((c + 1) * 64 + lkey) * INW;
            kn = *(const u32x4*)(srow + C_KC + g * 64 + ld0); vn = *(const u32x4*)(srow + C_VC + g * 64 + ld0);
#pragma unroll
            for (int qt = 0; qt < 2; ++qt)
#pragma unroll
                for (int ks = 0; ks < 2; ++ks) bqn[qt][ks] = *(const bf16x8*)(Hb + (size_t)((c + 1) * 64 + q0 + qt * 16 + fr) * INW + C_QC + g * 256 + r * 64 + ks * 32 + fq * 8);
        } else {
#pragma unroll
            for (int qt = 0; qt < 2; ++qt)
#pragma unroll
                for (int ks = 0; ks < 2; ++ks) bqn[qt][ks] = bq[qt][ks];
        }
        u32x2 zw[2][4];
#pragma unroll
        for (int qt = 0; qt < 2; ++qt)
#pragma unroll
            for (int dt = 0; dt < 4; ++dt) zw[qt][dt] = *(const u32x2*)(Hb + (size_t)(c * 64 + q0 + qt * 16 + fr) * INW + C_ZC + g * 256 + r * 64 + dt * 16 + fq * 4);
        f32x4 st[12][2];
#pragma unroll
        for (int kt = 0; kt < 12; ++kt) {
            st[kt][0] = (f32x4){0.f, 0.f, 0.f, 0.f}; st[kt][1] = (f32x4){0.f, 0.f, 0.f, 0.f};
            if (kt < nkt) {
                const int row = (((cf + (kt >> 2)) & 3) * 64 + (kt & 3) * 16 + fr);
                const bf16x8 a0 = *(const bf16x8*)(Kl + row * VROW + fq * 8), a1 = *(const bf16x8*)(Kl + row * VROW + 32 + fq * 8);
#pragma unroll
                for (int qt = 0; qt < 2; ++qt) { st[kt][qt] = MFMA16(a0, bq[qt][0], st[kt][qt]); st[kt][qt] = MFMA16(a1, bq[qt][1], st[kt][qt]); }
            }
        }
        float inv_den[2];
        bf16x8 pb[2][6];
#pragma unroll
        for (int qt = 0; qt < 2; ++qt) {
            float mx = sink;
#pragma unroll
            for (int kt = 0; kt < 12; ++kt) if (kt < nkt) {
#pragma unroll
                for (int j = 0; j < 4; ++j) mx = fmaxf(mx, st[kt][qt][j]);
            }
            mx = fmaxf(mx, __shfl_xor(mx, 16)); mx = fmaxf(mx, __shfl_xor(mx, 32));
            float sum = 0.f;
#pragma unroll
            for (int kt = 0; kt < 12; ++kt) {
                if (kt < nkt) {
#pragma unroll
                    for (int j = 0; j < 4; ++j) { const float e = __builtin_amdgcn_exp2f(st[kt][qt][j] - mx); st[kt][qt][j] = e; sum += e; }
                }
            }
            sum += __shfl_xor(sum, 16); sum += __shfl_xor(sum, 32);
            inv_den[qt] = 1.f / (sum + __builtin_amdgcn_exp2f(sink - mx));
#pragma unroll
            for (int s2 = 0; s2 < 6; ++s2) {
                u32x4 w;
                w.x = cvt_pk_bf16(st[2 * s2][qt][0], st[2 * s2][qt][1]); w.y = cvt_pk_bf16(st[2 * s2][qt][2], st[2 * s2][qt][3]);
                w.z = cvt_pk_bf16(st[2 * s2 + 1][qt][0], st[2 * s2 + 1][qt][1]); w.w = cvt_pk_bf16(st[2 * s2 + 1][qt][2], st[2 * s2 + 1][qt][3]);
                pb[qt][s2] = __builtin_bit_cast(bf16x8, w);
            }
        }
        f32x4 o[4][2];
#pragma unroll
        for (int dt = 0; dt < 4; ++dt) { o[dt][0] = (f32x4){0.f, 0.f, 0.f, 0.f}; o[dt][1] = (f32x4){0.f, 0.f, 0.f, 0.f}; }
#pragma unroll
        for (int s2 = 0; s2 < 6; ++s2) if (s2 < nch * 2) {
            const int rowb = ((cf + (s2 >> 1)) & 3) * 64 + (s2 & 1) * 32;
#pragma unroll
            for (int dt = 0; dt < 4; ++dt) {
                const u16* vr = Vl + (rowb + 4 * fq + (fr >> 2)) * VROW + dt * 16 + 4 * (fr & 3);
                const s16x4 lo = tr_read4(vr), hi = tr_read4(vr + 16 * VROW);
                const bf16x8 a = __builtin_shufflevector(lo, hi, 0, 1, 2, 3, 4, 5, 6, 7);
                o[dt][0] = MFMA16(a, pb[0][s2], o[dt][0]); o[dt][1] = MFMA16(a, pb[1][s2], o[dt][1]);
            }
        }
#pragma unroll
        for (int qt = 0; qt < 2; ++qt) {
            u16* orow = Mb + (size_t)(c * 64 + q0 + qt * 16 + fr) * MIXW + 512 + g * 256 + r * 64;
#pragma unroll
            for (int dt = 0; dt < 4; ++dt) {
                const u32x2 z2 = zw[qt][dt];
                const f32x4 ov = o[dt][qt] * inv_den[qt];
                u32x2 w; w.x = cvt_pk_bf16(ov[0] * bflo(z2.x), ov[1] * bfhi(z2.x)); w.y = cvt_pk_bf16(ov[2] * bflo(z2.y), ov[3] * bfhi(z2.y));
                *(u32x2*)(orow + dt * 16 + fq * 4) = w;
            }
        }
        if (u < 7) {
            *(u32x4*)(Kl + (((c + 1) & 3) * 64 + lkey) * VROW + ld0) = kn; *(u32x4*)(Vl + (((c + 1) & 3) * 64 + lkey) * VROW + ld0) = vn;
        }
#pragma unroll
        for (int qt = 0; qt < 2; ++qt)
#pragma unroll
            for (int ks = 0; ks < 2; ++ks) bq[qt][ks] = bqn[qt][ks];
        __syncthreads();
    }
}

constexpr int VS2 = 272;
DI void sgu_prompt_unit(const Params& p, int l, int unit) {
    unsigned char* ws = p.ws;
    const u16* H = (const u16*)(ws + WS_H); u16* MIX = (u16*)(ws + WS_MIX);
    const u16* WSB = (const u16*)(ws + WS_WSB) + (size_t)l * 4 * 128 * 128;
    u16* vn = (u16*)shm;
    const int tid = tid_opaque(), wid = __builtin_amdgcn_readfirstlane(tid >> 6), lane = tid & 63, fr = lane & 15, fq = lane >> 4;
    const int T0 = unit * 128;
    const int g = wid >> 1, ih = wid & 1;
    const int nks = ih ? 4 : 2;
    const int tok = wid * 16 + (lane >> 2), part = lane & 3;
    u32x4 vraw[8];
#pragma unroll
    for (int j = 0; j < 8; ++j) vraw[j] = *(const u32x4*)(H + (size_t)(T0 + tok) * INW + C_VA + j * 32 + part * 8);
    bf16x8 wf[4][4];
#pragma unroll
    for (int ks = 0; ks < 4; ++ks) if (ks < nks) {
#pragma unroll
        for (int mm = 0; mm < 4; ++mm) wf[ks][mm] = *(const bf16x8*)(WSB + ((size_t)g * 128 + (ih * 4 + mm) * 16 + fr) * 128 + ks * 32 + fq * 8);
    }
    {
        float s = 0.f, s2 = 0.f;
#pragma unroll
        for (int j = 0; j < 8; ++j) {
            const u32x4 w = vraw[j];
            const float x0 = bflo(w.x), x1 = bfhi(w.x), x2 = bflo(w.y), x3 = bfhi(w.y), x4 = bflo(w.z), x5 = bfhi(w.z), x6 = bflo(w.w), x7 = bfhi(w.w);
            s += ((x0 + x1) + (x2 + x3)) + ((x4 + x5) + (x6 + x7));
            s2 += ((x0 * x0 + x1 * x1) + (x2 * x2 + x3 * x3)) + ((x4 * x4 + x5 * x5) + (x6 * x6 + x7 * x7));
        }
        s += __shfl_xor(s, 1); s += __shfl_xor(s, 2); s2 += __shfl_xor(s2, 1); s2 += __shfl_xor(s2, 2);
        const float mu = s * (1.f / 256.f);
        const float var = fmaxf(s2 * (1.f / 256.f) - mu * mu, 0.f);
        const float rs = rsqrtf(var + 1e-5f);
#pragma unroll
        for (int j = 0; j < 8; ++j) {
            const int ch = j * 32 + part * 8;
            const f32x4 g0 = *(const f32x4*)(p.ln_v_g + l * 256 + ch), g1 = *(const f32x4*)(p.ln_v_g + l * 256 + ch + 4);
            const f32x4 b0 = *(const f32x4*)(p.ln_v_b + l * 256 + ch), b1 = *(const f32x4*)(p.ln_v_b + l * 256 + ch + 4);
            const u32x4 w = vraw[j];
            u32x4 o;
            o.x = cvt_pk_bf16((bflo(w.x) - mu) * rs * g0[0] + b0[0], (bfhi(w.x) - mu) * rs * g0[1] + b0[1]);
            o.y = cvt_pk_bf16((bflo(w.y) - mu) * rs * g0[2] + b0[2], (bfhi(w.y) - mu) * rs * g0[3] + b0[3]);
            o.z = cvt_pk_bf16((bflo(w.z) - mu) * rs * g1[0] + b1[0], (bfhi(w.z) - mu) * rs * g1[1] + b1[1]);
            o.w = cvt_pk_bf16((bflo(w.w) - mu) * rs * g1[2] + b1[2], (bfhi(w.w) - mu) * rs * g1[3] + b1[3]);
            *(u32x4*)(vn + tok * VS2 + ch) = o;
        }
    }
    __syncthreads();
    {
        u32x4 uw[4][2], zw[4][2];
#pragma unroll
        for (int mm = 0; mm < 4; ++mm) {
            const size_t rowH = (size_t)(T0 + (ih * 4 + mm) * 16 + fr) * INW;
#pragma unroll
            for (int nn = 0; nn < 2; ++nn) { const int ch = g * 64 + nn * 32 + fq * 8; uw[mm][nn] = *(const u32x4*)(H + rowH + C_UA + ch); zw[mm][nn] = *(const u32x4*)(H + rowH + C_ZA + ch); }
        }
        f32x4 acc[4][4];
#pragma unroll
        for (int mm = 0; mm < 4; ++mm)
#pragma unroll
            for (int n = 0; n < 4; ++n) acc[mm][n] = (f32x4){0.f, 0.f, 0.f, 0.f};
#pragma unroll
        for (int ks = 0; ks < 4; ++ks) if (ks < nks) {
            bf16x8 af[4];
#pragma unroll
            for (int n = 0; n < 4; ++n) {
                const u16* vr = vn + (ks * 32 + fq * 8 + (fr >> 2)) * VS2 + g * 64 + (n >> 1) * 32 + 8 * (fr & 3) + 4 * (n & 1);
                const s16x4 lo = tr_read4(vr), hi = tr_read4(vr + 4 * VS2);
                af[n] = __builtin_shufflevector(lo, hi, 0, 1, 2, 3, 4, 5, 6, 7);
            }
#pragma unroll
            for (int mm = 0; mm < 4; ++mm)
#pragma unroll
                for (int n = 0; n < 4; ++n) acc[mm][n] = MFMA16(af[n], wf[ks][mm], acc[mm][n]);
        }
#pragma unroll
        for (int mm = 0; mm < 4; ++mm) {
            const int i = (ih * 4 + mm) * 16 + fr;
            const float bias = p.b_s[(l * 4 + g) * 128 + i];
            const size_t rowM = (size_t)(T0 + i) * MIXW;
#pragma unroll
            for (int nn = 0; nn < 2; ++nn) {
                const int ch = g * 64 + nn * 32 + fq * 8;
                const u32x4 u4 = uw[mm][nn], z4 = zw[mm][nn];
                const f32x4 a = acc[mm][2 * nn], b2 = acc[mm][2 * nn + 1];
                u32x4 w;
                w.x = cvt_pk_bf16((a[0] + bias) * bflo(u4.x) * bflo(z4.x), (a[1] + bias) * bfhi(u4.x) * bfhi(z4.x));
                w.y = cvt_pk_bf16((a[2] + bias) * bflo(u4.y) * bflo(z4.y), (a[3] + bias) * bfhi(u4.y) * bfhi(z4.y));
                w.z = cvt_pk_bf16((b2[0] + bias) * bflo(u4.z) * bflo(z4.z), (b2[1] + bias) * bfhi(u4.z) * bfhi(z4.z));
                w.w = cvt_pk_bf16((b2[2] + bias) * bflo(u4.w) * bflo(z4.w), (b2[3] + bias) * bfhi(u4.w) * bfhi(z4.w));
                *(u32x4*)(MIX + rowM + ch) = w;
            }
        }
    }
    __syncthreads();
}

DI void sgu_sample_unit(const Params& p, int l, int b) {
    unsigned char* ws = p.ws;
    const u16* H = (const u16*)(ws + WS_H); u16* MIX = (u16*)(ws + WS_MIX);
    float* vn = (float*)shm;
    const int tid = tid_opaque(), wid = __builtin_amdgcn_readfirstlane(tid >> 6), lane = tid & 63;
    const int T0 = NTOKP + b * 16;
    const f32x4 g = *(const f32x4*)(p.ln_v_g + l * 256 + lane * 4), bb = *(const f32x4*)(p.ln_v_b + l * 256 + lane * 4);
    for (int tt = 0; tt < 2; ++tt) {
        const int tok = wid * 2 + tt;
        const u32x2 w = *(const u32x2*)(H + (size_t)(T0 + tok) * INW + C_VA + lane * 4);
        float x0 = bflo(w.x), x1 = bfhi(w.x), x2 = bflo(w.y), x3 = bfhi(w.y);
        const float mu = wave_sum((x0 + x1) + (x2 + x3)) * (1.f / 256.f);
        x0 -= mu; x1 -= mu; x2 -= mu; x3 -= mu;
        const float var = wave_sum((x0 * x0 + x1 * x1) + (x2 * x2 + x3 * x3)) * (1.f / 256.f);
        const float rs = rsqrtf(var + 1e-5f);
        f32x4 o; o[0] = x0 * rs * g[0] + bb[0]; o[1] = x1 * rs * g[1] + bb[1]; o[2] = x2 * rs * g[2] + bb[2]; o[3] = x3 * rs * g[3] + bb[3];
        *(f32x4*)(vn + tok * 256 + lane * 4) = o;
        *(f32x4*)(p.out + O_SV + ((size_t)(l * 16 + b) * 16 + tok) * 256 + lane * 4) = o;
    }
    __syncthreads();
    for (int e = 0; e < 8; ++e) {
        const int o = tid + 512 * e, i = o >> 8, ch = o & 255, g4 = ch >> 6;
        const float* wrow = p.w_s + ((size_t)(l * 4 + g4) * 128 + i) * 128;
        float s = p.b_s[(l * 4 + g4) * 128 + i];
        for (int j = 0; j < 16; ++j) s += wrow[j] * vn[j * 256 + ch];
        const size_t rowH = (size_t)(T0 + i) * INW;
        MIX[(size_t)(T0 + i) * MIXW + ch] = f2bf(s * bf2f(H[rowH + C_UA + ch]) * bf2f(H[rowH + C_ZA + ch]));
    }
    __syncthreads();
}

constexpr int HS = 72;
struct HgIn { u32x4 fb[4], q[4], v[4]; };
template <bool NEEDQ>
DI void hg_load(HgIn& x, const u16* __restrict__ H, int u, int hh, int half, int lane) {
    const int T0 = (u < NCH) ? u * 64 : NTOKP + (u - NCH) * 16, len = (u < NCH) ? 64 : 16;
#pragma unroll
    for (int i = 0; i < 4; ++i) {
        const int idx = half * 64 + lane + i * 128, j = idx >> 3, c8 = idx & 7;
        x.fb[i] = (u32x4){0u, 0u, 0u, 0u}; x.v[i] = (u32x4){0u, 0u, 0u, 0u}; x.q[i] = (u32x4){0u, 0u, 0u, 0u};
        if (j < len) {
            const u16* row = H + (size_t)(T0 + j) * INW + hh * 64 + c8 * 8;
            x.fb[i] = *(const u32x4*)(row + C_FB); x.v[i] = *(const u32x4*)(row + C_IB);
            if (NEEDQ) x.q[i] = *(const u32x4*)(row + C_QB);
        }
    }
}
DI void hgrn_local_body(const Params& p, int l, int u, const HgIn& x) {
    unsigned char* ws = p.ws;
    u16* UT = (u16*)(ws + WS_UT); float* DEC = (float*)(ws + WS_DEC);
    const float* LB = (const float*)(ws + WS_LB) + l * 256;
    const int tid = tid_opaque(), wid = __builtin_amdgcn_readfirstlane(tid >> 6), lane = tid & 63, fr = lane & 15, fq = lane >> 4;
    const int hh = wid >> 1, half = wid & 1;
    const int len = (u < NCH) ? 64 : 16;
    u16* vN = (u16*)shm + hh * (3 * 64 * HS);
    u16* kT = vN + 64 * HS;
    u16* fN = kT + 64 * HS;
    float* tot = (float*)(shm + 4 * 3 * 64 * HS * 2);
#pragma unroll
    for (int i = 0; i < 4; ++i) { const int idx = half * 64 + lane + i * 128, j = idx >> 3, c8 = idx & 7; *(u32x4*)(vN + j * HS + c8 * 8) = x.v[i]; *(u32x4*)(fN + j * HS + c8 * 8) = x.fb[i]; }
    __syncthreads();
    const float lb = LB[hh * 64 + lane];
    float fg[32], kk[32];
    float own = 1.f;
#pragma unroll
    for (int jj = 0; jj < 32; ++jj) {
        const int j = half * 32 + jj;
        const float gv = h2f(fN[j * HS + lane]);
        const float kv = (gv >= 0.f) ? gv : 1.f + gv, fv = (gv >= 0.f) ? 1.f - gv : -gv;
        fg[jj] = fv; kk[jj] = kv; own *= fv;
    }
    tot[(hh * 2 + half) * 64 + lane] = own;
    __syncthreads();
    {
        const float other = tot[(hh * 2 + (1 - half)) * 64 + lane];
        float s = half ? 1.f : other;
        unsigned pk[16];
#pragma unroll
        for (int jj = 31; jj >= 0; jj -= 2) {
            const float k1 = kk[jj] * s; s *= fg[jj];
            const float k0 = kk[jj - 1] * s; s *= fg[jj - 1];
            pk[jj >> 1] = cvt_pk_bf16(k0, k1);
        }
        if (half == 0) { const float dk = s; if (u < NCH) DEC[((size_t)u * 4 + hh) * 64 + lane] = dk; else tot[512 + hh * 64 + lane] = dk; }
#pragma unroll
        for (int q = 0; q < 4; ++q) { u32x4 w = {pk[4 * q], pk[4 * q + 1], pk[4 * q + 2], pk[4 * q + 3]}; *(u32x4*)(kT + lane * HS + half * 32 + q * 8) = w; }
    }
    __syncthreads();
    {
        f32x4 acc[2][4];
#pragma unroll
        for (int a = 0; a < 2; ++a)
#pragma unroll
            for (int kt = 0; kt < 4; ++kt) acc[a][kt] = (f32x4){0.f, 0.f, 0.f, 0.f};
#pragma unroll
        for (int ks = 0; ks < 2; ++ks) {
            bf16x8 av[2], bk[4];
#pragma unroll
            for (int a = 0; a < 2; ++a) {
                const u16* vr = vN + (ks * 32 + fq * 8 + (fr >> 2)) * HS + (half * 2 + a) * 16 + 4 * (fr & 3);
                const s16x4 lo = tr_read4(vr), hi = tr_read4(vr + 4 * HS);
                av[a] = __builtin_shufflevector(lo, hi, 0, 1, 2, 3, 4, 5, 6, 7);
            }
#pragma unroll
            for (int kt = 0; kt < 4; ++kt) bk[kt] = *(const bf16x8*)(kT + (kt * 16 + fr) * HS + ks * 32 + fq * 8);
#pragma unroll
            for (int a = 0; a < 2; ++a)
#pragma unroll
                for (int kt = 0; kt < 4; ++kt) acc[a][kt] = MFMA16(bk[kt], av[a], acc[a][kt]);
        }
        if (u < NCH) {
            u16* dst = UT + ((size_t)u * 4 + hh) * 4096;
#pragma unroll
            for (int a = 0; a < 2; ++a)
#pragma unroll
                for (int kt = 0; kt < 4; ++kt) {
                    u32x2 w; w.x = cvt_pk_bf16(acc[a][kt][0], acc[a][kt][1]); w.y = cvt_pk_bf16(acc[a][kt][2], acc[a][kt][3]);
                    *(u32x2*)(dst + ((half * 2 + a) * 16 + fr) * 64 + kt * 16 + fq * 4) = w;
                }
        } else {
            const size_t so = ((size_t)(l * 16 + (u - NCH)) * 4 + hh) * 4096;
#pragma unroll
            for (int kt = 0; kt < 4; ++kt)
#pragma unroll
                for (int r = 0; r < 4; ++r) {
                    const int k = kt * 16 + fq * 4 + r;
                    const float dk = tot[512 + hh * 64 + k];
#pragma unroll
                    for (int a = 0; a < 2; ++a) {
                        const int v = (half * 2 + a) * 16 + fr;
                        p.out[O_HS + so + k * 64 + v] = p.state_hgrn[so + k * 64 + v] * dk + acc[a][kt][r];
                    }
                }
        }
    }
    __syncthreads();
}
DI void hgrn_local_run(const Params& p, int l, int u0, int n) {
    const u16* H = (const u16*)(p.ws + WS_H);
    const int tid = tid_opaque(), wid = __builtin_amdgcn_readfirstlane(tid >> 6), lane = tid & 63;
    const int hh = wid >> 1, half = wid & 1;
    HgIn cur; hg_load<false>(cur, H, u0, hh, half, lane);
#pragma unroll 1
    for (int i = 0; i < n; ++i) {
        HgIn nxt = cur;
        if (i + 1 < n) hg_load<false>(nxt, H, u0 + i + 1, hh, half, lane);
        hgrn_local_body(p, l, u0 + i, cur);
        cur = nxt;
    }
}

DI void hgrn_scan_phase(const Params& p, int l, int wgi, int nwg) {
    unsigned char* ws = p.ws;
    const u16* __restrict__ UT = (const u16*)(ws + WS_UT); const float* __restrict__ DEC = (const float*)(ws + WS_DEC);
    u16* __restrict__ SBUF = (u16*)(ws + WS_SB);
    const long gt = (long)wgi * 512 + tid_opaque(), nth = (long)nwg * 512;
    for (long item = gt; item < 128 * 4096; item += nth) {
        const int seq = (int)(item >> 12), e = (int)(item & 4095), k = e & 63, v = e >> 6;
        if (seq < 64) {
            const int b = seq >> 2, hh = seq & 3;
            float s = 0.f;
            for (int c0 = 0; c0 < 64; c0 += 16) {
                float uu[16], dd[16];
#pragma unroll
                for (int c = 0; c < 16; ++c) { const size_t ub = (size_t)(b * 64 + c0 + c) * 4 + hh; uu[c] = bf2f(UT[ub * 4096 + e]); dd[c] = DEC[ub * 64 + k]; }
#pragma unroll
                for (int c = 0; c < 16; ++c) { const size_t ub = (size_t)(b * 64 + c0 + c) * 4 + hh; SBUF[ub * 4096 + e] = f2bf(s); s = dd[c] * s + uu[c]; }
            }
            p.out[O_HP + ((size_t)(l * 16 + b) * 4 + hh) * 4096 + k * 64 + v] = s;
        } else {
            const int b = (seq - 64) >> 2, hh = seq & 3;
            const size_t ub = (size_t)(NCH + b) * 4 + hh;
            SBUF[ub * 4096 + e] = f2bf(p.state_hgrn[((size_t)(l * 16 + b) * 4 + hh) * 4096 + k * 64 + v]);
        }
    }
}

DI void hgrn_out_body(const Params& p, int l, int u, const HgIn& x) {
    unsigned char* ws = p.ws;
    const u16* H = (const u16*)(ws + WS_H); u16* MIX = (u16*)(ws + WS_MIX);
    const u16* SBUF = (const u16*)(ws + WS_SB);
    const float* LB = (const float*)(ws + WS_LB) + l * 256;
    const int tid = tid_opaque(), wid = __builtin_amdgcn_readfirstlane(tid >> 6), lane = tid & 63, fr = lane & 15, fq = lane >> 4;
    const int hh = wid >> 1, half = wid & 1;
    const int T0 = (u < NCH) ? u * 64 : NTOKP + (u - NCH) * 16, len = (u < NCH) ? 64 : 16;
    u16* vN = (u16*)shm + hh * (4 * 64 * HS);
    u16* kh = vN + 64 * HS;
    u16* qh = kh + 64 * HS;
    u16* qt = qh + 64 * HS;
    float* tot = (float*)(shm + 4 * 4 * 64 * HS * 2);
#pragma unroll
    for (int i = 0; i < 4; ++i) {
        const int idx = half * 64 + lane + i * 128, j = idx >> 3, c8 = idx & 7;
        *(u32x4*)(vN + j * HS + c8 * 8) = x.v[i]; *(u32x4*)(kh + j * HS + c8 * 8) = x.fb[i]; *(u32x4*)(qh + j * HS + c8 * 8) = x.q[i];
    }
    bf16x8 sfr[2][4];
    {
        const u16* Sg = SBUF + ((size_t)u * 4 + hh) * 4096;
#pragma unroll
        for (int ks = 0; ks < 2; ++ks)
#pragma unroll
            for (int vt = 0; vt < 4; ++vt) sfr[ks][vt] = *(const bf16x8*)(Sg + (vt * 16 + fr) * 64 + ks * 32 + fq * 8);
    }
    u32x2 zw[2][4];
#pragma unroll
    for (int ii = 0; ii < 2; ++ii) {
        const int i = min((half * 2 + ii) * 16 + fr, len - 1);
#pragma unroll
        for (int vt = 0; vt < 4; ++vt) zw[ii][vt] = *(const u32x2*)(H + (size_t)(T0 + i) * INW + C_ZB + hh * 64 + vt * 16 + fq * 4);
    }
    __syncthreads();
    const float lb = LB[hh * 64 + lane];
    float fg[32], kk[32];
    float own = 1.f;
#pragma unroll
    for (int jj = 0; jj < 32; ++jj) {
        const int j = half * 32 + jj;
        const float gv = h2f(kh[j * HS + lane]);
        const float kv = (gv >= 0.f) ? gv : 1.f + gv, fv = (gv >= 0.f) ? 1.f - gv : -gv;
        own *= fv; fg[jj] = fv; kk[jj] = kv;
    }
    tot[(hh * 2 + half) * 64 + lane] = own;
    float qhv[32];
    if (half) {
        float D = 1.f;
#pragma unroll
        for (int jj = 0; jj < 32; ++jj) {
            const int j = 32 + jj;
            D *= fg[jj];
            const float qv = bf2f(qh[j * HS + lane]) * D;
            qhv[jj] = qv;
            kh[j * HS + lane] = f2bf(kk[jj] * __builtin_amdgcn_rcpf(D));
            qh[j * HS + lane] = f2bf(qv);
        }
    } else {
        float R = 1.f;
#pragma unroll
        for (int jj = 31; jj >= 0; --jj) {
            const int j = jj;
            const float qv = bf2f(qh[j * HS + lane]) * __builtin_amdgcn_rcpf(R);
            qhv[jj] = qv;
            kh[j * HS + lane] = f2bf(kk[jj] * R);
            qh[j * HS + lane] = f2bf(qv);
            R *= fg[jj];
        }
    }
    __syncthreads();
    {
        const float other = tot[(hh * 2 + (1 - half)) * 64 + lane];
        const float C = half ? other : own;
#pragma unroll
        for (int jj = 0; jj < 32; ++jj) { const int j = half * 32 + jj; qt[j * HS + lane] = f2bf(qhv[jj] * C); }
    }
    {
        f32x4 at[2][4];
#pragma unroll
        for (int ii = 0; ii < 2; ++ii)
#pragma unroll
            for (int jt = 0; jt < 4; ++jt) at[ii][jt] = (f32x4){0.f, 0.f, 0.f, 0.f};
#pragma unroll
        for (int ks = 0; ks < 2; ++ks) {
            bf16x8 bqf[2];
#pragma unroll
            for (int ii = 0; ii < 2; ++ii) bqf[ii] = *(const bf16x8*)(qh + ((half * 2 + ii) * 16 + fr) * HS + ks * 32 + fq * 8);
#pragma unroll
            for (int jt = 0; jt < 4; ++jt) if (jt <= half * 2 + 1) {
                const bf16x8 ak = *(const bf16x8*)(kh + (jt * 16 + fr) * HS + ks * 32 + fq * 8);
#pragma unroll
                for (int ii = 0; ii < 2; ++ii) at[ii][jt] = MFMA16(ak, bqf[ii], at[ii][jt]);
            }
        }
        bf16x8 pb[2][2];
#pragma unroll
        for (int ii = 0; ii < 2; ++ii) {
            const int i = (half * 2 + ii) * 16 + fr;
#pragma unroll
            for (int jt = 0; jt < 4; ++jt)
#pragma unroll
                for (int r = 0; r < 4; ++r) { const int j = jt * 16 + fq * 4 + r; if (j > i) at[ii][jt][r] = 0.f; }
#pragma unroll
            for (int s2 = 0; s2 < 2; ++s2) {
                u32x4 w;
                w.x = cvt_pk_bf16(at[ii][2 * s2][0], at[ii][2 * s2][1]); w.y = cvt_pk_bf16(at[ii][2 * s2][2], at[ii][2 * s2][3]);
                w.z = cvt_pk_bf16(at[ii][2 * s2 + 1][0], at[ii][2 * s2 + 1][1]); w.w = cvt_pk_bf16(at[ii][2 * s2 + 1][2], at[ii][2 * s2 + 1][3]);
                pb[ii][s2] = __builtin_bit_cast(bf16x8, w);
            }
        }
        f32x4 o[4][2];
#pragma unroll
        for (int vt = 0; vt < 4; ++vt) { o[vt][0] = (f32x4){0.f, 0.f, 0.f, 0.f}; o[vt][1] = (f32x4){0.f, 0.f, 0.f, 0.f}; }
#pragma unroll
        for (int s2 = 0; s2 < 2; ++s2) if (s2 <= half) {
#pragma unroll
            for (int vt = 0; vt < 4; ++vt) {
                const u16* vr = vN + (32 * s2 + 4 * fq + (fr >> 2)) * HS + vt * 16 + 4 * (fr & 3);
                const s16x4 lo = tr_read4(vr), hi = tr_read4(vr + 16 * HS);
                const bf16x8 a = __builtin_shufflevector(lo, hi, 0, 1, 2, 3, 4, 5, 6, 7);
                o[vt][0] = MFMA16(a, pb[0][s2], o[vt][0]); o[vt][1] = MFMA16(a, pb[1][s2], o[vt][1]);
            }
        }
        __syncthreads();
#pragma unroll
        for (int ks = 0; ks < 2; ++ks) {
            bf16x8 bqf[2];
#pragma unroll
            for (int ii = 0; ii < 2; ++ii) bqf[ii] = *(const bf16x8*)(qt + ((half * 2 + ii) * 16 + fr) * HS + ks * 32 + fq * 8);
#pragma unroll
            for (int vt = 0; vt < 4; ++vt) { o[vt][0] = MFMA16(sfr[ks][vt], bqf[0], o[vt][0]); o[vt][1] = MFMA16(sfr[ks][vt], bqf[1], o[vt][1]); }
        }
#pragma unroll
        for (int ii = 0; ii < 2; ++ii) {
            float ss = 0.f;
#pragma unroll
            for (int vt = 0; vt < 4; ++vt) { const f32x4 xx = o[vt][ii]; ss += (xx[0] * xx[0] + xx[1] * xx[1]) + (xx[2] * xx[2] + xx[3] * xx[3]); }
            ss += __shfl_xor(ss, 16); ss += __shfl_xor(ss, 32);
            const float rs = rsqrtf(ss * (1.f / 64.f) + 1e-6f);
            const int i = (half * 2 + ii) * 16 + fr;
            if (i < len) {
#pragma unroll
                for (int vt = 0; vt < 4; ++vt) {
                    const int v = vt * 16 + fq * 4;
                    const f32x4 gn = *(const f32x4*)(p.norm_b_g + l * 64 + v);
                    const u32x2 z2 = zw[ii][vt];
                    const f32x4 xx = o[vt][ii];
                    u32x2 w; w.x = cvt_pk_bf16(xx[0] * rs * gn[0] * bflo(z2.x), xx[1] * rs * gn[1] * bfhi(z2.x)); w.y = cvt_pk_bf16(xx[2] * rs * gn[2] * bflo(z2.y), xx[3] * rs * gn[3] * bfhi(z2.y));
                    *(u32x2*)(MIX + (size_t)(T0 + i) * MIXW + 256 + hh * 64 + v) = w;
                }
            }
        }
    }
}
DI void hgrn_out_run(const Params& p, int l, int u0, int n) {
    const u16* H = (const u16*)(p.ws + WS_H);
    const int tid = tid_opaque(), wid = __builtin_amdgcn_readfirstlane(tid >> 6), lane = tid & 63;
    const int hh = wid >> 1, half = wid & 1;
    HgIn cur; hg_load<true>(cur, H, u0, hh, half, lane);
#pragma unroll 1
    for (int i = 0; i < n; ++i) {
        HgIn nxt = cur;
        if (i + 1 < n) hg_load<true>(nxt, H, u0 + i + 1, hh, half, lane);
        hgrn_out_body(p, l, u0 + i, cur);
        cur = nxt;
    }
    __syncthreads();
}

DI void ln_phase(const Params& p, int l, int row0, int row1, int wgi, int nwg) {
    unsigned char* ws = p.ws;
    const u16* Z = (const u16*)(ws + WS_H);
    u16* XB = (u16*)(ws + WS_XB);
    const int tid = tid_opaque(), wid = __builtin_amdgcn_readfirstlane(tid >> 6), lane = tid & 63;
    f32x4 g[4], bb[4];
#pragma unroll
    for (int j = 0; j < 2; ++j) {
        g[2 * j] = *(const f32x4*)(p.ln_g + l * DM + lane * 8 + 512 * j); g[2 * j + 1] = *(const f32x4*)(p.ln_g + l * DM + lane * 8 + 512 * j + 4);
        bb[2 * j] = *(const f32x4*)(p.ln_b + l * DM + lane * 8 + 512 * j); bb[2 * j + 1] = *(const f32x4*)(p.ln_b + l * DM + lane * 8 + 512 * j + 4);
    }
    const int stride = nwg * 8;
    for (int rowa = row0 + wgi * 8 + wid; rowa < row1; rowa += 2 * stride) {
        const int rowb = rowa + stride;
        const bool hasb = rowb < row1;
        const u16* za = Z + (size_t)rowa * DM + lane * 8;
        const u16* zb = Z + (size_t)(hasb ? rowb : rowa) * DM + lane * 8;
        const u32x4 wa0 = *(const u32x4*)za, wa1 = *(const u32x4*)(za + 512), wb0 = *(const u32x4*)zb, wb1 = *(const u32x4*)(zb + 512);
#pragma unroll
        for (int rr = 0; rr < 2; ++rr) {
            if (rr == 1 && !hasb) break;
            const int row = rr ? rowb : rowa;
            const u32x4 w0 = rr ? wb0 : wa0, w1 = rr ? wb1 : wa1;
            f32x4 v[4];
            v[0] = (f32x4){bflo(w0.x), bfhi(w0.x), bflo(w0.y), bfhi(w0.y)}; v[1] = (f32x4){bflo(w0.z), bfhi(w0.z), bflo(w0.w), bfhi(w0.w)};
            v[2] = (f32x4){bflo(w1.x), bfhi(w1.x), bflo(w1.y), bfhi(w1.y)}; v[3] = (f32x4){bflo(w1.z), bfhi(w1.z), bflo(w1.w), bfhi(w1.w)};
            float s = 0.f;
#pragma unroll
            for (int j = 0; j < 4; ++j) s += (v[j][0] + v[j][1]) + (v[j][2] + v[j][3]);
            const float mu = wave_sum(s) * (1.f / DM);
            float s2 = 0.f;
#pragma unroll
            for (int j = 0; j < 4; ++j) { v[j] = v[j] - mu; s2 += (v[j][0] * v[j][0] + v[j][1] * v[j][1]) + (v[j][2] * v[j][2] + v[j][3] * v[j][3]); }
            const float rs = rsqrtf(wave_sum(s2) * (1.f / DM) + 1e-5f);
#pragma unroll
            for (int j = 0; j < 4; ++j) v[j] = v[j] * rs * g[j] + bb[j];
            if (l == 0) {
                u16* xr = XB + (size_t)row * DM + lane * 8;
#pragma unroll
                for (int j = 0; j < 2; ++j) {
                    u32x4 w; w.x = cvt_pk_bf16(v[2 * j][0], v[2 * j][1]); w.y = cvt_pk_bf16(v[2 * j][2], v[2 * j][3]); w.z = cvt_pk_bf16(v[2 * j + 1][0], v[2 * j + 1][1]); w.w = cvt_pk_bf16(v[2 * j + 1][2], v[2 * j + 1][3]);
                    *(u32x4*)(xr + 512 * j) = w;
                }
            } else {
                float* yr = p.out + (size_t)row * DM + lane * 8;
#pragma unroll
                for (int j = 0; j < 2; ++j) { __builtin_nontemporal_store(v[2 * j], (f32x4*)(yr + 512 * j)); __builtin_nontemporal_store(v[2 * j + 1], (f32x4*)(yr + 512 * j + 4)); }
            }
        }
    }
}

DI void phase_mix_a(const Params& p, int l) {
    unsigned char* ws = p.ws;
    const u16* H = (const u16*)(ws + WS_H); u16* MIX = (u16*)(ws + WS_MIX);
    constexpr int N_AT = 256, N_HL = NCH, N_SG = 512;
    const int G = gridDim.x;
    int w = blockIdx.x;
    for (; w < N_AT; w += G) attn_run(p, l, w);
    asm volatile("" ::: "memory");
    for (; w < N_AT + N_HL / 4; w += G) hgrn_local_run(p, l, (w - N_AT) * 4, 4);
    asm volatile("" ::: "memory");
    for (; w < N_AT + N_HL / 4 + N_SG; w += G) sgu_prompt_unit(p, l, w - N_AT - N_HL / 4);
}

DI void phase_mix_b(const Params& p, int l) {
    unsigned char* ws = p.ws;
    const u16* H = (const u16*)(ws + WS_H); u16* MIX = (u16*)(ws + WS_MIX);
    const u16* KVS = (const u16*)(ws + WS_KVS) + (size_t)l * 16 * 144 * 256;
    constexpr int N_HO = NCH / 4 + 16, N_HL = 16, N_AS = 32, N_SS = 16;
    const int G = gridDim.x;
    int w = blockIdx.x;
    for (; w < N_HO; w += G) { if (w < NCH / 4) hgrn_out_run(p, l, w * 4, 4); else hgrn_out_run(p, l, NCH + (w - NCH / 4), 1); }
    asm volatile("" ::: "memory");
    for (; w < N_HO + N_HL; w += G) hgrn_local_run(p, l, NCH + (w - N_HO), 1);
    asm volatile("" ::: "memory");
    for (; w < N_HO + N_HL + N_AS; w += G) {
        const int r = w - (N_HO + N_HL);
        const int g = r & 1, b = r >> 1;
        const size_t Tq = (size_t)NTOKP + b * 16;
        const u16* kv = KVS + (size_t)b * 144 * 256;
        attn_unit(H + Tq * INW + C_QC + g * 256, INW, 16, kv + g * 64, kv + 128 + g * 64, 256, 144,
                  H + Tq * INW + C_ZC + g * 256, INW, MIX + Tq * MIXW + 512 + g * 256, MIXW, p.sinks + l * 8 + g * 4);
    }
    asm volatile("" ::: "memory");
    for (; w < N_HO + N_HL + N_AS + N_SS; w += G) sgu_sample_unit(p, l, w - (N_HO + N_HL + N_AS));
}

__global__ void __launch_bounds__(512, 2) fwd_megakernel(Params p) {
    cg::grid_group grid = cg::this_grid();
    unsigned char* ws = p.ws;
    volatile LAS unsigned* st = (volatile LAS unsigned*)((LAS unsigned char*)shm + (LDS_BYTES - 16));
    if (threadIdx.x == 0) { st[0] = 0u; st[1] = 0u; }
    __syncthreads();
    XcdBarrier xb = xcd_barrier_post((unsigned*)(ws + WS_BAR), st);
    for (int rep = 0; rep < REP_PRO; ++rep) { phase_prologue(p); if (rep + 1 < REP_PRO) xcd_barrier(xb); }
    grid.sync();
    const int G = gridDim.x, wg = blockIdx.x;
#pragma unroll 1
    for (int l = 0; l < 2; ++l) {
#pragma unroll 1
        for (int rep = 0; rep < REP_G1; ++rep) {
            EpiIn e; e.ws = ws; e.out = p.out; e.l = l;
            #ifndef G1_WGM
#define G1_WGM 8
#endif
            StaticOrder so; so.init(NTOKP / BM, INW / BM, G, wg, 0, G1_WGM);
            gemm_phase((const u16*)(ws + WS_XB), (const u16*)(ws + WS_WTIN) + (size_t)l * INW * DM, so, e);
            xcd_barrier(xb);
        }
#pragma unroll 1
        for (int rep = 0; rep < REP_MIXA; ++rep) { phase_mix_a(p, l); xcd_barrier(xb); }
#pragma unroll 1
        for (int rep = 0; rep < REP_SCAN; ++rep) {
            if (wg < 12) {
                EpiIn e; e.ws = ws; e.out = p.out; e.l = l;
                StaticOrder so; so.init(1, INW / BM, 12, wg, NTOKP / BM);
                gemm_phase((const u16*)(ws + WS_XB), (const u16*)(ws + WS_WTIN) + (size_t)l * INW * DM, so, e);
            } else hgrn_scan_phase(p, l, wg - 12, G - 12);
            xcd_barrier(xb);
        }
#pragma unroll 1
        for (int rep = 0; rep < REP_HOUT; ++rep) { phase_mix_b(p, l); xcd_barrier(xb); }
#pragma unroll 1
        for (int rep = 0; rep < REP_G2; ++rep) {
            EpiOut e; e.ws = ws;
            StaticOrder so; so.init(NTOKP / BM, DM / BM, G, wg, 0);
            gemm_phase((const u16*)(ws + WS_MIX), (const u16*)(ws + WS_WTOUT) + (size_t)l * DM * MIXW, so, e);
            xcd_barrier(xb);
        }
#pragma unroll 1
        for (int rep = 0; rep < REP_LN; ++rep) {
            if (wg < 4) {
                EpiOut e; e.ws = ws;
                StaticOrder so; so.init(1, DM / BM, 4, wg, NTOKP / BM);
                gemm_phase((const u16*)(ws + WS_MIX), (const u16*)(ws + WS_WTOUT) + (size_t)l * DM * MIXW, so, e);
            } else ln_phase(p, l, 0, NTOKP, wg - 4, G - 4);
            xcd_barrier(xb);
        }
        if (wg < 32) ln_phase(p, l, NTOKP, MTOT, wg, 32);
    }
}


extern "C" void kernel_launch(void* const* d_in, const int* in_sizes, int n_in, void* d_out, int out_size, void* d_ws, size_t ws_size, hipStream_t stream) {
    static int grid_blocks = 0;
    if (!grid_blocks) {
        int dev = 0, cus = 0, per_cu = 0;
        (void)hipGetDevice(&dev);
        (void)hipDeviceGetAttribute(&cus, hipDeviceAttributeMultiprocessorCount, dev);
        (void)hipFuncSetAttribute((const void*)fwd_megakernel, hipFuncAttributeMaxDynamicSharedMemorySize, LDS_BYTES);
        (void)hipOccupancyMaxActiveBlocksPerMultiprocessor(&per_cu, (const void*)fwd_megakernel, 512, LDS_BYTES);
        if (per_cu < 1) { fprintf(stderr, "occupancy query returned %d\n", per_cu); per_cu = 1; }
        grid_blocks = cus * per_cu;
        if (ws_size < WS_END) fprintf(stderr, "workspace too small: %zu < %zu\n", ws_size, (size_t)WS_END);
    }
    Params p{};
    p.x_prompt = (const float*)d_in[0]; p.x_sample = (const float*)d_in[1]; p.cache_k = (const float*)d_in[2]; p.cache_v = (const float*)d_in[3];
    p.state_hgrn = (const float*)d_in[4]; p.w_in = (const float*)d_in[5]; p.ln_v_g = (const float*)d_in[6]; p.ln_v_b = (const float*)d_in[7];
    p.w_s = (const float*)d_in[8]; p.b_s = (const float*)d_in[9]; p.lb_param = (const float*)d_in[10]; p.norm_b_g = (const float*)d_in[11];
    p.sinks = (const float*)d_in[12]; p.w_out = (const float*)d_in[13]; p.ln_g = (const float*)d_in[14]; p.ln_b = (const float*)d_in[15];
    p.out = (float*)d_out; p.ws = (unsigned char*)d_ws;
    for (int i = 0; i < 8; ++i) p.inv[i] = powf(500000.0f, -(float)(2 * i) / 16.0f);
    (void)hipMemsetAsync((unsigned char*)d_ws + WS_BAR, 0, 16384, stream);
    void* args[] = {&p};
    hipError_t e = hipLaunchCooperativeKernel((const void*)fwd_megakernel, dim3(grid_blocks), dim3(512), args, LDS_BYTES, stream);
    if (e != hipSuccess) fprintf(stderr, "cooperative launch failed: %s (grid %d)\n", hipGetErrorString(e), grid_blocks);
}
```

```cpp
#include <hip/hip_runtime.h>
#include <hip/hip_cooperative_groups.h>
#ifndef REP_PRO
#define REP_PRO 1
#endif
#ifndef REP_G1
#define REP_G1 1
#endif
#ifndef REP_MIXA
#define REP_MIXA 1
#endif
#ifndef REP_SCAN
#define REP_SCAN 1
#endif
#ifndef REP_HOUT
#define REP_HOUT 1
#endif
#ifndef REP_G2
#define REP_G2 1
#endif
#ifndef REP_LN
#define REP_LN 1
#endif
#include <cstdio>
#include <cmath>
namespace cg = cooperative_groups;

typedef unsigned short u16;
typedef short bf16x8 __attribute__((ext_vector_type(8)));
typedef short s16x4 __attribute__((ext_vector_type(4)));
typedef float f32x4 __attribute__((ext_vector_type(4)));
typedef unsigned u32x2 __attribute__((ext_vector_type(2)));
typedef unsigned u32x4 __attribute__((ext_vector_type(4)));
#define DI __device__ __forceinline__

constexpr int DM = 1024, NB = 16, SEQ = 4096, NTOKP = NB * SEQ, NTOKS = 256, MTOT = NTOKP + NTOKS;
constexpr int INW = 3072, MIXW = 1024;
constexpr int NCH = 1024, NUNIT = NCH + 16;
constexpr float ALPHA = 1.41421356237309515f;
constexpr int LDS_BYTES = 155648;

constexpr int C_UA = 0, C_VA = 256, C_ZA = 512, C_QB = 768, C_FB = 1024, C_IB = 1280, C_ZB = 1536, C_QC = 1792, C_KC = 2304, C_VC = 2432, C_ZC = 2560;

constexpr size_t WS_WTIN = 0;
constexpr size_t WS_WTOUT = WS_WTIN + 2ull * INW * DM * 2;
constexpr size_t WS_XB = WS_WTOUT + 2ull * DM * DM * 2;
constexpr size_t WS_H = WS_XB + (size_t)MTOT * DM * 2;
constexpr size_t WS_MIX = WS_H + (size_t)MTOT * INW * 2;
constexpr size_t WS_UT = WS_MIX + (size_t)MTOT * MIXW * 2;
constexpr size_t WS_SB = WS_UT + (size_t)NUNIT * 4 * 4096 * 4;
constexpr size_t WS_DEC = WS_SB + (size_t)NUNIT * 4 * 4096 * 2;
constexpr size_t WS_WSB = WS_DEC + (size_t)NUNIT * 4 * 64 * 4;
constexpr size_t WS_RT = WS_WSB + 2ull * 4 * 128 * 128 * 2;
constexpr size_t WS_KVS = WS_RT + 4112ull * 8 * 8;
constexpr size_t WS_LB = WS_KVS + 2ull * 16 * 144 * 256 * 2;
constexpr size_t WS_BAR = WS_LB + 2ull * 256 * 4;
constexpr size_t WS_END = WS_BAR + 16384;

constexpr size_t O_YP = 0;
constexpr size_t O_YS = O_YP + (size_t)NTOKP * DM;
constexpr size_t O_KP = O_YS + (size_t)NTOKS * DM;
constexpr size_t O_VP = O_KP + 2ull * 16 * 128 * 128;
constexpr size_t O_HP = O_VP + 2ull * 16 * 128 * 128;
constexpr size_t O_KS = O_HP + 2ull * 16 * 4 * 4096;
constexpr size_t O_VS = O_KS + 2ull * 16 * 16 * 128;
constexpr size_t O_HS = O_VS + 2ull * 16 * 16 * 128;
constexpr size_t O_SV = O_HS + 2ull * 16 * 4 * 4096;

struct Params {
    const float* x_prompt; const float* x_sample; const float* cache_k; const float* cache_v; const float* state_hgrn;
    const float* w_in; const float* ln_v_g; const float* ln_v_b; const float* w_s; const float* b_s; const float* lb_param;
    const float* norm_b_g; const float* sinks; const float* w_out; const float* ln_g; const float* ln_b;
    float* out; unsigned char* ws;
    float inv[8];
};

extern __shared__ __attribute__((aligned(16))) unsigned char shm[];

DI unsigned cvt_pk_bf16(float lo, float hi) { unsigned r; asm volatile("v_cvt_pk_bf16_f32 %0, %1, %2" : "=v"(r) : "v"(lo), "v"(hi)); return r; }
DI u16 f2bf(float x) { return (u16)(cvt_pk_bf16(x, 0.f) & 0xffffu); }
DI float bf2f(u16 v) { return __uint_as_float(((unsigned)v) << 16); }
DI unsigned f2h(float x) { return (unsigned)__builtin_bit_cast(u16, (_Float16)x); }
DI float h2f(u16 b) { return (float)__builtin_bit_cast(_Float16, b); }
DI float bflo(unsigned w) { return __uint_as_float(w << 16); }
DI float bfhi(unsigned w) { return __uint_as_float(w & 0xffff0000u); }
DI float silu_f(float x) { return x * __builtin_amdgcn_rcpf(1.f + __expf(-x)); }
DI float wave_sum(float v) {
#pragma unroll
    for (int o = 1; o < 64; o <<= 1) v += __shfl_xor(v, o);
    return v;
}
DI int tid_opaque() { int t = threadIdx.x; asm volatile("" : "+v"(t)); return t; }
DI s16x4 tr_read4(const u16* p) { return __builtin_amdgcn_ds_read_tr16_b64_v4i16((__attribute__((address_space(3))) s16x4*)p); }
#define MFMA16(a, b, c) __builtin_amdgcn_mfma_f32_16x16x32_bf16((a), (b), (c), 0, 0, 0)


#define XB_TMO      128
#define XB_XCNT(j)  (256  + 64 * (j))
#define XB_XSUB(j)  (1280 + 64 * (j))
#define XB_XGEN(j)  (2304 + 64 * (j))
#define XB_TOP      3328
#define XB_TOPGEN   3392
#define XCD_BAR_WORDS 3456
#define XB_SPIN_CAP (1u << 22)
#define LAS __attribute__((address_space(3)))
DI unsigned xb_ld(unsigned* p) { return __hip_atomic_load(p, __ATOMIC_RELAXED, __HIP_MEMORY_SCOPE_AGENT); }
DI unsigned xb_add(unsigned* p, unsigned v) { return __hip_atomic_fetch_add(p, v, __ATOMIC_RELAXED, __HIP_MEMORY_SCOPE_AGENT); }
DI unsigned xb_xcc_id() { return (unsigned)__builtin_amdgcn_s_getreg((3 << 11) | 20) & 0xFu; }
#define XB_SPIN(cond, bar) do { unsigned _sp = 0; while (cond) { __builtin_amdgcn_s_sleep(1); \
    if ((++_sp & 255u) == 0u) { if (xb_ld(&(bar)[XB_TMO])) break; if (_sp > XB_SPIN_CAP) { atomicAdd(&(bar)[XB_TMO], 1u); break; } } } } while (0)
struct XcdBarrier { unsigned* bar; unsigned x; volatile LAS unsigned* st; };
DI XcdBarrier xcd_barrier_post(unsigned* bar, volatile LAS unsigned* st) {
    XcdBarrier b; b.bar = bar; b.x = xb_xcc_id(); b.st = st;
    if (threadIdx.x == 0) (void)xb_add(&bar[XB_XCNT(b.x)], 1u);
    return b;
}
DI void xcd_barrier_complete(unsigned* bar, unsigned x, unsigned& nloc, unsigned& nx) {
    const unsigned G = gridDim.x * gridDim.y * gridDim.z;
    unsigned sum, cnt, mine, sp = 0u;
    for (;;) {
        sum = 0u; cnt = 0u; mine = 0u;
#pragma unroll
        for (unsigned j = 0; j < 16; ++j) { const unsigned c = xb_ld(&bar[XB_XCNT(j)]); sum += c; cnt += (c > 0u) ? 1u : 0u; mine = (j == x) ? c : mine; }
        if (sum == G) break;
        __builtin_amdgcn_s_sleep(1);
        if ((++sp & 255u) == 0u) { if (xb_ld(&bar[XB_TMO])) break; if (sp > XB_SPIN_CAP) { atomicAdd(&bar[XB_TMO], 1u); break; } }
    }
    nloc = mine > 0u ? mine : 1u; nx = cnt > 0u ? cnt : 1u;
}
DI void xcd_barrier(const XcdBarrier& b) {
    asm volatile("s_waitcnt vmcnt(0)" ::: "memory");
    __syncthreads();
    if (threadIdx.x == 0) {
        unsigned* bar = b.bar;
        __builtin_amdgcn_s_waitcnt(0);
        unsigned nloc = b.st[0], nx = b.st[1];
        if (nloc == 0u) { xcd_barrier_complete(bar, b.x, nloc, nx); b.st[0] = nloc; b.st[1] = nx; }
        const unsigned old = xb_add(&bar[XB_XSUB(b.x)], 1u);
        const unsigned gen = old / nloc;
        if (old + 1u == (gen + 1u) * nloc) {
            __builtin_amdgcn_fence(__ATOMIC_RELEASE, "agent");
            asm volatile("s_waitcnt vmcnt(0)" ::: "memory");
            const unsigned og = xb_add(&bar[XB_TOP], 1u);
            const unsigned tg = og / nx;
            if (og + 1u == (tg + 1u) * nx) xb_add(&bar[XB_TOPGEN], 1u);
            else XB_SPIN(xb_ld(&bar[XB_TOPGEN]) == tg, bar);
            __builtin_amdgcn_fence(__ATOMIC_ACQUIRE, "agent");
            xb_add(&bar[XB_XGEN(b.x)], 1u);
            asm volatile("s_waitcnt vmcnt(0)" ::: "memory");
        } else {
            XB_SPIN(xb_ld(&bar[XB_XGEN(b.x)]) == gen, bar);
            __builtin_amdgcn_fence(__ATOMIC_ACQUIRE, "agent");
            asm volatile("s_waitcnt vmcnt(0)" ::: "memory");
        }
    }
    __syncthreads();
}

constexpr int BM = 256, BK = 64, HALF = 128, NXCD = 8, WGM = 8, HT = HALF * BK;
DI int lds_byte(int r, int c) { int st = (r >> 4) * 2 + (c >> 5), rr = r & 15, cc = c & 31, ob = rr * 64 + cc * 2; return st * 1024 + (ob ^ (((ob >> 9) & 1) << 5)); }
DI void stage_rc(int b, int& R, int& C) { int st = b / 1024, sb = b % 1024, swz = sb ^ (((sb >> 9) & 1) << 5); R = (st >> 1) * 16 + swz / 64; C = (st & 1) * 32 + (swz % 64) / 2; }

DI int perm32(int rho) { const int n = rho >> 4, i = rho & 15; return 8 * (i >> 2) + 4 * n + (i & 3); }
struct Unit { int pm, pn; };
struct StaticOrder {
    int nM, nN, nwg, G, c, pm0, wgm;
    DI void init(int nM_, int nN_, int G_, int c_, int pm0_, int wgm_ = WGM) { nM = nM_; nN = nN_; nwg = nM * nN; G = G_; c = c_; pm0 = pm0_; wgm = wgm_; }
    DI bool next(int i, Unit& u) const {
        const long L = (long)i * G + c; if (c >= G || L >= nwg) return false;
        int wgid = (int)L; { const int q = nwg / NXCD, r = nwg % NXCD, xcd = wgid % NXCD, off = wgid / NXCD; wgid = (xcd < r ? xcd * (q + 1) : r * (q + 1) + (xcd - r) * q) + off; }
        const int nig = wgm * nN, gid = wgid / nig, fm = gid * wgm, gsz = (nM - fm) < wgm ? (nM - fm) : wgm;
        u.pm = pm0 + fm + ((wgid % nig) % gsz); u.pn = (wgid % nig) / gsz; return true;
    }
};
template <class Epi, class Sched>
DI void gemm_phase(const u16* __restrict__ A, const u16* __restrict__ Bt, const Sched& S, const Epi& E) {
    LAS unsigned char* lds = (LAS unsigned char*)shm;
    constexpr int K = 1024, nt = K / BK, HTB = HT * 2;
    const int tid = tid_opaque(), wid = __builtin_amdgcn_readfirstlane(tid >> 6), lane = tid & 63, wr = wid >> 2, wc = wid & 3, fr = lane & 15, fq = lane >> 4;
    unsigned voffA[2], voffB[2];
#pragma unroll
    for (int i = 0; i < 2; ++i) { int R, C; stage_rc(tid * 16 + i * 8192, R, C); const int Rb = (R & ~31) + perm32(R & 31);
        voffA[i] = (unsigned)(R * K + C) * 2u; voffB[i] = (unsigned)(Rb * K + C) * 2u; }
    const size_t kstep = (size_t)(BK * 2), hstep = (size_t)HALF * K * 2, tstep = 2 * hstep;
    const unsigned ldsw = (unsigned)wid * 1024u;
    const int aoff = lds_byte(wr * 64 + fr, fq * 8), boff = lds_byte(wc * 32 + fr, fq * 8);
#define SA(b, h) (((b) * 2 + (h)) * HTB)
#define SB(b, h) ((4 + (b) * 2 + (h)) * HTB)
#define STAGE(bufoff, gbase, voff) do { _Pragma("unroll") for (int _i = 0; _i < 2; ++_i) \
    __builtin_amdgcn_global_load_lds((const unsigned*)((const char*)(gbase) + (voff)[_i]), (LAS unsigned*)(lds + (bufoff) + ldsw + _i * 8192), 16, 0, 0); } while (0)
#define LDA(dst, b, h) do { _Pragma("unroll") for (int m = 0; m < 4; ++m) _Pragma("unroll") for (int k = 0; k < 2; ++k) dst[m][k] = *(const LAS bf16x8*)(lds + SA(b, h) + aoff + m * 2048 + k * 1024); } while (0)
#define LDB(dst, b, h) do { _Pragma("unroll") for (int n = 0; n < 2; ++n) _Pragma("unroll") for (int k = 0; k < 2; ++k) dst[n][k] = *(const LAS bf16x8*)(lds + SB(b, h) + boff + n * 2048 + k * 1024); } while (0)
#define MMA(ai, bj, At, Bt_) do { __builtin_amdgcn_s_setprio(1); _Pragma("unroll") for (int m = 0; m < 4; ++m) _Pragma("unroll") for (int n = 0; n < 2; ++n) _Pragma("unroll") for (int k = 0; k < 2; ++k) \
      acc[ai][bj][m][n] = MFMA16(Bt_[n][k], At[m][k], acc[ai][bj][m][n]); \
    __builtin_amdgcn_s_setprio(0); } while (0)
#define WAIT_V(n) asm volatile("s_waitcnt vmcnt(" #n ")" ::: "memory")
#define WAIT_L(n) asm volatile("s_waitcnt lgkmcnt(" #n ")" ::: "memory")
#define BAR __builtin_amdgcn_s_barrier()
#define SCHED __builtin_amdgcn_sched_barrier(0)
    Unit cur, nxt; int ui = 0;
    if (!S.next(0, cur)) return;
    f32x4 acc[2][2][4][2];
#pragma unroll
    for (int a = 0; a < 2; ++a)
#pragma unroll
        for (int b = 0; b < 2; ++b)
#pragma unroll
            for (int m = 0; m < 4; ++m)
#pragma unroll
                for (int n = 0; n < 2; ++n) acc[a][b][m][n] = (f32x4){0.f, 0.f, 0.f, 0.f};
    bf16x8 At[4][2], B0[2][2], B1[2][2];
    const char* cA = (const char*)A + (size_t)cur.pm * tstep; const char* cB = (const char*)Bt + (size_t)cur.pn * tstep;
    STAGE(SB(0, 0), cB, voffB); STAGE(SB(0, 1), cB + hstep, voffB); STAGE(SA(0, 0), cA, voffA); STAGE(SA(0, 1), cA + hstep, voffA);
    if (wr == 1) BAR;
    WAIT_V(2); BAR;
    STAGE(SB(1, 0), cB + kstep, voffB); STAGE(SA(1, 0), cA + kstep, voffA); STAGE(SB(1, 1), cB + hstep + kstep, voffB);
    WAIT_V(6); BAR;
    for (;;) {
        const bool has_next = S.next(ui + 1, nxt);
        const char* nA = has_next ? (const char*)A + (size_t)nxt.pm * tstep : cA; const char* nB = has_next ? (const char*)Bt + (size_t)nxt.pn * tstep : cB;
        for (int t = 0; t < nt; t += 2) {
            const bool last = (t == nt - 2);
            const char* a1 = cA + (size_t)(t + 1) * kstep;
            const char* a2 = last ? nA : cA + (size_t)(t + 2) * kstep; const char* b2 = last ? nB : cB + (size_t)(t + 2) * kstep;
            const char* a3 = a2 + kstep; const char* b3 = b2 + kstep;
            LDB(B0, 0, 0); LDB(B1, 0, 1); SCHED; LDA(At, 0, 0); STAGE(SA(1, 1), a1 + hstep, voffA);
            WAIT_V(8); WAIT_L(0); BAR; MMA(0, 0, At, B0); MMA(0, 1, At, B1); BAR; SCHED;
            LDA(At, 0, 1); STAGE(SB(0, 0), b2, voffB); STAGE(SB(0, 1), b2 + hstep, voffB); STAGE(SA(0, 0), a2, voffA);
            WAIT_V(8); WAIT_L(0); BAR; MMA(1, 0, At, B0); MMA(1, 1, At, B1); BAR; SCHED;
            LDB(B0, 1, 0); LDB(B1, 1, 1); SCHED; LDA(At, 1, 0); STAGE(SA(0, 1), a2 + hstep, voffA);
            WAIT_V(8); WAIT_L(0); BAR; MMA(0, 0, At, B0); MMA(0, 1, At, B1); BAR; SCHED;
            LDA(At, 1, 1); STAGE(SB(1, 0), b3, voffB); STAGE(SB(1, 1), b3 + hstep, voffB); STAGE(SA(1, 0), a3, voffA);
            WAIT_V(8); WAIT_L(0); BAR; MMA(1, 0, At, B0); MMA(1, 1, At, B1); BAR; SCHED;
        }
        if (wr == 0) BAR;
        E(acc, cur.pm * BM, cur.pn * BM, wr, wc, fr, fq);
        if (!has_next) break;
#pragma unroll
        for (int a = 0; a < 2; ++a)
#pragma unroll
            for (int b = 0; b < 2; ++b)
#pragma unroll
                for (int m = 0; m < 4; ++m)
#pragma unroll
                    for (int n = 0; n < 2; ++n) acc[a][b][m][n] = (f32x4){0.f, 0.f, 0.f, 0.f};
        cur = nxt; cA = nA; cB = nB; ++ui;
        if (wr == 1) BAR;
    }
    WAIT_V(0);
    BAR;
    __syncthreads();
#undef SA
#undef SB
#undef STAGE
#undef LDA
#undef LDB
#undef MMA
}

struct EpiIn {
    unsigned char* ws; float* out; int l;
    DI void operator()(const f32x4 (&acc)[2][2][4][2], int brow, int bcol, int wr, int wc, int fr, int fq) const {
        int ll = l; asm volatile("" : "+s"(ll));
        u16* H = (u16*)(ws + WS_H); const float* RT = (const float*)(ws + WS_RT);
        float* okp = out + O_KP + (size_t)ll * 16 * 128 * 128; float* ovp = out + O_VP + (size_t)ll * 16 * 128 * 128;
        float* oks = out + O_KS + (size_t)ll * 16 * 16 * 128; float* ovs = out + O_VS + (size_t)ll * 16 * 16 * 128;
        u16* KVS = (u16*)(ws + WS_KVS) + (size_t)ll * 16 * 144 * 256;
        int type[2];
#pragma unroll
        for (int bj = 0; bj < 2; ++bj) {
            const int cb = bcol + bj * HALF; int ty;
            if (cb < C_ZA) ty = 0; else if (cb < C_FB) ty = 1; else if (cb < C_IB) ty = 5; else if (cb < C_ZB) ty = 0; else if (cb < C_QC) ty = 1;
            else if (cb < C_KC) ty = 2; else if (cb == C_KC) ty = 3; else if (cb == C_VC) ty = 4; else ty = 1;
            type[bj] = ty;
        }
        const int cin = wc * 32 + fq * 8;
        f32x4 lbv[2][2];
#pragma unroll
        for (int bj = 0; bj < 2; ++bj) {
            lbv[bj][0] = (f32x4){0.f, 0.f, 0.f, 0.f}; lbv[bj][1] = (f32x4){0.f, 0.f, 0.f, 0.f};
            if (type[bj] == 5) { const float* lbp = (const float*)(ws + WS_LB) + ll * 256 + (bcol + bj * HALF - C_FB) + cin; lbv[bj][0] = *(const f32x4*)lbp; lbv[bj][1] = *(const f32x4*)(lbp + 4); }
        }
#pragma unroll
        for (int ai = 0; ai < 2; ++ai)
#pragma unroll
            for (int m = 0; m < 4; ++m) {
                const int row = brow + ai * HALF + wr * 64 + m * 16 + fr;
                int posidx, kvo = -1; float* ko = nullptr; float* vo = nullptr; u16* kvs = nullptr;
                if (row < NTOKP) { const int b = row >> 12, t = row & 4095; posidx = t;
                    if (t >= SEQ - 128) { kvo = (b * 128 + (t - (SEQ - 128))) * 128; ko = okp; vo = ovp; } }
                else { const int s = row - NTOKP, sb = s >> 4, st = s & 15; posidx = 4096 + st; kvo = (sb * 16 + st) * 128; ko = oks; vo = ovs; kvs = KVS + (size_t)(sb * 144 + 128 + st) * 256; }
                u16* hrow = H + (size_t)row * INW;
#pragma unroll
                for (int bj = 0; bj < 2; ++bj) {
                    const int cb = bcol + bj * HALF, ty = type[bj];
                    f32x4 v0 = acc[ai][bj][m][0], v1 = acc[ai][bj][m][1];
                    if (ty == 1) {
#pragma unroll
                        for (int j = 0; j < 4; ++j) { v0[j] = silu_f(v0[j]); v1[j] = silu_f(v1[j]); }
                    } else if (ty == 5) {
                        const f32x4 l0 = lbv[bj][0], l1 = lbv[bj][1];
#pragma unroll
                        for (int j = 0; j < 4; ++j) {
                            const float t0 = __expf(-v0[j]), t1 = __expf(-v1[j]);
                            const float s0 = __builtin_amdgcn_rcpf(1.f + t0), s1 = __builtin_amdgcn_rcpf(1.f + t1);
                            const float k0 = (1.f - l0[j]) * t0 * s0, k1 = (1.f - l1[j]) * t1 * s1;
                            const float f0 = l0[j] + (1.f - l0[j]) * s0, f1 = l1[j] + (1.f - l1[j]) * s1;
                            v0[j] = (k0 <= 0.5f) ? k0 : -f0; v1[j] = (k1 <= 0.5f) ? k1 : -f1;
                        }
                    } else if (ty == 2 || ty == 3) {
                        if ((wc & 1) == 0) {
                            const f32x4 c0 = *(const f32x4*)(RT + (size_t)posidx * 16), c1 = *(const f32x4*)(RT + (size_t)posidx * 16 + 4), c2 = *(const f32x4*)(RT + (size_t)posidx * 16 + 8), c3 = *(const f32x4*)(RT + (size_t)posidx * 16 + 12);
                            const float cs[8] = {c0[0], c0[2], c1[0], c1[2], c2[0], c2[2], c3[0], c3[2]}, sn[8] = {c0[1], c0[3], c1[1], c1[3], c2[1], c2[3], c3[1], c3[3]};
#pragma unroll
                            for (int e = 0; e < 8; ++e) {
                                const float mine = (e < 4) ? v0[e & 3] : v1[e & 3];
                                const float pv = __shfl_xor(mine, 16);
                                const float rot = (fq == 0) ? (mine * cs[e] - pv * sn[e]) : (mine * cs[e] + pv * sn[e]);
                                const float res = (fq < 2) ? rot : mine;
                                if (e < 4) v0[e & 3] = res; else v1[e & 3] = res;
                            }
                        }
                        if (ty == 3) { if (kvo >= 0) { *(f32x4*)(ko + kvo + cin) = v0; *(f32x4*)(ko + kvo + cin + 4) = v1; } }
                        else { v0 = v0 * 0.18033688011112042f; v1 = v1 * 0.18033688011112042f; }
                    } else if (ty == 4) { if (kvo >= 0) { *(f32x4*)(vo + kvo + cin) = v0; *(f32x4*)(vo + kvo + cin + 4) = v1; } }
                    u32x4 w; w.x = cvt_pk_bf16(v0[0], v0[1]); w.y = cvt_pk_bf16(v0[2], v0[3]); w.z = cvt_pk_bf16(v1[0], v1[1]); w.w = cvt_pk_bf16(v1[2], v1[3]);
                    if (ty == 5) {
                        w.x = f2h(v0[0]) | (f2h(v0[1]) << 16); w.y = f2h(v0[2]) | (f2h(v0[3]) << 16); w.z = f2h(v1[0]) | (f2h(v1[1]) << 16); w.w = f2h(v1[2]) | (f2h(v1[3]) << 16);
                    }
                    __builtin_nontemporal_store(w, (u32x4*)(hrow + cb + cin));
                    if ((ty == 3 || ty == 4) && kvs) *(u32x4*)(kvs + (cb + cin - C_KC)) = w;
                }
                asm volatile("" ::: "memory");
            }
    }
};
struct EpiOut {
    unsigned char* ws;
    DI void operator()(const f32x4 (&acc)[2][2][4][2], int brow, int bcol, int wr, int wc, int fr, int fq) const {
        size_t zo = WS_H; asm volatile("" : "+s"(zo));
        u16* Z = (u16*)(ws + zo); const u16* XB = (const u16*)(ws + zo - WS_H + WS_XB);
        u32x4 xw[2][4][2];
#pragma unroll
        for (int ai = 0; ai < 2; ++ai)
#pragma unroll
            for (int m = 0; m < 4; ++m)
#pragma unroll
                for (int bj = 0; bj < 2; ++bj)
                    xw[ai][m][bj] = *(const u32x4*)(XB + (size_t)(brow + ai * HALF + wr * 64 + m * 16 + fr) * DM + bcol + bj * HALF + wc * 32 + fq * 8);
#pragma unroll
        for (int ai = 0; ai < 2; ++ai)
#pragma unroll
            for (int m = 0; m < 4; ++m) {
                const int row = brow + ai * HALF + wr * 64 + m * 16 + fr;
#pragma unroll
                for (int bj = 0; bj < 2; ++bj) {
                    const int col0 = bcol + bj * HALF + wc * 32 + fq * 8;
                    const u32x4 x4 = xw[ai][m][bj];
                    f32x4 v0 = acc[ai][bj][m][0], v1 = acc[ai][bj][m][1];
                    v0[0] += ALPHA * bflo(x4.x); v0[1] += ALPHA * bfhi(x4.x); v0[2] += ALPHA * bflo(x4.y); v0[3] += ALPHA * bfhi(x4.y);
                    v1[0] += ALPHA * bflo(x4.z); v1[1] += ALPHA * bfhi(x4.z); v1[2] += ALPHA * bflo(x4.w); v1[3] += ALPHA * bfhi(x4.w);
                    u32x4 w; w.x = cvt_pk_bf16(v0[0], v0[1]); w.y = cvt_pk_bf16(v0[2], v0[3]); w.z = cvt_pk_bf16(v1[0], v1[1]); w.w = cvt_pk_bf16(v1[2], v1[3]);
                    __builtin_nontemporal_store(w, (u32x4*)(Z + (size_t)row * DM + col0));
                }
            }
    }
};

DI void phase_prologue(const Params& p) {
    const int tid = tid_opaque();
    const long gt = (long)blockIdx.x * 512 + tid, nth = (long)gridDim.x * 512;
    unsigned char* ws = p.ws;
    const int NTW = (gridDim.x >= 256) ? 48 : 0;
    const bool do_cvt = (NTW == 0) || ((int)blockIdx.x >= NTW), do_tr = (NTW == 0) || ((int)blockIdx.x < NTW);
    const long gtc = (long)((int)blockIdx.x - NTW) * 512 + tid, nthc = (long)((int)gridDim.x - NTW) * 512;
    if (do_cvt) {
        u16* XB = (u16*)(ws + WS_XB);
        const long nv = (long)MTOT * DM / 8;
        const long nth = nthc;
        for (long i0 = gtc; i0 < nv; i0 += 4 * nth) {
            f32x4 a[4], b[4];
#pragma unroll
            for (int k = 0; k < 4; ++k) {
                const long i = i0 + k * nth;
                const long e = (i < nv ? i : i0) * 8;
                const float* sp = (e < (long)NTOKP * DM) ? (p.x_prompt + e) : (p.x_sample + (e - (long)NTOKP * DM));
                a[k] = __builtin_nontemporal_load((const f32x4*)sp); b[k] = __builtin_nontemporal_load((const f32x4*)(sp + 4));
            }
#pragma unroll
            for (int k = 0; k < 4; ++k) {
                const long i = i0 + k * nth;
                if (i < nv) {
                    u32x4 o; o.x = cvt_pk_bf16(a[k][0], a[k][1]); o.y = cvt_pk_bf16(a[k][2], a[k][3]); o.z = cvt_pk_bf16(b[k][0], b[k][1]); o.w = cvt_pk_bf16(b[k][2], b[k][3]);
                    *(u32x4*)(XB + i * 8) = o;
                }
            }
        }
    }
    if (do_tr) {
        float* tile = (float*)shm;
        const int T_IN = 16 * 48, T_OUT = 16 * 16, NT = 2 * T_IN + 2 * T_OUT;
        const int trs = NTW ? NTW : (int)gridDim.x;
        for (int it = blockIdx.x; it < NT; it += trs) {
            const float* W; u16* WT; int N, r = it;
            if (r < 2 * T_IN) { const int l = r / T_IN; r -= l * T_IN; W = p.w_in + (size_t)l * DM * INW; WT = (u16*)(ws + WS_WTIN) + (size_t)l * INW * DM; N = INW; }
            else { r -= 2 * T_IN; const int l = r / T_OUT; r -= l * T_OUT; W = p.w_out + (size_t)l * MIXW * DM; WT = (u16*)(ws + WS_WTOUT) + (size_t)l * DM * MIXW; N = DM; }
            const int nb = N / 64, k0 = (r / nb) * 64, n0 = (r % nb) * 64;
#pragma unroll
            for (int i = 0; i < 8; ++i) { const int idx = tid + i * 512, kk = idx >> 6, nn = idx & 63; tile[kk * 65 + nn] = W[(size_t)(k0 + kk) * N + n0 + nn]; }
            __syncthreads();
#pragma unroll
            for (int i = 0; i < 8; ++i) { const int idx = tid + i * 512, nn = idx >> 6, kk = idx & 63; WT[(size_t)(n0 + nn) * 1024 + k0 + kk] = f2bf(tile[kk * 65 + nn]); }
            __syncthreads();
        }
    }
    {
        u16* WSB = (u16*)(ws + WS_WSB);
        for (long i = gt; i < 2 * 4 * 128 * 128; i += nth) { const int jj = i & 127, ii = (i >> 7) & 127; WSB[i] = ((jj >> 6) <= (ii >> 6)) ? f2bf(p.w_s[i]) : (u16)0; }
    }
    {
        float2* RT = (float2*)(ws + WS_RT);
        for (long i = gt; i < 4112 * 8; i += nth) {
            const int pi = (int)(i >> 3), fi = (int)(i & 7);
            const int pos = pi < 4096 ? pi : 2048 + (pi - 4096);
            const float ang = (float)pos * p.inv[fi];
            double r = (double)ang * 0.15915494309189533577; r -= rint(r);
            const float rf = (float)r;
            RT[i] = make_float2(__builtin_amdgcn_cosf(rf), __builtin_amdgcn_sinf(rf));
        }
    }
    {
        u16* KVS = (u16*)(ws + WS_KVS);
        for (long i = gt; i < 2 * 16 * 128 * 256; i += nth) {
            const int c = i & 255, row = (i >> 8) & 127, lb = (int)(i >> 15);
            const float v = (c < 128) ? p.cache_k[((size_t)lb * 128 + row) * 128 + c] : p.cache_v[((size_t)lb * 128 + row) * 128 + (c - 128)];
            KVS[((size_t)lb * 144 + row) * 256 + c] = f2bf(v);
        }
    }
    {
        float* LB = (float*)(ws + WS_LB);
        for (long i = gt; i < 256; i += nth) {
            const float a = p.lb_param[i], b = p.lb_param[256 + i], m = fmaxf(a, b);
            const float ea = expf(a - m), eb = expf(b - m);
            LB[i] = 0.f; LB[256 + i] = eb / (ea + eb);
        }
    }
}

constexpr int VROW = 72;
DI void attn_unit(const u16* __restrict__ Q, int qstride, int nq, const u16* __restrict__ Kp, const u16* __restrict__ Vp, int kvstride, int nkeys,
                  const u16* __restrict__ Zg, int zstride, u16* __restrict__ Out, int ostride, const float* __restrict__ sinks4) {
    u16* Vl = (u16*)shm;
    const int tid = tid_opaque(), wid = __builtin_amdgcn_readfirstlane(tid >> 6), lane = tid & 63, fr = lane & 15, fq = lane >> 4;
    const int nk32 = (nkeys + 31) & ~31, nkt = nk32 >> 4, nks = nk32 >> 5;
    const int r = wid >> 1, q0 = (wid & 1) * 32;
    const bool active = q0 < nq;
    u32x4 vreg[3];
#pragma unroll
    for (int i = 0; i < 3; ++i) {
        const int idx = tid + i * 512, key = idx >> 3, d0 = (idx & 7) * 8;
        vreg[i] = (u32x4){0u, 0u, 0u, 0u};
        if (key < nkeys) vreg[i] = *(const u32x4*)(Vp + (size_t)key * kvstride + d0);
    }
    bf16x8 bq[2][2], ak[12][2];
    if (active) {
#pragma unroll
        for (int qt = 0; qt < 2; ++qt)
#pragma unroll
            for (int ks = 0; ks < 2; ++ks) { const int qrow = min(q0 + qt * 16 + fr, nq - 1); bq[qt][ks] = *(const bf16x8*)(Q + (size_t)qrow * qstride + r * 64 + ks * 32 + fq * 8); }
#pragma unroll
        for (int kt = 0; kt < 12; ++kt) if (kt < nkt) {
            const int krow = min(kt * 16 + fr, nkeys - 1);
            ak[kt][0] = *(const bf16x8*)(Kp + (size_t)krow * kvstride + fq * 8); ak[kt][1] = *(const bf16x8*)(Kp + (size_t)krow * kvstride + 32 + fq * 8);
        }
    }
#pragma unroll
    for (int i = 0; i < 3; ++i) {
        const int idx = tid + i * 512, key = idx >> 3, d0 = (idx & 7) * 8;
        if (key < nk32) *(u32x4*)(Vl + key * VROW + d0) = vreg[i];
    }
    __syncthreads();
    if (active) {
        f32x4 st[12][2];
#pragma unroll
        for (int kt = 0; kt < 12; ++kt) {
            st[kt][0] = (f32x4){0.f, 0.f, 0.f, 0.f}; st[kt][1] = (f32x4){0.f, 0.f, 0.f, 0.f};
            if (kt < nkt) {
#pragma unroll
                for (int qt = 0; qt < 2; ++qt) { st[kt][qt] = MFMA16(ak[kt][0], bq[qt][0], st[kt][qt]); st[kt][qt] = MFMA16(ak[kt][1], bq[qt][1], st[kt][qt]); }
            }
        }
        u32x2 zw[2][4];
#pragma unroll
        for (int qt = 0; qt < 2; ++qt) {
            const int q = min(q0 + qt * 16 + fr, nq - 1);
#pragma unroll
            for (int dt = 0; dt < 4; ++dt) zw[qt][dt] = *(const u32x2*)(Zg + (size_t)q * zstride + r * 64 + dt * 16 + fq * 4);
        }
        const float sink = sinks4[r] * 1.4426950408889634f;
        float inv_den[2];
        bf16x8 pb[2][6];
#pragma unroll
        for (int qt = 0; qt < 2; ++qt) {
            float mx = sink;
#pragma unroll
            for (int kt = 0; kt < 12; ++kt) if (kt < nkt) {
#pragma unroll
                for (int j = 0; j < 4; ++j) { const int key = kt * 16 + fq * 4 + j; float s = st[kt][qt][j]; if (key >= nkeys) s = -INFINITY; st[kt][qt][j] = s; mx = fmaxf(mx, s); }
            }
            mx = fmaxf(mx, __shfl_xor(mx, 16)); mx = fmaxf(mx, __shfl_xor(mx, 32));
            float sum = 0.f;
#pragma unroll
            for (int kt = 0; kt < 12; ++kt) if (kt < nkt) {
#pragma unroll
                for (int j = 0; j < 4; ++j) { const float e = __builtin_amdgcn_exp2f(st[kt][qt][j] - mx); st[kt][qt][j] = e; sum += e; }
            }
            sum += __shfl_xor(sum, 16); sum += __shfl_xor(sum, 32);
            inv_den[qt] = 1.f / (sum + __builtin_amdgcn_exp2f(sink - mx));
#pragma unroll
            for (int s2 = 0; s2 < 6; ++s2) {
                u32x4 w;
                w.x = cvt_pk_bf16(st[2 * s2][qt][0], st[2 * s2][qt][1]); w.y = cvt_pk_bf16(st[2 * s2][qt][2], st[2 * s2][qt][3]);
                w.z = cvt_pk_bf16(st[2 * s2 + 1][qt][0], st[2 * s2 + 1][qt][1]); w.w = cvt_pk_bf16(st[2 * s2 + 1][qt][2], st[2 * s2 + 1][qt][3]);
                pb[qt][s2] = __builtin_bit_cast(bf16x8, w);
            }
        }
        f32x4 o[4][2];
#pragma unroll
        for (int dt = 0; dt < 4; ++dt) { o[dt][0] = (f32x4){0.f, 0.f, 0.f, 0.f}; o[dt][1] = (f32x4){0.f, 0.f, 0.f, 0.f}; }
#pragma unroll
        for (int s2 = 0; s2 < 6; ++s2) if (s2 < nks) {
#pragma unroll
            for (int dt = 0; dt < 4; ++dt) {
                const u16* vr = Vl + (32 * s2 + 4 * fq + (fr >> 2)) * VROW + dt * 16 + 4 * (fr & 3);
                const s16x4 lo = tr_read4(vr), hi = tr_read4(vr + 16 * VROW);
                const bf16x8 a = __builtin_shufflevector(lo, hi, 0, 1, 2, 3, 4, 5, 6, 7);
                o[dt][0] = MFMA16(a, pb[0][s2], o[dt][0]); o[dt][1] = MFMA16(a, pb[1][s2], o[dt][1]);
            }
        }
#pragma unroll
        for (int qt = 0; qt < 2; ++qt) {
            const int q = q0 + qt * 16 + fr;
            if (q < nq) {
#pragma unroll
                for (int dt = 0; dt < 4; ++dt) {
                    const int d = dt * 16 + fq * 4;
                    const u32x2 z2 = zw[qt][dt];
                    const f32x4 ov = o[dt][qt] * inv_den[qt];
                    u32x2 w; w.x = cvt_pk_bf16(ov[0] * bflo(z2.x), ov[1] * bfhi(z2.x)); w.y = cvt_pk_bf16(ov[2] * bflo(z2.y), ov[3] * bfhi(z2.y));
                    *(u32x2*)(Out + (size_t)q * ostride + r * 64 + d) = w;
                }
            }
        }
    }
    __syncthreads();
}

DI void attn_run(const Params& p, int l, int run) {
    unsigned char* ws = p.ws;
    const u16* H = (const u16*)(ws + WS_H); u16* MIX = (u16*)(ws + WS_MIX);
    u16* Kl = (u16*)shm; u16* Vl = Kl + 4 * 64 * VROW;
    const int tid = tid_opaque(), wid = __builtin_amdgcn_readfirstlane(tid >> 6), lane = tid & 63, fr = lane & 15, fq = lane >> 4;
    const int r = wid >> 1, q0 = (wid & 1) * 32;
    const int b = run >> 4, g = (run >> 3) & 1, c0 = (run & 7) * 8;
    const u16* Hb = H + (size_t)b * SEQ * INW;
    u16* Mb = MIX + (size_t)b * SEQ * MIXW;
    const int lkey = tid >> 3, ld0 = (tid & 7) * 8;
    const float sink = p.sinks[l * 8 + g * 4 + r] * 1.4426950408889634f;
    {
        u32x4 kv3[3], vv3[3];
#pragma unroll
        for (int i = 0; i < 3; ++i) {
            const int ch = c0 - 2 + i;
            kv3[i] = (u32x4){0u, 0u, 0u, 0u}; vv3[i] = (u32x4){0u, 0u, 0u, 0u};
            if (ch >= 0) { const u16* srow = Hb + (size_t)(ch * 64 + lkey) * INW; kv3[i] = *(const u32x4*)(srow + C_KC + g * 64 + ld0); vv3[i] = *(const u32x4*)(srow + C_VC + g * 64 + ld0); }
        }
#pragma unroll
        for (int i = 0; i < 3; ++i) {
            const int ch = c0 - 2 + i;
            if (ch >= 0) { *(u32x4*)(Kl + ((ch & 3) * 64 + lkey) * VROW + ld0) = kv3[i]; *(u32x4*)(Vl + ((ch & 3) * 64 + lkey) * VROW + ld0) = vv3[i]; }
        }
    }
    bf16x8 bq[2][2];
#pragma unroll
    for (int qt = 0; qt < 2; ++qt)
#pragma unroll
        for (int ks = 0; ks < 2; ++ks) bq[qt][ks] = *(const bf16x8*)(Hb + (size_t)(c0 * 64 + q0 + qt * 16 + fr) * INW + C_QC + g * 256 + r * 64 + ks * 32 + fq * 8);
    __syncthreads();
#pragma unroll 1
    for (int u = 0; u < 8; ++u) {
        const int c = c0 + u;
        const int nch = min(c + 1, 3), cf = c - nch + 1, nkt = nch * 4;
        u32x4 kn = {0u, 0u, 0u, 0u}, vn = {0u, 0u, 0u, 0u}; bf16x8 bqn[2][2];
        if (u < 7) {
            const u16* srow = Hb + (size_t)((c + 1) * 64 + lkey) * INW;
            kn = *(const u32x4*)(srow + C_KC + g * 64 + ld0); vn = *(const u32x4*)(srow + C_VC + g * 64 + ld0);
#pragma unroll
            for (int qt = 0; qt < 2; ++qt)
#pragma unroll
                for (int ks = 0; ks < 2; ++ks) bqn[qt][ks] = *(const bf16x8*)(Hb + (size_t)((c + 1) * 64 + q0 + qt * 16 + fr) * INW + C_QC + g * 256 + r * 64 + ks * 32 + fq * 8);
        } else {
#pragma unroll
            for (int qt = 0; qt < 2; ++qt)
#pragma unroll
                for (int ks = 0; ks < 2; ++ks) bqn[qt][ks] = bq[qt][ks];
        }
        u32x4 zw[2][2];
#pragma unroll
        for (int qt = 0; qt < 2; ++qt)
#pragma unroll
            for (int dd = 0; dd < 2; ++dd) zw[qt][dd] = *(const u32x4*)(Hb + (size_t)(c * 64 + q0 + qt * 16 + fr) * INW + C_ZC + g * 256 + r * 64 + dd * 32 + fq * 8);
        f32x4 st[12][2];
#pragma unroll
        for (int kt = 0; kt < 12; ++kt) {
            st[kt][0] = (f32x4){0.f, 0.f, 0.f, 0.f}; st[kt][1] = (f32x4){0.f, 0.f, 0.f, 0.f};
            if (kt < nkt) {
                const int row = (((cf + (kt >> 2)) & 3) * 64 + (kt & 3) * 16 + fr);
                const bf16x8 a0 = *(const bf16x8*)(Kl + row * VROW + fq * 8), a1 = *(const bf16x8*)(Kl + row * VROW + 32 + fq * 8);
#pragma unroll
                for (int qt = 0; qt < 2; ++qt) { st[kt][qt] = MFMA16(a0, bq[qt][0], st[kt][qt]); st[kt][qt] = MFMA16(a1, bq[qt][1], st[kt][qt]); }
            }
        }
        float inv_den[2];
        bf16x8 pb[2][6];
#pragma unroll
        for (int qt = 0; qt < 2; ++qt) {
            float mx = sink;
#pragma unroll
            for (int kt = 0; kt < 12; ++kt) if (kt < nkt) {
#pragma unroll
                for (int j = 0; j < 4; ++j) mx = fmaxf(mx, st[kt][qt][j]);
            }
            mx = fmaxf(mx, __shfl_xor(mx, 16)); mx = fmaxf(mx, __shfl_xor(mx, 32));
            float sum = 0.f;
#pragma unroll
            for (int kt = 0; kt < 12; ++kt) {
                if (kt < nkt) {
#pragma unroll
                    for (int j = 0; j < 4; ++j) { const float e = __builtin_amdgcn_exp2f(st[kt][qt][j] - mx); st[kt][qt][j] = e; sum += e; }
                }
            }
            sum += __shfl_xor(sum, 16); sum += __shfl_xor(sum, 32);
            inv_den[qt] = 1.f / (sum + __builtin_amdgcn_exp2f(sink - mx));
#pragma unroll
            for (int s2 = 0; s2 < 6; ++s2) {
                u32x4 w;
                w.x = cvt_pk_bf16(st[2 * s2][qt][0], st[2 * s2][qt][1]); w.y = cvt_pk_bf16(st[2 * s2][qt][2], st[2 * s2][qt][3]);
                w.z = cvt_pk_bf16(st[2 * s2 + 1][qt][0], st[2 * s2 + 1][qt][1]); w.w = cvt_pk_bf16(st[2 * s2 + 1][qt][2], st[2 * s2 + 1][qt][3]);
                pb[qt][s2] = __builtin_bit_cast(bf16x8, w);
            }
        }
        f32x4 o[4][2];
#pragma unroll
        for (int dt = 0; dt < 4; ++dt) { o[dt][0] = (f32x4){0.f, 0.f, 0.f, 0.f}; o[dt][1] = (f32x4){0.f, 0.f, 0.f, 0.f}; }
#pragma unroll
        for (int s2 = 0; s2 < 6; ++s2) if (s2 < nch * 2) {
            const int rowb = ((cf + (s2 >> 1)) & 3) * 64 + (s2 & 1) * 32;
#pragma unroll
            for (int dt = 0; dt < 4; ++dt) {
                const u16* vr = Vl + (rowb + 4 * fq + (fr >> 2)) * VROW + (dt >> 1) * 32 + 8 * (fr & 3) + 4 * (dt & 1);
                const s16x4 lo = tr_read4(vr), hi = tr_read4(vr + 16 * VROW);
                const bf16x8 a = __builtin_shufflevector(lo, hi, 0, 1, 2, 3, 4, 5, 6, 7);
                o[dt][0] = MFMA16(a, pb[0][s2], o[dt][0]); o[dt][1] = MFMA16(a, pb[1][s2], o[dt][1]);
            }
        }
#pragma unroll
        for (int qt = 0; qt < 2; ++qt) {
            u16* orow = Mb + (size_t)(c * 64 + q0 + qt * 16 + fr) * MIXW + 512 + g * 256 + r * 64;
#pragma unroll
            for (int dd = 0; dd < 2; ++dd) {
                const u32x4 z4 = zw[qt][dd];
                const f32x4 oa = o[2 * dd][qt] * inv_den[qt], ob = o[2 * dd + 1][qt] * inv_den[qt];
                u32x4 w;
                w.x = cvt_pk_bf16(oa[0] * bflo(z4.x), oa[1] * bfhi(z4.x)); w.y = cvt_pk_bf16(oa[2] * bflo(z4.y), oa[3] * bfhi(z4.y));
                w.z = cvt_pk_bf16(ob[0] * bflo(z4.z), ob[1] * bfhi(z4.z)); w.w = cvt_pk_bf16(ob[2] * bflo(z4.w), ob[3] * bfhi(z4.w));
                *(u32x4*)(orow + dd * 32 + fq * 8) = w;
            }
        }
        if (u < 7) {
            *(u32x4*)(Kl + (((c + 1) & 3) * 64 + lkey) * VROW + ld0) = kn; *(u32x4*)(Vl + (((c + 1) & 3) * 64 + lkey) * VROW + ld0) = vn;
        }
#pragma unroll
        for (int qt = 0; qt < 2; ++qt)
#pragma unroll
            for (int ks = 0; ks < 2; ++ks) bq[qt][ks] = bqn[qt][ks];
        __syncthreads();
    }
}

constexpr int VS2 = 272;
DI void sgu_prompt_unit(const Params& p, int l, int unit) {
    unsigned char* ws = p.ws;
    const u16* H = (const u16*)(ws + WS_H); u16* MIX = (u16*)(ws + WS_MIX);
    const u16* WSB = (const u16*)(ws + WS_WSB) + (size_t)l * 4 * 128 * 128;
    u16* vn = (u16*)shm;
    const int tid = tid_opaque(), wid = __builtin_amdgcn_readfirstlane(tid >> 6), lane = tid & 63, fr = lane & 15, fq = lane >> 4;
    const int T0 = unit * 128;
    const int g = wid >> 1, ih = wid & 1;
    const int nks = ih ? 4 : 2;
    const int tok = wid * 16 + (lane >> 2), part = lane & 3;
    u32x4 vraw[8];
#pragma unroll
    for (int j = 0; j < 8; ++j) vraw[j] = *(const u32x4*)(H + (size_t)(T0 + tok) * INW + C_VA + j * 32 + part * 8);
    bf16x8 wf[4][4];
#pragma unroll
    for (int ks = 0; ks < 4; ++ks) if (ks < nks) {
#pragma unroll
        for (int mm = 0; mm < 4; ++mm) wf[ks][mm] = *(const bf16x8*)(WSB + ((size_t)g * 128 + (ih * 4 + mm) * 16 + fr) * 128 + ks * 32 + fq * 8);
    }
    {
        float s = 0.f, s2 = 0.f;
#pragma unroll
        for (int j = 0; j < 8; ++j) {
            const u32x4 w = vraw[j];
            const float x0 = bflo(w.x), x1 = bfhi(w.x), x2 = bflo(w.y), x3 = bfhi(w.y), x4 = bflo(w.z), x5 = bfhi(w.z), x6 = bflo(w.w), x7 = bfhi(w.w);
            s += ((x0 + x1) + (x2 + x3)) + ((x4 + x5) + (x6 + x7));
            s2 += ((x0 * x0 + x1 * x1) + (x2 * x2 + x3 * x3)) + ((x4 * x4 + x5 * x5) + (x6 * x6 + x7 * x7));
        }
        s += __shfl_xor(s, 1); s += __shfl_xor(s, 2); s2 += __shfl_xor(s2, 1); s2 += __shfl_xor(s2, 2);
        const float mu = s * (1.f / 256.f);
        const float var = fmaxf(s2 * (1.f / 256.f) - mu * mu, 0.f);
        const float rs = rsqrtf(var + 1e-5f);
#pragma unroll
        for (int j = 0; j < 8; ++j) {
            const int ch = j * 32 + part * 8;
            const f32x4 g0 = *(const f32x4*)(p.ln_v_g + l * 256 + ch), g1 = *(const f32x4*)(p.ln_v_g + l * 256 + ch + 4);
            const f32x4 b0 = *(const f32x4*)(p.ln_v_b + l * 256 + ch), b1 = *(const f32x4*)(p.ln_v_b + l * 256 + ch + 4);
            const u32x4 w = vraw[j];
            u32x4 o;
            o.x = cvt_pk_bf16((bflo(w.x) - mu) * rs * g0[0] + b0[0], (bfhi(w.x) - mu) * rs * g0[1] + b0[1]);
            o.y = cvt_pk_bf16((bflo(w.y) - mu) * rs * g0[2] + b0[2], (bfhi(w.y) - mu) * rs * g0[3] + b0[3]);
            o.z = cvt_pk_bf16((bflo(w.z) - mu) * rs * g1[0] + b1[0], (bfhi(w.z) - mu) * rs * g1[1] + b1[1]);
            o.w = cvt_pk_bf16((bflo(w.w) - mu) * rs * g1[2] + b1[2], (bfhi(w.w) - mu) * rs * g1[3] + b1[3]);
            *(u32x4*)(vn + tok * VS2 + ch) = o;
        }
    }
    __syncthreads();
    {
        u32x4 uw[4][2], zw[4][2];
#pragma unroll
        for (int mm = 0; mm < 4; ++mm) {
            const size_t rowH = (size_t)(T0 + (ih * 4 + mm) * 16 + fr) * INW;
#pragma unroll
            for (int nn = 0; nn < 2; ++nn) { const int ch = g * 64 + nn * 32 + fq * 8; uw[mm][nn] = *(const u32x4*)(H + rowH + C_UA + ch); zw[mm][nn] = *(const u32x4*)(H + rowH + C_ZA + ch); }
        }
        f32x4 acc[4][4];
#pragma unroll
        for (int mm = 0; mm < 4; ++mm)
#pragma unroll
            for (int n = 0; n < 4; ++n) acc[mm][n] = (f32x4){0.f, 0.f, 0.f, 0.f};
#pragma unroll
        for (int ks = 0; ks < 4; ++ks) if (ks < nks) {
            bf16x8 af[4];
#pragma unroll
            for (int n = 0; n < 4; ++n) {
                const u16* vr = vn + (ks * 32 + fq * 8 + (fr >> 2)) * VS2 + g * 64 + (n >> 1) * 32 + 8 * (fr & 3) + 4 * (n & 1);
                const s16x4 lo = tr_read4(vr), hi = tr_read4(vr + 4 * VS2);
                af[n] = __builtin_shufflevector(lo, hi, 0, 1, 2, 3, 4, 5, 6, 7);
            }
#pragma unroll
            for (int mm = 0; mm < 4; ++mm)
#pragma unroll
                for (int n = 0; n < 4; ++n) acc[mm][n] = MFMA16(af[n], wf[ks][mm], acc[mm][n]);
        }
#pragma unroll
        for (int mm = 0; mm < 4; ++mm) {
            const int i = (ih * 4 + mm) * 16 + fr;
            const float bias = p.b_s[(l * 4 + g) * 128 + i];
            const size_t rowM = (size_t)(T0 + i) * MIXW;
#pragma unroll
            for (int nn = 0; nn < 2; ++nn) {
                const int ch = g * 64 + nn * 32 + fq * 8;
                const u32x4 u4 = uw[mm][nn], z4 = zw[mm][nn];
                const f32x4 a = acc[mm][2 * nn], b2 = acc[mm][2 * nn + 1];
                u32x4 w;
                w.x = cvt_pk_bf16((a[0] + bias) * bflo(u4.x) * bflo(z4.x), (a[1] + bias) * bfhi(u4.x) * bfhi(z4.x));
                w.y = cvt_pk_bf16((a[2] + bias) * bflo(u4.y) * bflo(z4.y), (a[3] + bias) * bfhi(u4.y) * bfhi(z4.y));
                w.z = cvt_pk_bf16((b2[0] + bias) * bflo(u4.z) * bflo(z4.z), (b2[1] + bias) * bfhi(u4.z) * bfhi(z4.z));
                w.w = cvt_pk_bf16((b2[2] + bias) * bflo(u4.w) * bflo(z4.w), (b2[3] + bias) * bfhi(u4.w) * bfhi(z4.w));
                *(u32x4*)(MIX + rowM + ch) = w;
            }
        }
    }
    __syncthreads();
}

DI void sgu_sample_unit(const Params& p, int l, int b) {
    unsigned char* ws = p.ws;
    const u16* H = (const u16*)(ws + WS_H); u16* MIX = (u16*)(ws + WS_MIX);
    float* vn = (float*)shm;
    const int tid = tid_opaque(), wid = __builtin_amdgcn_readfirstlane(tid >> 6), lane = tid & 63;
    const int T0 = NTOKP + b * 16;
    const f32x4 g = *(const f32x4*)(p.ln_v_g + l * 256 + lane * 4), bb = *(const f32x4*)(p.ln_v_b + l * 256 + lane * 4);
    for (int tt = 0; tt < 2; ++tt) {
        const int tok = wid * 2 + tt;
        const u32x2 w = *(const u32x2*)(H + (size_t)(T0 + tok) * INW + C_VA + lane * 4);
        float x0 = bflo(w.x), x1 = bfhi(w.x), x2 = bflo(w.y), x3 = bfhi(w.y);
        const float mu = wave_sum((x0 + x1) + (x2 + x3)) * (1.f / 256.f);
        x0 -= mu; x1 -= mu; x2 -= mu; x3 -= mu;
        const float var = wave_sum((x0 * x0 + x1 * x1) + (x2 * x2 + x3 * x3)) * (1.f / 256.f);
        const float rs = rsqrtf(var + 1e-5f);
        f32x4 o; o[0] = x0 * rs * g[0] + bb[0]; o[1] = x1 * rs * g[1] + bb[1]; o[2] = x2 * rs * g[2] + bb[2]; o[3] = x3 * rs * g[3] + bb[3];
        *(f32x4*)(vn + tok * 256 + lane * 4) = o;
        *(f32x4*)(p.out + O_SV + ((size_t)(l * 16 + b) * 16 + tok) * 256 + lane * 4) = o;
    }
    __syncthreads();
    for (int e = 0; e < 8; ++e) {
        const int o = tid + 512 * e, i = o >> 8, ch = o & 255, g4 = ch >> 6;
        const float* wrow = p.w_s + ((size_t)(l * 4 + g4) * 128 + i) * 128;
        float s = p.b_s[(l * 4 + g4) * 128 + i];
        for (int j = 0; j < 16; ++j) s += wrow[j] * vn[j * 256 + ch];
        const size_t rowH = (size_t)(T0 + i) * INW;
        MIX[(size_t)(T0 + i) * MIXW + ch] = f2bf(s * bf2f(H[rowH + C_UA + ch]) * bf2f(H[rowH + C_ZA + ch]));
    }
    __syncthreads();
}

constexpr int HS = 72;
struct HgIn { u32x4 fb[4], q[4], v[4]; };
template <bool NEEDQ>
DI void hg_load(HgIn& x, const u16* __restrict__ H, int u, int hh, int half, int lane) {
    const int T0 = (u < NCH) ? u * 64 : NTOKP + (u - NCH) * 16, len = (u < NCH) ? 64 : 16;
#pragma unroll
    for (int i = 0; i < 4; ++i) {
        const int idx = half * 64 + lane + i * 128, j = idx >> 3, c8 = idx & 7;
        x.fb[i] = (u32x4){0u, 0u, 0u, 0u}; x.v[i] = (u32x4){0u, 0u, 0u, 0u}; x.q[i] = (u32x4){0u, 0u, 0u, 0u};
        if (j < len) {
            const u16* row = H + (size_t)(T0 + j) * INW + hh * 64 + c8 * 8;
            x.fb[i] = *(const u32x4*)(row + C_FB); x.v[i] = *(const u32x4*)(row + C_IB);
            if (NEEDQ) x.q[i] = *(const u32x4*)(row + C_QB);
        }
    }
}
DI void hgrn_local_body(const Params& p, int l, int u, const HgIn& x) {
    unsigned char* ws = p.ws;
    u16* UT = (u16*)(ws + WS_UT); float* DEC = (float*)(ws + WS_DEC);
    const float* LB = (const float*)(ws + WS_LB) + l * 256;
    const int tid = tid_opaque(), wid = __builtin_amdgcn_readfirstlane(tid >> 6), lane = tid & 63, fr = lane & 15, fq = lane >> 4;
    const int hh = wid >> 1, half = wid & 1;
    const int len = (u < NCH) ? 64 : 16;
    u16* vN = (u16*)shm + hh * (3 * 64 * HS);
    u16* kT = vN + 64 * HS;
    u16* fN = kT + 64 * HS;
    float* tot = (float*)(shm + 4 * 3 * 64 * HS * 2);
#pragma unroll
    for (int i = 0; i < 4; ++i) { const int idx = half * 64 + lane + i * 128, j = idx >> 3, c8 = idx & 7; *(u32x4*)(vN + j * HS + c8 * 8) = x.v[i]; *(u32x4*)(fN + j * HS + c8 * 8) = x.fb[i]; }
    __syncthreads();
    const float lb = LB[hh * 64 + lane];
    float fg[32], kk[32];
    float own = 1.f;
#pragma unroll
    for (int jj = 0; jj < 32; ++jj) {
        const int j = half * 32 + jj;
        const float gv = h2f(fN[j * HS + lane]);
        const float kv = (gv >= 0.f) ? gv : 1.f + gv, fv = (gv >= 0.f) ? 1.f - gv : -gv;
        fg[jj] = fv; kk[jj] = kv; own *= fv;
    }
    tot[(hh * 2 + half) * 64 + lane] = own;
    __syncthreads();
    {
        const float other = tot[(hh * 2 + (1 - half)) * 64 + lane];
        float s = half ? 1.f : other;
        unsigned pk[16];
#pragma unroll
        for (int jj = 31; jj >= 0; jj -= 2) {
            const float k1 = kk[jj] * s; s *= fg[jj];
            const float k0 = kk[jj - 1] * s; s *= fg[jj - 1];
            pk[jj >> 1] = cvt_pk_bf16(k0, k1);
        }
        if (half == 0) { const float dk = s; if (u < NCH) DEC[((size_t)u * 4 + hh) * 64 + lane] = dk; else tot[512 + hh * 64 + lane] = dk; }
#pragma unroll
        for (int q = 0; q < 4; ++q) { u32x4 w = {pk[4 * q], pk[4 * q + 1], pk[4 * q + 2], pk[4 * q + 3]}; *(u32x4*)(kT + lane * HS + half * 32 + q * 8) = w; }
    }
    __syncthreads();
    {
        f32x4 acc[2][4];
#pragma unroll
        for (int a = 0; a < 2; ++a)
#pragma unroll
            for (int kt = 0; kt < 4; ++kt) acc[a][kt] = (f32x4){0.f, 0.f, 0.f, 0.f};
#pragma unroll
        for (int ks = 0; ks < 2; ++ks) {
            bf16x8 av[2], bk[4];
#pragma unroll
            for (int a = 0; a < 2; ++a) {
                const u16* vr = vN + (ks * 32 + fq * 8 + (fr >> 2)) * HS + (half * 2 + a) * 16 + 4 * (fr & 3);
                const s16x4 lo = tr_read4(vr), hi = tr_read4(vr + 4 * HS);
                av[a] = __builtin_shufflevector(lo, hi, 0, 1, 2, 3, 4, 5, 6, 7);
            }
#pragma unroll
            for (int kt = 0; kt < 4; ++kt) bk[kt] = *(const bf16x8*)(kT + (kt * 16 + fr) * HS + ks * 32 + fq * 8);
#pragma unroll
            for (int a = 0; a < 2; ++a)
#pragma unroll
                for (int kt = 0; kt < 4; ++kt) acc[a][kt] = MFMA16(bk[kt], av[a], acc[a][kt]);
        }
        if (u < NCH) {
            u16* dst = UT + ((size_t)u * 4 + hh) * 4096;
#pragma unroll
            for (int a = 0; a < 2; ++a)
#pragma unroll
                for (int kt = 0; kt < 4; ++kt) {
                    u32x2 w; w.x = cvt_pk_bf16(acc[a][kt][0], acc[a][kt][1]); w.y = cvt_pk_bf16(acc[a][kt][2], acc[a][kt][3]);
                    *(u32x2*)(dst + ((half * 2 + a) * 16 + fr) * 64 + kt * 16 + fq * 4) = w;
                }
        } else {
            const size_t so = ((size_t)(l * 16 + (u - NCH)) * 4 + hh) * 4096;
#pragma unroll
            for (int kt = 0; kt < 4; ++kt)
#pragma unroll
                for (int r = 0; r < 4; ++r) {
                    const int k = kt * 16 + fq * 4 + r;
                    const float dk = tot[512 + hh * 64 + k];
#pragma unroll
                    for (int a = 0; a < 2; ++a) {
                        const int v = (half * 2 + a) * 16 + fr;
                        p.out[O_HS + so + k * 64 + v] = p.state_hgrn[so + k * 64 + v] * dk + acc[a][kt][r];
                    }
                }
        }
    }
    __syncthreads();
}
DI void hgrn_local_run(const Params& p, int l, int u0, int n) {
    const u16* H = (const u16*)(p.ws + WS_H);
    const int tid = tid_opaque(), wid = __builtin_amdgcn_readfirstlane(tid >> 6), lane = tid & 63;
    const int hh = wid >> 1, half = wid & 1;
    HgIn cur; hg_load<false>(cur, H, u0, hh, half, lane);
#pragma unroll 1
    for (int i = 0; i < n; ++i) {
        HgIn nxt = cur;
        if (i + 1 < n) hg_load<false>(nxt, H, u0 + i + 1, hh, half, lane);
        hgrn_local_body(p, l, u0 + i, cur);
        cur = nxt;
    }
}

DI void hgrn_scan_phase(const Params& p, int l, int wgi, int nwg) {
    unsigned char* ws = p.ws;
    const u16* __restrict__ UT = (const u16*)(ws + WS_UT); const float* __restrict__ DEC = (const float*)(ws + WS_DEC);
    u16* __restrict__ SBUF = (u16*)(ws + WS_SB);
    const long gt = (long)wgi * 512 + tid_opaque(), nth = (long)nwg * 512;
    for (long item = gt; item < 128 * 4096; item += nth) {
        const int seq = (int)(item >> 12), e = (int)(item & 4095), k = e & 63, v = e >> 6;
        if (seq < 64) {
            const int b = seq >> 2, hh = seq & 3;
            float s = 0.f;
            for (int c0 = 0; c0 < 64; c0 += 16) {
                float uu[16], dd[16];
#pragma unroll
                for (int c = 0; c < 16; ++c) { const size_t ub = (size_t)(b * 64 + c0 + c) * 4 + hh; uu[c] = bf2f(UT[ub * 4096 + e]); dd[c] = DEC[ub * 64 + k]; }
#pragma unroll
                for (int c = 0; c < 16; ++c) { const size_t ub = (size_t)(b * 64 + c0 + c) * 4 + hh; SBUF[ub * 4096 + e] = f2bf(s); s = dd[c] * s + uu[c]; }
            }
            p.out[O_HP + ((size_t)(l * 16 + b) * 4 + hh) * 4096 + k * 64 + v] = s;
        } else {
            const int b = (seq - 64) >> 2, hh = seq & 3;
            const size_t ub = (size_t)(NCH + b) * 4 + hh;
            SBUF[ub * 4096 + e] = f2bf(p.state_hgrn[((size_t)(l * 16 + b) * 4 + hh) * 4096 + k * 64 + v]);
        }
    }
}

DI void hgrn_out_body(const Params& p, int l, int u, const HgIn& x) {
    unsigned char* ws = p.ws;
    const u16* H = (const u16*)(ws + WS_H); u16* MIX = (u16*)(ws + WS_MIX);
    const u16* SBUF = (const u16*)(ws + WS_SB);
    const float* LB = (const float*)(ws + WS_LB) + l * 256;
    const int tid = tid_opaque(), wid = __builtin_amdgcn_readfirstlane(tid >> 6), lane = tid & 63, fr = lane & 15, fq = lane >> 4;
    const int hh = wid >> 1, half = wid & 1;
    const int T0 = (u < NCH) ? u * 64 : NTOKP + (u - NCH) * 16, len = (u < NCH) ? 64 : 16;
    u16* vN = (u16*)shm + hh * (4 * 64 * HS);
    u16* kh = vN + 64 * HS;
    u16* qh = kh + 64 * HS;
    u16* qt = qh + 64 * HS;
    float* tot = (float*)(shm + 4 * 4 * 64 * HS * 2);
#pragma unroll
    for (int i = 0; i < 4; ++i) {
        const int idx = half * 64 + lane + i * 128, j = idx >> 3, c8 = idx & 7;
        *(u32x4*)(vN + j * HS + c8 * 8) = x.v[i]; *(u32x4*)(kh + j * HS + c8 * 8) = x.fb[i]; *(u32x4*)(qh + j * HS + c8 * 8) = x.q[i];
    }
    bf16x8 sfr[2][4];
    {
        const u16* Sg = SBUF + ((size_t)u * 4 + hh) * 4096;
#pragma unroll
        for (int ks = 0; ks < 2; ++ks)
#pragma unroll
            for (int vt = 0; vt < 4; ++vt) sfr[ks][vt] = *(const bf16x8*)(Sg + (vt * 16 + fr) * 64 + ks * 32 + fq * 8);
    }
    u32x2 zw[2][4];
#pragma unroll
    for (int ii = 0; ii < 2; ++ii) {
        const int i = min((half * 2 + ii) * 16 + fr, len - 1);
#pragma unroll
        for (int vt = 0; vt < 4; ++vt) zw[ii][vt] = *(const u32x2*)(H + (size_t)(T0 + i) * INW + C_ZB + hh * 64 + vt * 16 + fq * 4);
    }
    __syncthreads();
    const float lb = LB[hh * 64 + lane];
    float fg[32], kk[32];
    float own = 1.f;
#pragma unroll
    for (int jj = 0; jj < 32; ++jj) {
        const int j = half * 32 + jj;
        const float gv = h2f(kh[j * HS + lane]);
        const float kv = (gv >= 0.f) ? gv : 1.f + gv, fv = (gv >= 0.f) ? 1.f - gv : -gv;
        own *= fv; fg[jj] = fv; kk[jj] = kv;
    }
    tot[(hh * 2 + half) * 64 + lane] = own;
    float qhv[32];
    if (half) {
        float D = 1.f;
#pragma unroll
        for (int jj = 0; jj < 32; ++jj) {
            const int j = 32 + jj;
            D *= fg[jj];
            const float qv = bf2f(qh[j * HS + lane]) * D;
            qhv[jj] = qv;
            kh[j * HS + lane] = f2bf(kk[jj] * __builtin_amdgcn_rcpf(D));
            qh[j * HS + lane] = f2bf(qv);
        }
    } else {
        float R = 1.f;
#pragma unroll
        for (int jj = 31; jj >= 0; --jj) {
            const int j = jj;
            const float qv = bf2f(qh[j * HS + lane]) * __builtin_amdgcn_rcpf(R);
            qhv[jj] = qv;
            kh[j * HS + lane] = f2bf(kk[jj] * R);
            qh[j * HS + lane] = f2bf(qv);
            R *= fg[jj];
        }
    }
    __syncthreads();
    {
        const float other = tot[(hh * 2 + (1 - half)) * 64 + lane];
        const float C = half ? other : own;
#pragma unroll
        for (int jj = 0; jj < 32; ++jj) { const int j = half * 32 + jj; qt[j * HS + lane] = f2bf(qhv[jj] * C); }
    }
    {
        f32x4 at[2][4];
#pragma unroll
        for (int ii = 0; ii < 2; ++ii)
#pragma unroll
            for (int jt = 0; jt < 4; ++jt) at[ii][jt] = (f32x4){0.f, 0.f, 0.f, 0.f};
#pragma unroll
        for (int ks = 0; ks < 2; ++ks) {
            bf16x8 bqf[2];
#pragma unroll
            for (int ii = 0; ii < 2; ++ii) bqf[ii] = *(const bf16x8*)(qh + ((half * 2 + ii) * 16 + fr) * HS + ks * 32 + fq * 8);
#pragma unroll
            for (int jt = 0; jt < 4; ++jt) if (jt <= half * 2 + 1) {
                const bf16x8 ak = *(const bf16x8*)(kh + (jt * 16 + fr) * HS + ks * 32 + fq * 8);
#pragma unroll
                for (int ii = 0; ii < 2; ++ii) at[ii][jt] = MFMA16(ak, bqf[ii], at[ii][jt]);
            }
        }
        bf16x8 pb[2][2];
#pragma unroll
        for (int ii = 0; ii < 2; ++ii) {
            const int i = (half * 2 + ii) * 16 + fr;
#pragma unroll
            for (int jt = 0; jt < 4; ++jt)
#pragma unroll
                for (int r = 0; r < 4; ++r) { const int j = jt * 16 + fq * 4 + r; if (j > i) at[ii][jt][r] = 0.f; }
#pragma unroll
            for (int s2 = 0; s2 < 2; ++s2) {
                u32x4 w;
                w.x = cvt_pk_bf16(at[ii][2 * s2][0], at[ii][2 * s2][1]); w.y = cvt_pk_bf16(at[ii][2 * s2][2], at[ii][2 * s2][3]);
                w.z = cvt_pk_bf16(at[ii][2 * s2 + 1][0], at[ii][2 * s2 + 1][1]); w.w = cvt_pk_bf16(at[ii][2 * s2 + 1][2], at[ii][2 * s2 + 1][3]);
                pb[ii][s2] = __builtin_bit_cast(bf16x8, w);
            }
        }
        f32x4 o[4][2];
#pragma unroll
        for (int vt = 0; vt < 4; ++vt) { o[vt][0] = (f32x4){0.f, 0.f, 0.f, 0.f}; o[vt][1] = (f32x4){0.f, 0.f, 0.f, 0.f}; }
#pragma unroll
        for (int s2 = 0; s2 < 2; ++s2) if (s2 <= half) {
#pragma unroll
            for (int vt = 0; vt < 4; ++vt) {
                const u16* vr = vN + (32 * s2 + 4 * fq + (fr >> 2)) * HS + vt * 16 + 4 * (fr & 3);
                const s16x4 lo = tr_read4(vr), hi = tr_read4(vr + 16 * HS);
                const bf16x8 a = __builtin_shufflevector(lo, hi, 0, 1, 2, 3, 4, 5, 6, 7);
                o[vt][0] = MFMA16(a, pb[0][s2], o[vt][0]); o[vt][1] = MFMA16(a, pb[1][s2], o[vt][1]);
            }
        }
        __syncthreads();
#pragma unroll
        for (int ks = 0; ks < 2; ++ks) {
            bf16x8 bqf[2];
#pragma unroll
            for (int ii = 0; ii < 2; ++ii) bqf[ii] = *(const bf16x8*)(qt + ((half * 2 + ii) * 16 + fr) * HS + ks * 32 + fq * 8);
#pragma unroll
            for (int vt = 0; vt < 4; ++vt) { o[vt][0] = MFMA16(sfr[ks][vt], bqf[0], o[vt][0]); o[vt][1] = MFMA16(sfr[ks][vt], bqf[1], o[vt][1]); }
        }
#pragma unroll
        for (int ii = 0; ii < 2; ++ii) {
            float ss = 0.f;
#pragma unroll
            for (int vt = 0; vt < 4; ++vt) { const f32x4 xx = o[vt][ii]; ss += (xx[0] * xx[0] + xx[1] * xx[1]) + (xx[2] * xx[2] + xx[3] * xx[3]); }
            ss += __shfl_xor(ss, 16); ss += __shfl_xor(ss, 32);
            const float rs = rsqrtf(ss * (1.f / 64.f) + 1e-6f);
            const int i = (half * 2 + ii) * 16 + fr;
            if (i < len) {
#pragma unroll
                for (int vt = 0; vt < 4; ++vt) {
                    const int v = vt * 16 + fq * 4;
                    const f32x4 gn = *(const f32x4*)(p.norm_b_g + l * 64 + v);
                    const u32x2 z2 = zw[ii][vt];
                    const f32x4 xx = o[vt][ii];
                    u32x2 w; w.x = cvt_pk_bf16(xx[0] * rs * gn[0] * bflo(z2.x), xx[1] * rs * gn[1] * bfhi(z2.x)); w.y = cvt_pk_bf16(xx[2] * rs * gn[2] * bflo(z2.y), xx[3] * rs * gn[3] * bfhi(z2.y));
                    *(u32x2*)(MIX + (size_t)(T0 + i) * MIXW + 256 + hh * 64 + v) = w;
                }
            }
        }
    }
}
DI void hgrn_out_run(const Params& p, int l, int u0, int n) {
    const u16* H = (const u16*)(p.ws + WS_H);
    const int tid = tid_opaque(), wid = __builtin_amdgcn_readfirstlane(tid >> 6), lane = tid & 63;
    const int hh = wid >> 1, half = wid & 1;
    HgIn cur; hg_load<true>(cur, H, u0, hh, half, lane);
#pragma unroll 1
    for (int i = 0; i < n; ++i) {
        HgIn nxt = cur;
        if (i + 1 < n) hg_load<true>(nxt, H, u0 + i + 1, hh, half, lane);
        hgrn_out_body(p, l, u0 + i, cur);
        cur = nxt;
    }
    __syncthreads();
}

DI void ln_phase(const Params& p, int l, int row0, int row1, int wgi, int nwg) {
    unsigned char* ws = p.ws;
    const u16* Z = (const u16*)(ws + WS_H);
    u16* XB = (u16*)(ws + WS_XB);
    const int tid = tid_opaque(), wid = __builtin_amdgcn_readfirstlane(tid >> 6), lane = tid & 63;
    f32x4 g[4], bb[4];
#pragma unroll
    for (int j = 0; j < 2; ++j) {
        g[2 * j] = *(const f32x4*)(p.ln_g + l * DM + lane * 8 + 512 * j); g[2 * j + 1] = *(const f32x4*)(p.ln_g + l * DM + lane * 8 + 512 * j + 4);
        bb[2 * j] = *(const f32x4*)(p.ln_b + l * DM + lane * 8 + 512 * j); bb[2 * j + 1] = *(const f32x4*)(p.ln_b + l * DM + lane * 8 + 512 * j + 4);
    }
    const int stride = nwg * 8;
    for (int rowa = row0 + wgi * 8 + wid; rowa < row1; rowa += 2 * stride) {
        const int rowb = rowa + stride;
        const bool hasb = rowb < row1;
        const u16* za = Z + (size_t)rowa * DM + lane * 8;
        const u16* zb = Z + (size_t)(hasb ? rowb : rowa) * DM + lane * 8;
        const u32x4 wa0 = *(const u32x4*)za, wa1 = *(const u32x4*)(za + 512), wb0 = *(const u32x4*)zb, wb1 = *(const u32x4*)(zb + 512);
#pragma unroll
        for (int rr = 0; rr < 2; ++rr) {
            if (rr == 1 && !hasb) break;
            const int row = rr ? rowb : rowa;
            const u32x4 w0 = rr ? wb0 : wa0, w1 = rr ? wb1 : wa1;
            f32x4 v[4];
            v[0] = (f32x4){bflo(w0.x), bfhi(w0.x), bflo(w0.y), bfhi(w0.y)}; v[1] = (f32x4){bflo(w0.z), bfhi(w0.z), bflo(w0.w), bfhi(w0.w)};
            v[2] = (f32x4){bflo(w1.x), bfhi(w1.x), bflo(w1.y), bfhi(w1.y)}; v[3] = (f32x4){bflo(w1.z), bfhi(w1.z), bflo(w1.w), bfhi(w1.w)};
            float s = 0.f;
#pragma unroll
            for (int j = 0; j < 4; ++j) s += (v[j][0] + v[j][1]) + (v[j][2] + v[j][3]);
            const float mu = wave_sum(s) * (1.f / DM);
            float s2 = 0.f;
#pragma unroll
            for (int j = 0; j < 4; ++j) { v[j] = v[j] - mu; s2 += (v[j][0] * v[j][0] + v[j][1] * v[j][1]) + (v[j][2] * v[j][2] + v[j][3] * v[j][3]); }
            const float rs = rsqrtf(wave_sum(s2) * (1.f / DM) + 1e-5f);
#pragma unroll
            for (int j = 0; j < 4; ++j) v[j] = v[j] * rs * g[j] + bb[j];
            if (l == 0) {
                u16* xr = XB + (size_t)row * DM + lane * 8;
#pragma unroll
                for (int j = 0; j < 2; ++j) {
                    u32x4 w; w.x = cvt_pk_bf16(v[2 * j][0], v[2 * j][1]); w.y = cvt_pk_bf16(v[2 * j][2], v[2 * j][3]); w.z = cvt_pk_bf16(v[2 * j + 1][0], v[2 * j + 1][1]); w.w = cvt_pk_bf16(v[2 * j + 1][2], v[2 * j + 1][3]);
                    *(u32x4*)(xr + 512 * j) = w;
                }
            } else {
                float* yr = p.out + (size_t)row * DM + lane * 8;
#pragma unroll
                for (int j = 0; j < 2; ++j) { __builtin_nontemporal_store(v[2 * j], (f32x4*)(yr + 512 * j)); __builtin_nontemporal_store(v[2 * j + 1], (f32x4*)(yr + 512 * j + 4)); }
            }
        }
    }
}

DI void phase_mix_a(const Params& p, int l) {
    unsigned char* ws = p.ws;
    const u16* H = (const u16*)(ws + WS_H); u16* MIX = (u16*)(ws + WS_MIX);
    constexpr int N_AT = 256, N_HL = NCH, N_SG = 512;
    const int G = gridDim.x;
    int w = blockIdx.x;
    for (; w < N_AT; w += G) attn_run(p, l, w);
    asm volatile("" ::: "memory");
    for (; w < N_AT + N_HL / 4; w += G) hgrn_local_run(p, l, (w - N_AT) * 4, 4);
    asm volatile("" ::: "memory");
    for (; w < N_AT + N_HL / 4 + N_SG; w += G) sgu_prompt_unit(p, l, w - N_AT - N_HL / 4);
}

DI void phase_mix_b(const Params& p, int l) {
    unsigned char* ws = p.ws;
    const u16* H = (const u16*)(ws + WS_H); u16* MIX = (u16*)(ws + WS_MIX);
    const u16* KVS = (const u16*)(ws + WS_KVS) + (size_t)l * 16 * 144 * 256;
    constexpr int N_HO = NCH / 4 + 16, N_HL = 16, N_AS = 32, N_SS = 16;
    const int G = gridDim.x;
    int w = blockIdx.x;
    for (; w < N_HO; w += G) { if (w < NCH / 4) hgrn_out_run(p, l, w * 4, 4); else hgrn_out_run(p, l, NCH + (w - NCH / 4), 1); }
    asm volatile("" ::: "memory");
    for (; w < N_HO + N_HL; w += G) hgrn_local_run(p, l, NCH + (w - N_HO), 1);
    asm volatile("" ::: "memory");
    for (; w < N_HO + N_HL + N_AS; w += G) {
        const int r = w - (N_HO + N_HL);
        const int g = r & 1, b = r >> 1;
        const size_t Tq = (size_t)NTOKP + b * 16;
        const u16* kv = KVS + (size_t)b * 144 * 256;
        attn_unit(H + Tq * INW + C_QC + g * 256, INW, 16, kv + g * 64, kv + 128 + g * 64, 256, 144,
                  H + Tq * INW + C_ZC + g * 256, INW, MIX + Tq * MIXW + 512 + g * 256, MIXW, p.sinks + l * 8 + g * 4);
    }
    asm volatile("" ::: "memory");
    for (; w < N_HO + N_HL + N_AS + N_SS; w += G) sgu_sample_unit(p, l, w - (N_HO + N_HL + N_AS));
}

__global__ void __launch_bounds__(512, 2) fwd_megakernel(Params p) {
    cg::grid_group grid = cg::this_grid();
    unsigned char* ws = p.ws;
    volatile LAS unsigned* st = (volatile LAS unsigned*)((LAS unsigned char*)shm + (LDS_BYTES - 16));
    if (threadIdx.x == 0) { st[0] = 0u; st[1] = 0u; }
    __syncthreads();
    XcdBarrier xb = xcd_barrier_post((unsigned*)(ws + WS_BAR), st);
    for (int rep = 0; rep < REP_PRO; ++rep) { phase_prologue(p); if (rep + 1 < REP_PRO) xcd_barrier(xb); }
    grid.sync();
    const int G = gridDim.x, wg = blockIdx.x;
#pragma unroll 1
    for (int l = 0; l < 2; ++l) {
#pragma unroll 1
        for (int rep = 0; rep < REP_G1; ++rep) {
            EpiIn e; e.ws = ws; e.out = p.out; e.l = l;
            #ifndef G1_WGM
#define G1_WGM 8
#endif
            StaticOrder so; so.init(NTOKP / BM, INW / BM, G, wg, 0, G1_WGM);
            gemm_phase((const u16*)(ws + WS_XB), (const u16*)(ws + WS_WTIN) + (size_t)l * INW * DM, so, e);
            xcd_barrier(xb);
        }
#pragma unroll 1
        for (int rep = 0; rep < REP_MIXA; ++rep) { phase_mix_a(p, l); xcd_barrier(xb); }
#pragma unroll 1
        for (int rep = 0; rep < REP_SCAN; ++rep) {
            if (wg < 12) {
                EpiIn e; e.ws = ws; e.out = p.out; e.l = l;
                StaticOrder so; so.init(1, INW / BM, 12, wg, NTOKP / BM);
                gemm_phase((const u16*)(ws + WS_XB), (const u16*)(ws + WS_WTIN) + (size_t)l * INW * DM, so, e);
            } else hgrn_scan_phase(p, l, wg - 12, G - 12);
            xcd_barrier(xb);
        }
#pragma unroll 1
        for (int rep = 0; rep < REP_HOUT; ++rep) { phase_mix_b(p, l); xcd_barrier(xb); }
#pragma unroll 1
        for (int rep = 0; rep < REP_G2; ++rep) {
            EpiOut e; e.ws = ws;
            StaticOrder so; so.init(NTOKP / BM, DM / BM, G, wg, 0);
            gemm_phase((const u16*)(ws + WS_MIX), (const u16*)(ws + WS_WTOUT) + (size_t)l * DM * MIXW, so, e);
            xcd_barrier(xb);
        }
#pragma unroll 1
        for (int rep = 0; rep < REP_LN; ++rep) {
            if (wg < 4) {
                EpiOut e; e.ws = ws;
                StaticOrder so; so.init(1, DM / BM, 4, wg, NTOKP / BM);
                gemm_phase((const u16*)(ws + WS_MIX), (const u16*)(ws + WS_WTOUT) + (size_t)l * DM * MIXW, so, e);
            } else ln_phase(p, l, 0, NTOKP, wg - 4, G - 4);
            xcd_barrier(xb);
        }
        if (wg < 32) ln_phase(p, l, NTOKP, MTOT, wg, 32);
    }
}


extern "C" void kernel_launch(void* const* d_in, const int* in_sizes, int n_in, void* d_out, int out_size, void* d_ws, size_t ws_size, hipStream_t stream) {
    static int grid_blocks = 0;
    if (!grid_blocks) {
        int dev = 0, cus = 0, per_cu = 0;
        (void)hipGetDevice(&dev);
        (void)hipDeviceGetAttribute(&cus, hipDeviceAttributeMultiprocessorCount, dev);
        (void)hipFuncSetAttribute((const void*)fwd_megakernel, hipFuncAttributeMaxDynamicSharedMemorySize, LDS_BYTES);
        (void)hipOccupancyMaxActiveBlocksPerMultiprocessor(&per_cu, (const void*)fwd_megakernel, 512, LDS_BYTES);
        if (per_cu < 1) { fprintf(stderr, "occupancy query returned %d\n", per_cu); per_cu = 1; }
        grid_blocks = cus * per_cu;
        if (ws_size < WS_END) fprintf(stderr, "workspace too small: %zu < %zu\n", ws_size, (size_t)WS_END);
    }
    Params p{};
    p.x_prompt = (const float*)d_in[0]; p.x_sample = (const float*)d_in[1]; p.cache_k = (const float*)d_in[2]; p.cache_v = (const float*)d_in[3];
    p.state_hgrn = (const float*)d_in[4]; p.w_in = (const float*)d_in[5]; p.ln_v_g = (const float*)d_in[6]; p.ln_v_b = (const float*)d_in[7];
    p.w_s = (const float*)d_in[8]; p.b_s = (const float*)d_in[9]; p.lb_param = (const float*)d_in[10]; p.norm_b_g = (const float*)d_in[11];
    p.sinks = (const float*)d_in[12]; p.w_out = (const float*)d_in[13]; p.ln_g = (const float*)d_in[14]; p.ln_b = (const float*)d_in[15];
    p.out = (float*)d_out; p.ws = (unsigned char*)d_ws;
    for (int i = 0; i < 8; ++i) p.inv[i] = powf(500000.0f, -(float)(2 * i) / 16.0f);
    (void)hipMemsetAsync((unsigned char*)d_ws + WS_BAR, 0, 16384, stream);
    void* args[] = {&p};
    hipError_t e = hipLaunchCooperativeKernel((const void*)fwd_megakernel, dim3(grid_blocks), dim3(512), args, LDS_BYTES, stream);
    if (e != hipSuccess) fprintf(stderr, "cooperative launch failed: %s (grid %d)\n", hipGetErrorString(e), grid_blocks);
}
```

```cpp
#include <hip/hip_runtime.h>
#include <hip/hip_cooperative_groups.h>
#ifndef REP_PRO
#define REP_PRO 1
#endif
#ifndef REP_G1
#define REP_G1 1
#endif
#ifndef REP_MIXA
#define REP_MIXA 1
#endif
#ifndef REP_SCAN
#define REP_SCAN 1
#endif
#ifndef REP_HOUT
#define REP_HOUT 1
#endif
#ifndef REP_G2
#define REP_G2 1
#endif
#ifndef REP_LN
#define REP_LN 1
#endif
#include <cstdio>
#include <cmath>
namespace cg = cooperative_groups;

typedef unsigned short u16;
typedef short bf16x8 __attribute__((ext_vector_type(8)));
typedef short s16x4 __attribute__((ext_vector_type(4)));
typedef float f32x4 __attribute__((ext_vector_type(4)));
typedef unsigned u32x2 __attribute__((ext_vector_type(2)));
typedef unsigned u32x4 __attribute__((ext_vector_type(4)));
#define DI __device__ __forceinline__

constexpr int DM = 1024, NB = 16, SEQ = 4096, NTOKP = NB * SEQ, NTOKS = 256, MTOT = NTOKP + NTOKS;
constexpr int INW = 3072, MIXW = 1024;
constexpr int NCH = 1024, NUNIT = NCH + 16;
constexpr float ALPHA = 1.41421356237309515f;
constexpr int LDS_BYTES = 155648;

constexpr int C_UA = 0, C_VA = 256, C_ZA = 512, C_QB = 768, C_FB = 1024, C_IB = 1280, C_ZB = 1536, C_QC = 1792, C_KC = 2304, C_VC = 2432, C_ZC = 2560;

constexpr size_t WS_WTIN = 0;
constexpr size_t WS_WTOUT = WS_WTIN + 2ull * INW * DM * 2;
constexpr size_t WS_XB = WS_WTOUT + 2ull * DM * DM * 2;
constexpr size_t WS_H = WS_XB + (size_t)MTOT * DM * 2;
constexpr size_t WS_MIX = WS_H + (size_t)MTOT * INW * 2;
constexpr size_t WS_UT = WS_MIX + (size_t)MTOT * MIXW * 2;
constexpr size_t WS_SB = WS_UT + (size_t)NUNIT * 4 * 4096 * 4;
constexpr size_t WS_DEC = WS_SB + (size_t)NUNIT * 4 * 4096 * 2;
constexpr size_t WS_WSB = WS_DEC + (size_t)NUNIT * 4 * 64 * 4;
constexpr size_t WS_RT = WS_WSB + 2ull * 4 * 128 * 128 * 2;
constexpr size_t WS_KVS = WS_RT + 4112ull * 8 * 8;
constexpr size_t WS_LB = WS_KVS + 2ull * 16 * 144 * 256 * 2;
constexpr size_t WS_BAR = WS_LB + 2ull * 256 * 4;
constexpr size_t WS_END = WS_BAR + 16384;

constexpr size_t O_YP = 0;
constexpr size_t O_YS = O_YP + (size_t)NTOKP * DM;
constexpr size_t O_KP = O_YS + (size_t)NTOKS * DM;
constexpr size_t O_VP = O_KP + 2ull * 16 * 128 * 128;
constexpr size_t O_HP = O_VP + 2ull * 16 * 128 * 128;
constexpr size_t O_KS = O_HP + 2ull * 16 * 4 * 4096;
constexpr size_t O_VS = O_KS + 2ull * 16 * 16 * 128;
constexpr size_t O_HS = O_VS + 2ull * 16 * 16 * 128;
constexpr size_t O_SV = O_HS + 2ull * 16 * 4 * 4096;

struct Params {
    const float* x_prompt; const float* x_sample; const float* cache_k; const float* cache_v; const float* state_hgrn;
    const float* w_in; const float* ln_v_g; const float* ln_v_b; const float* w_s; const float* b_s; const float* lb_param;
    const float* norm_b_g; const float* sinks; const float* w_out; const float* ln_g; const float* ln_b;
    float* out; unsigned char* ws;
    float inv[8];
};

extern __shared__ __attribute__((aligned(16))) unsigned char shm[];

DI unsigned cvt_pk_bf16(float lo, float hi) { unsigned r; asm volatile("v_cvt_pk_bf16_f32 %0, %1, %2" : "=v"(r) : "v"(lo), "v"(hi)); return r; }
DI u16 f2bf(float x) { return (u16)(cvt_pk_bf16(x, 0.f) & 0xffffu); }
DI float bf2f(u16 v) { return __uint_as_float(((unsigned)v) << 16); }
DI unsigned f2h(float x) { return (unsigned)__builtin_bit_cast(u16, (_Float16)x); }
DI float h2f(u16 b) { return (float)__builtin_bit_cast(_Float16, b); }
DI float bflo(unsigned w) { return __uint_as_float(w << 16); }
DI float bfhi(unsigned w) { return __uint_as_float(w & 0xffff0000u); }
DI float silu_f(float x) { return x * __builtin_amdgcn_rcpf(1.f + __expf(-x)); }
DI float wave_sum(float v) {
#pragma unroll
    for (int o = 1; o < 64; o <<= 1) v += __shfl_xor(v, o);
    return v;
}
DI int tid_opaque() { int t = threadIdx.x; asm volatile("" : "+v"(t)); return t; }
DI s16x4 tr_read4(const u16* p) { return __builtin_amdgcn_ds_read_tr16_b64_v4i16((__attribute__((address_space(3))) s16x4*)p); }
#define MFMA16(a, b, c) __builtin_amdgcn_mfma_f32_16x16x32_bf16((a), (b), (c), 0, 0, 0)


#define XB_TMO      128
#define XB_XCNT(j)  (256  + 64 * (j))
#define XB_XSUB(j)  (1280 + 64 * (j))
#define XB_XGEN(j)  (2304 + 64 * (j))
#define XB_TOP      3328
#define XB_TOPGEN   3392
#define XCD_BAR_WORDS 3456
#define XB_SPIN_CAP (1u << 22)
#define LAS __attribute__((address_space(3)))
DI unsigned xb_ld(unsigned* p) { return __hip_atomic_load(p, __ATOMIC_RELAXED, __HIP_MEMORY_SCOPE_AGENT); }
DI unsigned xb_add(unsigned* p, unsigned v) { return __hip_atomic_fetch_add(p, v, __ATOMIC_RELAXED, __HIP_MEMORY_SCOPE_AGENT); }
DI unsigned xb_xcc_id() { return (unsigned)__builtin_amdgcn_s_getreg((3 << 11) | 20) & 0xFu; }
#define XB_SPIN(cond, bar) do { unsigned _sp = 0; while (cond) { __builtin_amdgcn_s_sleep(1); \
    if ((++_sp & 255u) == 0u) { if (xb_ld(&(bar)[XB_TMO])) break; if (_sp > XB_SPIN_CAP) { atomicAdd(&(bar)[XB_TMO], 1u); break; } } } } while (0)
struct XcdBarrier { unsigned* bar; unsigned x; volatile LAS unsigned* st; };
DI XcdBarrier xcd_barrier_post(unsigned* bar, volatile LAS unsigned* st) {
    XcdBarrier b; b.bar = bar; b.x = xb_xcc_id(); b.st = st;
    if (threadIdx.x == 0) (void)xb_add(&bar[XB_XCNT(b.x)], 1u);
    return b;
}
DI void xcd_barrier_complete(unsigned* bar, unsigned x, unsigned& nloc, unsigned& nx) {
    const unsigned G = gridDim.x * gridDim.y * gridDim.z;
    unsigned sum, cnt, mine, sp = 0u;
    for (;;) {
        sum = 0u; cnt = 0u; mine = 0u;
#pragma unroll
        for (unsigned j = 0; j < 16; ++j) { const unsigned c = xb_ld(&bar[XB_XCNT(j)]); sum += c; cnt += (c > 0u) ? 1u : 0u; mine = (j == x) ? c : mine; }
        if (sum == G) break;
        __builtin_amdgcn_s_sleep(1);
        if ((++sp & 255u) == 0u) { if (xb_ld(&bar[XB_TMO])) break; if (sp > XB_SPIN_CAP) { atomicAdd(&bar[XB_TMO], 1u); break; } }
    }
    nloc = mine > 0u ? mine : 1u; nx = cnt > 0u ? cnt : 1u;
}
DI void xcd_barrier(const XcdBarrier& b) {
    asm volatile("s_waitcnt vmcnt(0)" ::: "memory");
    __syncthreads();
    if (threadIdx.x == 0) {
        unsigned* bar = b.bar;
        __builtin_amdgcn_s_waitcnt(0);
        unsigned nloc = b.st[0], nx = b.st[1];
        if (nloc == 0u) { xcd_barrier_complete(bar, b.x, nloc, nx); b.st[0] = nloc; b.st[1] = nx; }
        const unsigned old = xb_add(&bar[XB_XSUB(b.x)], 1u);
        const unsigned gen = old / nloc;
        if (old + 1u == (gen + 1u) * nloc) {
            __builtin_amdgcn_fence(__ATOMIC_RELEASE, "agent");
            asm volatile("s_waitcnt vmcnt(0)" ::: "memory");
            const unsigned og = xb_add(&bar[XB_TOP], 1u);
            const unsigned tg = og / nx;
            if (og + 1u == (tg + 1u) * nx) xb_add(&bar[XB_TOPGEN], 1u);
            else XB_SPIN(xb_ld(&bar[XB_TOPGEN]) == tg, bar);
            __builtin_amdgcn_fence(__ATOMIC_ACQUIRE, "agent");
            xb_add(&bar[XB_XGEN(b.x)], 1u);
            asm volatile("s_waitcnt vmcnt(0)" ::: "memory");
        } else {
            XB_SPIN(xb_ld(&bar[XB_XGEN(b.x)]) == gen, bar);
            __builtin_amdgcn_fence(__ATOMIC_ACQUIRE, "agent");
            asm volatile("s_waitcnt vmcnt(0)" ::: "memory");
        }
    }
    __syncthreads();
}

constexpr int BM = 256, BK = 64, HALF = 128, NXCD = 8, WGM = 8, HT = HALF * BK;
DI int lds_byte(int r, int c) { int st = (r >> 4) * 2 + (c >> 5), rr = r & 15, cc = c & 31, ob = rr * 64 + cc * 2; return st * 1024 + (ob ^ (((ob >> 9) & 1) << 5)); }
DI void stage_rc(int b, int& R, int& C) { int st = b / 1024, sb = b % 1024, swz = sb ^ (((sb >> 9) & 1) << 5); R = (st >> 1) * 16 + swz / 64; C = (st & 1) * 32 + (swz % 64) / 2; }

DI int perm32(int rho) { const int n = rho >> 4, i = rho & 15; return 8 * (i >> 2) + 4 * n + (i & 3); }
struct Unit { int pm, pn; };
struct StaticOrder {
    int nM, nN, nwg, G, c, pm0, wgm;
    DI void init(int nM_, int nN_, int G_, int c_, int pm0_, int wgm_ = WGM) { nM = nM_; nN = nN_; nwg = nM * nN; G = G_; c = c_; pm0 = pm0_; wgm = wgm_; }
    DI bool next(int i, Unit& u) const {
        const long L = (long)i * G + c; if (c >= G || L >= nwg) return false;
        int wgid = (int)L; { const int q = nwg / NXCD, r = nwg % NXCD, xcd = wgid % NXCD, off = wgid / NXCD; wgid = (xcd < r ? xcd * (q + 1) : r * (q + 1) + (xcd - r) * q) + off; }
        const int nig = wgm * nN, gid = wgid / nig, fm = gid * wgm, gsz = (nM - fm) < wgm ? (nM - fm) : wgm;
        u.pm = pm0 + fm + ((wgid % nig) % gsz); u.pn = (wgid % nig) / gsz; return true;
    }
};
template <class Epi, class Sched>
DI void gemm_phase(const u16* __restrict__ A, const u16* __restrict__ Bt, const Sched& S, const Epi& E) {
    LAS unsigned char* lds = (LAS unsigned char*)shm;
    constexpr int K = 1024, nt = K / BK, HTB = HT * 2;
    const int tid = tid_opaque(), wid = __builtin_amdgcn_readfirstlane(tid >> 6), lane = tid & 63, wr = wid >> 2, wc = wid & 3, fr = lane & 15, fq = lane >> 4;
    unsigned voffA[2], voffB[2];
#pragma unroll
    for (int i = 0; i < 2; ++i) { int R, C; stage_rc(tid * 16 + i * 8192, R, C); const int Rb = (R & ~31) + perm32(R & 31);
        voffA[i] = (unsigned)(R * K + C) * 2u; voffB[i] = (unsigned)(Rb * K + C) * 2u; }
    const size_t kstep = (size_t)(BK * 2), hstep = (size_t)HALF * K * 2, tstep = 2 * hstep;
    const unsigned ldsw = (unsigned)wid * 1024u;
    const int aoff = lds_byte(wr * 64 + fr, fq * 8), boff = lds_byte(wc * 32 + fr, fq * 8);
#define SA(b, h) (((b) * 2 + (h)) * HTB)
#define SB(b, h) ((4 + (b) * 2 + (h)) * HTB)
#define STAGE(bufoff, gbase, voff) do { _Pragma("unroll") for (int _i = 0; _i < 2; ++_i) \
    __builtin_amdgcn_global_load_lds((const unsigned*)((const char*)(gbase) + (voff)[_i]), (LAS unsigned*)(lds + (bufoff) + ldsw + _i * 8192), 16, 0, 0); } while (0)
#define LDA(dst, b, h) do { _Pragma("unroll") for (int m = 0; m < 4; ++m) _Pragma("unroll") for (int k = 0; k < 2; ++k) dst[m][k] = *(const LAS bf16x8*)(lds + SA(b, h) + aoff + m * 2048 + k * 1024); } while (0)
#define LDB(dst, b, h) do { _Pragma("unroll") for (int n = 0; n < 2; ++n) _Pragma("unroll") for (int k = 0; k < 2; ++k) dst[n][k] = *(const LAS bf16x8*)(lds + SB(b, h) + boff + n * 2048 + k * 1024); } while (0)
#define MMA(ai, bj, At, Bt_) do { __builtin_amdgcn_s_setprio(1); _Pragma("unroll") for (int m = 0; m < 4; ++m) _Pragma("unroll") for (int n = 0; n < 2; ++n) _Pragma("unroll") for (int k = 0; k < 2; ++k) \
      acc[ai][bj][m][n] = MFMA16(Bt_[n][k], At[m][k], acc[ai][bj][m][n]); \
    __builtin_amdgcn_s_setprio(0); } while (0)
#define WAIT_V(n) asm volatile("s_waitcnt vmcnt(" #n ")" ::: "memory")
#define WAIT_L(n) asm volatile("s_waitcnt lgkmcnt(" #n ")" ::: "memory")
#define BAR __builtin_amdgcn_s_barrier()
#define SCHED __builtin_amdgcn_sched_barrier(0)
    Unit cur, nxt; int ui = 0;
    if (!S.next(0, cur)) return;
    f32x4 acc[2][2][4][2];
#pragma unroll
    for (int a = 0; a < 2; ++a)
#pragma unroll
        for (int b = 0; b < 2; ++b)
#pragma unroll
            for (int m = 0; m < 4; ++m)
#pragma unroll
                for (int n = 0; n < 2; ++n) acc[a][b][m][n] = (f32x4){0.f, 0.f, 0.f, 0.f};
    bf16x8 At[4][2], B0[2][2], B1[2][2];
    const char* cA = (const char*)A + (size_t)cur.pm * tstep; const char* cB = (const char*)Bt + (size_t)cur.pn * tstep;
    STAGE(SB(0, 0), cB, voffB); STAGE(SB(0, 1), cB + hstep, voffB); STAGE(SA(0, 0), cA, voffA); STAGE(SA(0, 1), cA + hstep, voffA);
    if (wr == 1) BAR;
    WAIT_V(2); BAR;
    STAGE(SB(1, 0), cB + kstep, voffB); STAGE(SA(1, 0), cA + kstep, voffA); STAGE(SB(1, 1), cB + hstep + kstep, voffB);
    WAIT_V(6); BAR;
    for (;;) {
        const bool has_next = S.next(ui + 1, nxt);
        const char* nA = has_next ? (const char*)A + (size_t)nxt.pm * tstep : cA; const char* nB = has_next ? (const char*)Bt + (size_t)nxt.pn * tstep : cB;
        for (int t = 0; t < nt; t += 2) {
            const bool last = (t == nt - 2);
            const char* a1 = cA + (size_t)(t + 1) * kstep;
            const char* a2 = last ? nA : cA + (size_t)(t + 2) * kstep; const char* b2 = last ? nB : cB + (size_t)(t + 2) * kstep;
            const char* a3 = a2 + kstep; const char* b3 = b2 + kstep;
            LDB(B0, 0, 0); LDB(B1, 0, 1); SCHED; LDA(At, 0, 0); STAGE(SA(1, 1), a1 + hstep, voffA);
            WAIT_V(8); WAIT_L(0); BAR; MMA(0, 0, At, B0); MMA(0, 1, At, B1); BAR; SCHED;
            LDA(At, 0, 1); STAGE(SB(0, 0), b2, voffB); STAGE(SB(0, 1), b2 + hstep, voffB); STAGE(SA(0, 0), a2, voffA);
            WAIT_V(8); WAIT_L(0); BAR; MMA(1, 0, At, B0); MMA(1, 1, At, B1); BAR; SCHED;
            LDB(B0, 1, 0); LDB(B1, 1, 1); SCHED; LDA(At, 1, 0); STAGE(SA(0, 1), a2 + hstep, voffA);
            WAIT_V(8); WAIT_L(0); BAR; MMA(0, 0, At, B0); MMA(0, 1, At, B1); BAR; SCHED;
            LDA(At, 1, 1); STAGE(SB(1, 0), b3, voffB); STAGE(SB(1, 1), b3 + hstep, voffB); STAGE(SA(1, 0), a3, voffA);
            WAIT_V(8); WAIT_L(0); BAR; MMA(1, 0, At, B0); MMA(1, 1, At, B1); BAR; SCHED;
        }
        if (wr == 0) BAR;
        E(acc, cur.pm * BM, cur.pn * BM, wr, wc, fr, fq);
        if (!has_next) break;
#pragma unroll
        for (int a = 0; a < 2; ++a)
#pragma unroll
            for (int b = 0; b < 2; ++b)
#pragma unroll
                for (int m = 0; m < 4; ++m)
#pragma unroll
                    for (int n = 0; n < 2; ++n) acc[a][b][m][n] = (f32x4){0.f, 0.f, 0.f, 0.f};
        cur = nxt; cA = nA; cB = nB; ++ui;
        if (wr == 1) BAR;
    }
    WAIT_V(0);
    BAR;
    __syncthreads();
#undef SA
#undef SB
#undef STAGE
#undef LDA
#undef LDB
#undef MMA
}

struct EpiIn {
    unsigned char* ws; float* out; int l;
    DI void operator()(const f32x4 (&acc)[2][2][4][2], int brow, int bcol, int wr, int wc, int fr, int fq) const {
        int ll = l; asm volatile("" : "+s"(ll));
        u16* H = (u16*)(ws + WS_H); const float* RT = (const float*)(ws + WS_RT);
        float* okp = out + O_KP + (size_t)ll * 16 * 128 * 128; float* ovp = out + O_VP + (size_t)ll * 16 * 128 * 128;
        float* oks = out + O_KS + (size_t)ll * 16 * 16 * 128; float* ovs = out + O_VS + (size_t)ll * 16 * 16 * 128;
        u16* KVS = (u16*)(ws + WS_KVS) + (size_t)ll * 16 * 144 * 256;
        int type[2];
#pragma unroll
        for (int bj = 0; bj < 2; ++bj) {
            const int cb = bcol + bj * HALF; int ty;
            if (cb < C_ZA) ty = 0; else if (cb < C_FB) ty = 1; else if (cb < C_IB) ty = 5; else if (cb < C_ZB) ty = 0; else if (cb < C_QC) ty = 1;
            else if (cb < C_KC) ty = 2; else if (cb == C_KC) ty = 3; else if (cb == C_VC) ty = 4; else ty = 1;
            type[bj] = ty;
        }
        const int cin = wc * 32 + fq * 8;
        f32x4 lbv[2][2];
#pragma unroll
        for (int bj = 0; bj < 2; ++bj) {
            lbv[bj][0] = (f32x4){0.f, 0.f, 0.f, 0.f}; lbv[bj][1] = (f32x4){0.f, 0.f, 0.f, 0.f};
            if (type[bj] == 5) { const float* lbp = (const float*)(ws + WS_LB) + ll * 256 + (bcol + bj * HALF - C_FB) + cin; lbv[bj][0] = *(const f32x4*)lbp; lbv[bj][1] = *(const f32x4*)(lbp + 4); }
        }
#pragma unroll
        for (int ai = 0; ai < 2; ++ai)
#pragma unroll
            for (int m = 0; m < 4; ++m) {
                const int row = brow + ai * HALF + wr * 64 + m * 16 + fr;
                int posidx, kvo = -1; float* ko = nullptr; float* vo = nullptr; u16* kvs = nullptr;
                if (row < NTOKP) { const int b = row >> 12, t = row & 4095; posidx = t;
                    if (t >= SEQ - 128) { kvo = (b * 128 + (t - (SEQ - 128))) * 128; ko = okp; vo = ovp; } }
                else { const int s = row - NTOKP, sb = s >> 4, st = s & 15; posidx = 4096 + st; kvo = (sb * 16 + st) * 128; ko = oks; vo = ovs; kvs = KVS + (size_t)(sb * 144 + 128 + st) * 256; }
                u16* hrow = H + (size_t)row * INW;
#pragma unroll
                for (int bj = 0; bj < 2; ++bj) {
                    const int cb = bcol + bj * HALF, ty = type[bj];
                    f32x4 v0 = acc[ai][bj][m][0], v1 = acc[ai][bj][m][1];
                    if (ty == 1) {
#pragma unroll
                        for (int j = 0; j < 4; ++j) { v0[j] = silu_f(v0[j]); v1[j] = silu_f(v1[j]); }
                    } else if (ty == 5) {
                        const f32x4 l0 = lbv[bj][0], l1 = lbv[bj][1];
#pragma unroll
                        for (int j = 0; j < 4; ++j) {
                            const float t0 = __expf(-v0[j]), t1 = __expf(-v1[j]);
                            const float s0 = __builtin_amdgcn_rcpf(1.f + t0), s1 = __builtin_amdgcn_rcpf(1.f + t1);
                            const float k0 = (1.f - l0[j]) * t0 * s0, k1 = (1.f - l1[j]) * t1 * s1;
                            const float f0 = l0[j] + (1.f - l0[j]) * s0, f1 = l1[j] + (1.f - l1[j]) * s1;
                            v0[j] = (k0 <= 0.5f) ? k0 : -f0; v1[j] = (k1 <= 0.5f) ? k1 : -f1;
                        }
                    } else if (ty == 2 || ty == 3) {
                        if ((wc & 1) == 0) {
                            const f32x4 c0 = *(const f32x4*)(RT + (size_t)posidx * 16), c1 = *(const f32x4*)(RT + (size_t)posidx * 16 + 4), c2 = *(const f32x4*)(RT + (size_t)posidx * 16 + 8), c3 = *(const f32x4*)(RT + (size_t)posidx * 16 + 12);
                            const float cs[8] = {c0[0], c0[2], c1[0], c1[2], c2[0], c2[2], c3[0], c3[2]}, sn[8] = {c0[1], c0[3], c1[1], c1[3], c2[1], c2[3], c3[1], c3[3]};
#pragma unroll
                            for (int e = 0; e < 8; ++e) {
                                const float mine = (e < 4) ? v0[e & 3] : v1[e & 3];
                                const float pv = __shfl_xor(mine, 16);
                                const float rot = (fq == 0) ? (mine * cs[e] - pv * sn[e]) : (mine * cs[e] + pv * sn[e]);
                                const float res = (fq < 2) ? rot : mine;
                                if (e < 4) v0[e & 3] = res; else v1[e & 3] = res;
                            }
                        }
                        if (ty == 3) { if (kvo >= 0) { *(f32x4*)(ko + kvo + cin) = v0; *(f32x4*)(ko + kvo + cin + 4) = v1; } }
                        else { v0 = v0 * 0.18033688011112042f; v1 = v1 * 0.18033688011112042f; }
                    } else if (ty == 4) { if (kvo >= 0) { *(f32x4*)(vo + kvo + cin) = v0; *(f32x4*)(vo + kvo + cin + 4) = v1; } }
                    u32x4 w; w.x = cvt_pk_bf16(v0[0], v0[1]); w.y = cvt_pk_bf16(v0[2], v0[3]); w.z = cvt_pk_bf16(v1[0], v1[1]); w.w = cvt_pk_bf16(v1[2], v1[3]);
                    if (ty == 5) {
                        w.x = f2h(v0[0]) | (f2h(v0[1]) << 16); w.y = f2h(v0[2]) | (f2h(v0[3]) << 16); w.z = f2h(v1[0]) | (f2h(v1[1]) << 16); w.w = f2h(v1[2]) | (f2h(v1[3]) << 16);
                    }
                    __builtin_nontemporal_store(w, (u32x4*)(hrow + cb + cin));
                    if ((ty == 3 || ty == 4) && kvs) *(u32x4*)(kvs + (cb + cin - C_KC)) = w;
                }
                asm volatile("" ::: "memory");
            }
    }
};
struct EpiOut {
    unsigned char* ws;
    DI void operator()(const f32x4 (&acc)[2][2][4][2], int brow, int bcol, int wr, int wc, int fr, int fq) const {
        size_t zo = WS_H; asm volatile("" : "+s"(zo));
        u16* Z = (u16*)(ws + zo); const u16* XB = (const u16*)(ws + zo - WS_H + WS_XB);
        u32x4 xw[2][4][2];
#pragma unroll
        for (int ai = 0; ai < 2; ++ai)
#pragma unroll
            for (int m = 0; m < 4; ++m)
#pragma unroll
                for (int bj = 0; bj < 2; ++bj)
                    xw[ai][m][bj] = *(const u32x4*)(XB + (size_t)(brow + ai * HALF + wr * 64 + m * 16 + fr) * DM + bcol + bj * HALF + wc * 32 + fq * 8);
#pragma unroll
        for (int ai = 0; ai < 2; ++ai)
#pragma unroll
            for (int m = 0; m < 4; ++m) {
                const int row = brow + ai * HALF + wr * 64 + m * 16 + fr;
#pragma unroll
                for (int bj = 0; bj < 2; ++bj) {
                    const int col0 = bcol + bj * HALF + wc * 32 + fq * 8;
                    const u32x4 x4 = xw[ai][m][bj];
                    f32x4 v0 = acc[ai][bj][m][0], v1 = acc[ai][bj][m][1];
                    v0[0] += ALPHA * bflo(x4.x); v0[1] += ALPHA * bfhi(x4.x); v0[2] += ALPHA * bflo(x4.y); v0[3] += ALPHA * bfhi(x4.y);
                    v1[0] += ALPHA * bflo(x4.z); v1[1] += ALPHA * bfhi(x4.z); v1[2] += ALPHA * bflo(x4.w); v1[3] += ALPHA * bfhi(x4.w);
                    u32x4 w; w.x = cvt_pk_bf16(v0[0], v0[1]); w.y = cvt_pk_bf16(v0[2], v0[3]); w.z = cvt_pk_bf16(v1[0], v1[1]); w.w = cvt_pk_bf16(v1[2], v1[3]);
                    __builtin_nontemporal_store(w, (u32x4*)(Z + (size_t)row * DM + col0));
                }
            }
    }
};

DI void phase_prologue(const Params& p) {
    const int tid = tid_opaque();
    const long gt = (long)blockIdx.x * 512 + tid, nth = (long)gridDim.x * 512;
    unsigned char* ws = p.ws;
    const int NTW = (gridDim.x >= 256) ? 48 : 0;
    const bool do_cvt = (NTW == 0) || ((int)blockIdx.x >= NTW), do_tr = (NTW == 0) || ((int)blockIdx.x < NTW);
    const long gtc = (long)((int)blockIdx.x - NTW) * 512 + tid, nthc = (long)((int)gridDim.x - NTW) * 512;
    if (do_cvt) {
        u16* XB = (u16*)(ws + WS_XB);
        const long nv = (long)MTOT * DM / 8;
        const long nth = nthc;
        for (long i0 = gtc; i0 < nv; i0 += 4 * nth) {
            f32x4 a[4], b[4];
#pragma unroll
            for (int k = 0; k < 4; ++k) {
                const long i = i0 + k * nth;
                const long e = (i < nv ? i : i0) * 8;
                const float* sp = (e < (long)NTOKP * DM) ? (p.x_prompt + e) : (p.x_sample + (e - (long)NTOKP * DM));
                a[k] = __builtin_nontemporal_load((const f32x4*)sp); b[k] = __builtin_nontemporal_load((const f32x4*)(sp + 4));
            }
#pragma unroll
            for (int k = 0; k < 4; ++k) {
                const long i = i0 + k * nth;
                if (i < nv) {
                    u32x4 o; o.x = cvt_pk_bf16(a[k][0], a[k][1]); o.y = cvt_pk_bf16(a[k][2], a[k][3]); o.z = cvt_pk_bf16(b[k][0], b[k][1]); o.w = cvt_pk_bf16(b[k][2], b[k][3]);
                    *(u32x4*)(XB + i * 8) = o;
                }
            }
        }
    }
    if (do_tr) {
        float* tile = (float*)shm;
        const int T_IN = 16 * 48, T_OUT = 16 * 16, NT = 2 * T_IN + 2 * T_OUT;
        const int trs = NTW ? NTW : (int)gridDim.x;
        for (int it = blockIdx.x; it < NT; it += trs) {
            const float* W; u16* WT; int N, r = it;
            if (r < 2 * T_IN) { const int l = r / T_IN; r -= l * T_IN; W = p.w_in + (size_t)l * DM * INW; WT = (u16*)(ws + WS_WTIN) + (size_t)l * INW * DM; N = INW; }
            else { r -= 2 * T_IN; const int l = r / T_OUT; r -= l * T_OUT; W = p.w_out + (size_t)l * MIXW * DM; WT = (u16*)(ws + WS_WTOUT) + (size_t)l * DM * MIXW; N = DM; }
            const int nb = N / 64, k0 = (r / nb) * 64, n0 = (r % nb) * 64;
#pragma unroll
            for (int i = 0; i < 8; ++i) { const int idx = tid + i * 512, kk = idx >> 6, nn = idx & 63; tile[kk * 65 + nn] = W[(size_t)(k0 + kk) * N + n0 + nn]; }
            __syncthreads();
#pragma unroll
            for (int i = 0; i < 8; ++i) { const int idx = tid + i * 512, nn = idx >> 6, kk = idx & 63; WT[(size_t)(n0 + nn) * 1024 + k0 + kk] = f2bf(tile[kk * 65 + nn]); }
            __syncthreads();
        }
    }
    {
        u16* WSB = (u16*)(ws + WS_WSB);
        for (long i = gt; i < 2 * 4 * 128 * 128; i += nth) { const int jj = i & 127, ii = (i >> 7) & 127; WSB[i] = ((jj >> 6) <= (ii >> 6)) ? f2bf(p.w_s[i]) : (u16)0; }
    }
    {
        float2* RT = (float2*)(ws + WS_RT);
        for (long i = gt; i < 4112 * 8; i += nth) {
            const int pi = (int)(i >> 3), fi = (int)(i & 7);
            const int pos = pi < 4096 ? pi : 2048 + (pi - 4096);
            const float ang = (float)pos * p.inv[fi];
            double r = (double)ang * 0.15915494309189533577; r -= rint(r);
            const float rf = (float)r;
            RT[i] = make_float2(__builtin_amdgcn_cosf(rf), __builtin_amdgcn_sinf(rf));
        }
    }
    {
        u16* KVS = (u16*)(ws + WS_KVS);
        for (long i = gt; i < 2 * 16 * 128 * 256; i += nth) {
            const int c = i & 255, row = (i >> 8) & 127, lb = (int)(i >> 15);
            const float v = (c < 128) ? p.cache_k[((size_t)lb * 128 + row) * 128 + c] : p.cache_v[((size_t)lb * 128 + row) * 128 + (c - 128)];
            KVS[((size_t)lb * 144 + row) * 256 + c] = f2bf(v);
        }
    }
    {
        float* LB = (float*)(ws + WS_LB);
        for (long i = gt; i < 256; i += nth) {
            const float a = p.lb_param[i], b = p.lb_param[256 + i], m = fmaxf(a, b);
            const float ea = expf(a - m), eb = expf(b - m);
            LB[i] = 0.f; LB[256 + i] = eb / (ea + eb);
        }
    }
}

constexpr int VROW = 72;
DI void attn_unit(const u16* __restrict__ Q, int qstride, int nq, const u16* __restrict__ Kp, const u16* __restrict__ Vp, int kvstride, int nkeys,
                  const u16* __restrict__ Zg, int zstride, u16* __restrict__ Out, int ostride, const float* __restrict__ sinks4) {
    u16* Vl = (u16*)shm;
    const int tid = tid_opaque(), wid = __builtin_amdgcn_readfirstlane(tid >> 6), lane = tid & 63, fr = lane & 15, fq = lane >> 4;
    const int nk32 = (nkeys + 31) & ~31, nkt = nk32 >> 4, nks = nk32 >> 5;
    const int r = wid >> 1, q0 = (wid & 1) * 32;
    const bool active = q0 < nq;
    u32x4 vreg[3];
#pragma unroll
    for (int i = 0; i < 3; ++i) {
        const int idx = tid + i * 512, key = idx >> 3, d0 = (idx & 7) * 8;
        vreg[i] = (u32x4){0u, 0u, 0u, 0u};
        if (key < nkeys) vreg[i] = *(const u32x4*)(Vp + (size_t)key * kvstride + d0);
    }
    bf16x8 bq[2][2], ak[12][2];
    if (active) {
#pragma unroll
        for (int qt = 0; qt < 2; ++qt)
#pragma unroll
            for (int ks = 0; ks < 2; ++ks) { const int qrow = min(q0 + qt * 16 + fr, nq - 1); bq[qt][ks] = *(const bf16x8*)(Q + (size_t)qrow * qstride + r * 64 + ks * 32 + fq * 8); }
#pragma unroll
        for (int kt = 0; kt < 12; ++kt) if (kt < nkt) {
            const int krow = min(kt * 16 + fr, nkeys - 1);
            ak[kt][0] = *(const bf16x8*)(Kp + (size_t)krow * kvstride + fq * 8); ak[kt][1] = *(const bf16x8*)(Kp + (size_t)krow * kvstride + 32 + fq * 8);
        }
    }
#pragma unroll
    for (int i = 0; i < 3; ++i) {
        const int idx = tid + i * 512, key = idx >> 3, d0 = (idx & 7) * 8;
        if (key < nk32) *(u32x4*)(Vl + key * VROW + d0) = vreg[i];
    }
    __syncthreads();
    if (active) {
        f32x4 st[12][2];
#pragma unroll
        for (int kt = 0; kt < 12; ++kt) {
            st[kt][0] = (f32x4){0.f, 0.f, 0.f, 0.f}; st[kt][1] = (f32x4){0.f, 0.f, 0.f, 0.f};
            if (kt < nkt) {
#pragma unroll
                for (int qt = 0; qt < 2; ++qt) { st[kt][qt] = MFMA16(ak[kt][0], bq[qt][0], st[kt][qt]); st[kt][qt] = MFMA16(ak[kt][1], bq[qt][1], st[kt][qt]); }
            }
        }
        u32x2 zw[2][4];
#pragma unroll
        for (int qt = 0; qt < 2; ++qt) {
            const int q = min(q0 + qt * 16 + fr, nq - 1);
#pragma unroll
            for (int dt = 0; dt < 4; ++dt) zw[qt][dt] = *(const u32x2*)(Zg + (size_t)q * zstride + r * 64 + dt * 16 + fq * 4);
        }
        const float sink = sinks4[r] * 1.4426950408889634f;
        float inv_den[2];
        bf16x8 pb[2][6];
#pragma unroll
        for (int qt = 0; qt < 2; ++qt) {
            float mx = sink;
#pragma unroll
            for (int kt = 0; kt < 12; ++kt) if (kt < nkt) {
#pragma unroll
                for (int j = 0; j < 4; ++j) { const int key = kt * 16 + fq * 4 + j; float s = st[kt][qt][j]; if (key >= nkeys) s = -INFINITY; st[kt][qt][j] = s; mx = fmaxf(mx, s); }
            }
            mx = fmaxf(mx, __shfl_xor(mx, 16)); mx = fmaxf(mx, __shfl_xor(mx, 32));
            float sum = 0.f;
#pragma unroll
            for (int kt = 0; kt < 12; ++kt) if (kt < nkt) {
#pragma unroll
                for (int j = 0; j < 4; ++j) { const float e = __builtin_amdgcn_exp2f(st[kt][qt][j] - mx); st[kt][qt][j] = e; sum += e; }
            }
            sum += __shfl_xor(sum, 16); sum += __shfl_xor(sum, 32);
            inv_den[qt] = 1.f / (sum + __builtin_amdgcn_exp2f(sink - mx));
#pragma unroll
            for (int s2 = 0; s2 < 6; ++s2) {
                u32x4 w;
                w.x = cvt_pk_bf16(st[2 * s2][qt][0], st[2 * s2][qt][1]); w.y = cvt_pk_bf16(st[2 * s2][qt][2], st[2 * s2][qt][3]);
                w.z = cvt_pk_bf16(st[2 * s2 + 1][qt][0], st[2 * s2 + 1][qt][1]); w.w = cvt_pk_bf16(st[2 * s2 + 1][qt][2], st[2 * s2 + 1][qt][3]);
                pb[qt][s2] = __builtin_bit_cast(bf16x8, w);
            }
        }
        f32x4 o[4][2];
#pragma unroll
        for (int dt = 0; dt < 4; ++dt) { o[dt][0] = (f32x4){0.f, 0.f, 0.f, 0.f}; o[dt][1] = (f32x4){0.f, 0.f, 0.f, 0.f}; }
#pragma unroll
        for (int s2 = 0; s2 < 6; ++s2) if (s2 < nks) {
#pragma unroll
            for (int dt = 0; dt < 4; ++dt) {
                const u16* vr = Vl + (32 * s2 + 4 * fq + (fr >> 2)) * VROW + dt * 16 + 4 * (fr & 3);
                const s16x4 lo = tr_read4(vr), hi = tr_read4(vr + 16 * VROW);
                const bf16x8 a = __builtin_shufflevector(lo, hi, 0, 1, 2, 3, 4, 5, 6, 7);
                o[dt][0] = MFMA16(a, pb[0][s2], o[dt][0]); o[dt][1] = MFMA16(a, pb[1][s2], o[dt][1]);
            }
        }
#pragma unroll
        for (int qt = 0; qt < 2; ++qt) {
            const int q = q0 + qt * 16 + fr;
            if (q < nq) {
#pragma unroll
                for (int dt = 0; dt < 4; ++dt) {
                    const int d = dt * 16 + fq * 4;
                    const u32x2 z2 = zw[qt][dt];
                    const f32x4 ov = o[dt][qt] * inv_den[qt];
                    u32x2 w; w.x = cvt_pk_bf16(ov[0] * bflo(z2.x), ov[1] * bfhi(z2.x)); w.y = cvt_pk_bf16(ov[2] * bflo(z2.y), ov[3] * bfhi(z2.y));
                    *(u32x2*)(Out + (size_t)q * ostride + r * 64 + d) = w;
                }
            }
        }
    }
    __syncthreads();
}

DI void attn_run(const Params& p, int l, int run) {
    unsigned char* ws = p.ws;
    const u16* H = (const u16*)(ws + WS_H); u16* MIX = (u16*)(ws + WS_MIX);
    u16* Kl = (u16*)shm; u16* Vl = Kl + 4 * 64 * VROW;
    const int tid = tid_opaque(), wid = __builtin_amdgcn_readfirstlane(tid >> 6), lane = tid & 63, fr = lane & 15, fq = lane >> 4;
    const int r = wid >> 1, q0 = (wid & 1) * 32;
    const int b = run >> 4, g = (run >> 3) & 1, c0 = (run & 7) * 8;
    const u16* Hb = H + (size_t)b * SEQ * INW;
    u16* Mb = MIX + (size_t)b * SEQ * MIXW;
    const int lkey = tid >> 3, ld0 = (tid & 7) * 8;
    const float sink = p.sinks[l * 8 + g * 4 + r] * 1.4426950408889634f;
    {
        u32x4 kv3[3], vv3[3];
#pragma unroll
        for (int i = 0; i < 3; ++i) {
            const int ch = c0 - 2 + i;
            kv3[i] = (u32x4){0u, 0u, 0u, 0u}; vv3[i] = (u32x4){0u, 0u, 0u, 0u};
            if (ch >= 0) { const u16* srow = Hb + (size_t)(ch * 64 + lkey) * INW; kv3[i] = *(const u32x4*)(srow + C_KC + g * 64 + ld0); vv3[i] = *(const u32x4*)(srow + C_VC + g * 64 + ld0); }
        }
#pragma unroll
        for (int i = 0; i < 3; ++i) {
            const int ch = c0 - 2 + i;
            if (ch >= 0) { *(u32x4*)(Kl + ((ch & 3) * 64 + lkey) * VROW + ld0) = kv3[i]; *(u32x4*)(Vl + ((ch & 3) * 64 + lkey) * VROW + ld0) = vv3[i]; }
        }
    }
    bf16x8 bq[2][2];
#pragma unroll
    for (int qt = 0; qt < 2; ++qt)
#pragma unroll
        for (int ks = 0; ks < 2; ++ks) bq[qt][ks] = *(const bf16x8*)(Hb + (size_t)(c0 * 64 + q0 + qt * 16 + fr) * INW + C_QC + g * 256 + r * 64 + ks * 32 + fq * 8);
    __syncthreads();
#pragma unroll 1
    for (int u = 0; u < 8; ++u) {
        const int c = c0 + u;
        const int nch = min(c + 1, 3), cf = c - nch + 1, nkt = nch * 4;
        u32x4 kn = {0u, 0u, 0u, 0u}, vn = {0u, 0u, 0u, 0u}; bf16x8 bqn[2][2];
        if (u < 7) {
            const u16* srow = Hb + (size_t)((c + 1) * 64 + lkey) * INW;
            kn = *(const u32x4*)(srow + C_KC + g * 64 + ld0); vn = *(const u32x4*)(srow + C_VC + g * 64 + ld0);
#pragma unroll
            for (int qt = 0; qt < 2; ++qt)
#pragma unroll
                for (int ks = 0; ks < 2; ++ks) bqn[qt][ks] = *(const bf16x8*)(Hb + (size_t)((c + 1) * 64 + q0 + qt * 16 + fr) * INW + C_QC + g * 256 + r * 64 + ks * 32 + fq * 8);
        } else {
#pragma unroll
            for (int qt = 0; qt < 2; ++qt)
#pragma unroll
                for (int ks = 0; ks < 2; ++ks) bqn[qt][ks] = bq[qt][ks];
        }
        u32x4 zw[2][2];
#pragma unroll
        for (int qt = 0; qt < 2; ++qt)
#pragma unroll
            for (int dd = 0; dd < 2; ++dd) zw[qt][dd] = *(const u32x4*)(Hb + (size_t)(c * 64 + q0 + qt * 16 + fr) * INW + C_ZC + g * 256 + r * 64 + dd * 32 + fq * 8);
        f32x4 st[12][2];
#pragma unroll
        for (int kt = 0; kt < 12; ++kt) {
            st[kt][0] = (f32x4){0.f, 0.f, 0.f, 0.f}; st[kt][1] = (f32x4){0.f, 0.f, 0.f, 0.f};
            if (kt < nkt) {
                const int row = (((cf + (kt >> 2)) & 3) * 64 + (kt & 3) * 16 + fr);
                const bf16x8 a0 = *(const bf16x8*)(Kl + row * VROW + fq * 8), a1 = *(const bf16x8*)(Kl + row * VROW + 32 + fq * 8);
#pragma unroll
                for (int qt = 0; qt < 2; ++qt) { st[kt][qt] = MFMA16(a0, bq[qt][0], st[kt][qt]); st[kt][qt] = MFMA16(a1, bq[qt][1], st[kt][qt]); }
            }
        }
        float inv_den[2];
        bf16x8 pb[2][6];
#pragma unroll
        for (int qt = 0; qt < 2; ++qt) {
            float mx = sink;
#pragma unroll
            for (int kt = 0; kt < 12; ++kt) if (kt < nkt) {
#pragma unroll
                for (int j = 0; j < 4; ++j) mx = fmaxf(mx, st[kt][qt][j]);
            }
            mx = fmaxf(mx, __shfl_xor(mx, 16)); mx = fmaxf(mx, __shfl_xor(mx, 32));
            float sum = 0.f;
#pragma unroll
            for (int kt = 0; kt < 12; ++kt) {
                if (kt < nkt) {
#pragma unroll
                    for (int j = 0; j < 4; ++j) { const float e = __builtin_amdgcn_exp2f(st[kt][qt][j] - mx); st[kt][qt][j] = e; sum += e; }
                }
            }
            sum += __shfl_xor(sum, 16); sum += __shfl_xor(sum, 32);
            inv_den[qt] = 1.f / (sum + __builtin_amdgcn_exp2f(sink - mx));
#pragma unroll
            for (int s2 = 0; s2 < 6; ++s2) {
                u32x4 w;
                w.x = cvt_pk_bf16(st[2 * s2][qt][0], st[2 * s2][qt][1]); w.y = cvt_pk_bf16(st[2 * s2][qt][2], st[2 * s2][qt][3]);
                w.z = cvt_pk_bf16(st[2 * s2 + 1][qt][0], st[2 * s2 + 1][qt][1]); w.w = cvt_pk_bf16(st[2 * s2 + 1][qt][2], st[2 * s2 + 1][qt][3]);
                pb[qt][s2] = __builtin_bit_cast(bf16x8, w);
            }
        }
        f32x4 o[4][2];
#pragma unroll
        for (int dt = 0; dt < 4; ++dt) { o[dt][0] = (f32x4){0.f, 0.f, 0.f, 0.f}; o[dt][1] = (f32x4){0.f, 0.f, 0.f, 0.f}; }
#pragma unroll
        for (int s2 = 0; s2 < 6; ++s2) if (s2 < nch * 2) {
            const int rowb = ((cf + (s2 >> 1)) & 3) * 64 + (s2 & 1) * 32;
#pragma unroll
            for (int dt = 0; dt < 4; ++dt) {
                const u16* vr = Vl + (rowb + 4 * fq + (fr >> 2)) * VROW + (dt >> 1) * 32 + 8 * (fr & 3) + 4 * (dt & 1);
                const s16x4 lo = tr_read4(vr), hi = tr_read4(vr + 16 * VROW);
                const bf16x8 a = __builtin_shufflevector(lo, hi, 0, 1, 2, 3, 4, 5, 6, 7);
                o[dt][0] = MFMA16(a, pb[0][s2], o[dt][0]); o[dt][1] = MFMA16(a, pb[1][s2], o[dt][1]);
            }
        }
#pragma unroll
        for (int qt = 0; qt < 2; ++qt) {
            u16* orow = Mb + (size_t)(c * 64 + q0 + qt * 16 + fr) * MIXW + 512 + g * 256 + r * 64;
#pragma unroll
            for (int dd = 0; dd < 2; ++dd) {
                const u32x4 z4 = zw[qt][dd];
                const f32x4 oa = o[2 * dd][qt] * inv_den[qt], ob = o[2 * dd + 1][qt] * inv_den[qt];
                u32x4 w;
                w.x = cvt_pk_bf16(oa[0] * bflo(z4.x), oa[1] * bfhi(z4.x)); w.y = cvt_pk_bf16(oa[2] * bflo(z4.y), oa[3] * bfhi(z4.y));
                w.z = cvt_pk_bf16(ob[0] * bflo(z4.z), ob[1] * bfhi(z4.z)); w.w = cvt_pk_bf16(ob[2] * bflo(z4.w), ob[3] * bfhi(z4.w));
                *(u32x4*)(orow + dd * 32 + fq * 8) = w;
            }
        }
        if (u < 7) {
            *(u32x4*)(Kl + (((c + 1) & 3) * 64 + lkey) * VROW + ld0) = kn; *(u32x4*)(Vl + (((c + 1) & 3) * 64 + lkey) * VROW + ld0) = vn;
        }
#pragma unroll
        for (int qt = 0; qt < 2; ++qt)
#pragma unroll
            for (int ks = 0; ks < 2; ++ks) bq[qt][ks] = bqn[qt][ks];
        __syncthreads();
    }
}

constexpr int VS2 = 272;
DI void sgu_prompt_unit(const Params& p, int l, int unit) {
    unsigned char* ws = p.ws;
    const u16* H = (const u16*)(ws + WS_H); u16* MIX = (u16*)(ws + WS_MIX);
    const u16* WSB = (const u16*)(ws + WS_WSB) + (size_t)l * 4 * 128 * 128;
    u16* vn = (u16*)shm;
    const int tid = tid_opaque(), wid = __builtin_amdgcn_readfirstlane(tid >> 6), lane = tid & 63, fr = lane & 15, fq = lane >> 4;
    const int T0 = unit * 128;
    const int g = wid >> 1, ih = wid & 1;
    const int nks = ih ? 4 : 2;
    const int tok = wid * 16 + (lane >> 2), part = lane & 3;
    u32x4 vraw[8];
#pragma unroll
    for (int j = 0; j < 8; ++j) vraw[j] = *(const u32x4*)(H + (size_t)(T0 + tok) * INW + C_VA + j * 32 + part * 8);
    bf16x8 wf[4][4];
#pragma unroll
    for (int ks = 0; ks < 4; ++ks) if (ks < nks) {
#pragma unroll
        for (int mm = 0; mm < 4; ++mm) wf[ks][mm] = *(const bf16x8*)(WSB + ((size_t)g * 128 + (ih * 4 + mm) * 16 + fr) * 128 + ks * 32 + fq * 8);
    }
    {
        float s = 0.f, s2 = 0.f;
#pragma unroll
        for (int j = 0; j < 8; ++j) {
            const u32x4 w = vraw[j];
            const float x0 = bflo(w.x), x1 = bfhi(w.x), x2 = bflo(w.y), x3 = bfhi(w.y), x4 = bflo(w.z), x5 = bfhi(w.z), x6 = bflo(w.w), x7 = bfhi(w.w);
            s += ((x0 + x1) + (x2 + x3)) + ((x4 + x5) + (x6 + x7));
            s2 += ((x0 * x0 + x1 * x1) + (x2 * x2 + x3 * x3)) + ((x4 * x4 + x5 * x5) + (x6 * x6 + x7 * x7));
        }
        s += __shfl_xor(s, 1); s += __shfl_xor(s, 2); s2 += __shfl_xor(s2, 1); s2 += __shfl_xor(s2, 2);
        const float mu = s * (1.f / 256.f);
        const float var = fmaxf(s2 * (1.f / 256.f) - mu * mu, 0.f);
        const float rs = rsqrtf(var + 1e-5f);
#pragma unroll
        for (int j = 0; j < 8; ++j) {
            const int ch = j * 32 + part * 8;
            const f32x4 g0 = *(const f32x4*)(p.ln_v_g + l * 256 + ch), g1 = *(const f32x4*)(p.ln_v_g + l * 256 + ch + 4);
            const f32x4 b0 = *(const f32x4*)(p.ln_v_b + l * 256 + ch), b1 = *(const f32x4*)(p.ln_v_b + l * 256 + ch + 4);
            const u32x4 w = vraw[j];
            u32x4 o;
            o.x = cvt_pk_bf16((bflo(w.x) - mu) * rs * g0[0] + b0[0], (bfhi(w.x) - mu) * rs * g0[1] + b0[1]);
            o.y = cvt_pk_bf16((bflo(w.y) - mu) * rs * g0[2] + b0[2], (bfhi(w.y) - mu) * rs * g0[3] + b0[3]);
            o.z = cvt_pk_bf16((bflo(w.z) - mu) * rs * g1[0] + b1[0], (bfhi(w.z) - mu) * rs * g1[1] + b1[1]);
            o.w = cvt_pk_bf16((bflo(w.w) - mu) * rs * g1[2] + b1[2], (bfhi(w.w) - mu) * rs * g1[3] + b1[3]);
            *(u32x4*)(vn + tok * VS2 + ch) = o;
        }
    }
    __syncthreads();
    {
        u32x4 uw[4][2], zw[4][2];
#pragma unroll
        for (int mm = 0; mm < 4; ++mm) {
            const size_t rowH = (size_t)(T0 + (ih * 4 + mm) * 16 + fr) * INW;
#pragma unroll
            for (int nn = 0; nn < 2; ++nn) { const int ch = g * 64 + nn * 32 + fq * 8; uw[mm][nn] = *(const u32x4*)(H + rowH + C_UA + ch); zw[mm][nn] = *(const u32x4*)(H + rowH + C_ZA + ch); }
        }
        f32x4 acc[4][4];
#pragma unroll
        for (int mm = 0; mm < 4; ++mm)
#pragma unroll
            for (int n = 0; n < 4; ++n) acc[mm][n] = (f32x4){0.f, 0.f, 0.f, 0.f};
#pragma unroll
        for (int ks = 0; ks < 4; ++ks) if (ks < nks) {
            bf16x8 af[4];
#pragma unroll
            for (int n = 0; n < 4; ++n) {
                const u16* vr = vn + (ks * 32 + fq * 8 + (fr >> 2)) * VS2 + g * 64 + (n >> 1) * 32 + 8 * (fr & 3) + 4 * (n & 1);
                const s16x4 lo = tr_read4(vr), hi = tr_read4(vr + 4 * VS2);
                af[n] = __builtin_shufflevector(lo, hi, 0, 1, 2, 3, 4, 5, 6, 7);
            }
#pragma unroll
            for (int mm = 0; mm < 4; ++mm)
#pragma unroll
                for (int n = 0; n < 4; ++n) acc[mm][n] = MFMA16(af[n], wf[ks][mm], acc[mm][n]);
        }
#pragma unroll
        for (int mm = 0; mm < 4; ++mm) {
            const int i = (ih * 4 + mm) * 16 + fr;
            const float bias = p.b_s[(l * 4 + g) * 128 + i];
            const size_t rowM = (size_t)(T0 + i) * MIXW;
#pragma unroll
            for (int nn = 0; nn < 2; ++nn) {
                const int ch = g * 64 + nn * 32 + fq * 8;
                const u32x4 u4 = uw[mm][nn], z4 = zw[mm][nn];
                const f32x4 a = acc[mm][2 * nn], b2 = acc[mm][2 * nn + 1];
                u32x4 w;
                w.x = cvt_pk_bf16((a[0] + bias) * bflo(u4.x) * bflo(z4.x), (a[1] + bias) * bfhi(u4.x) * bfhi(z4.x));
                w.y = cvt_pk_bf16((a[2] + bias) * bflo(u4.y) * bflo(z4.y), (a[3] + bias) * bfhi(u4.y) * bfhi(z4.y));
                w.z = cvt_pk_bf16((b2[0] + bias) * bflo(u4.z) * bflo(z4.z), (b2[1] + bias) * bfhi(u4.z) * bfhi(z4.z));
                w.w = cvt_pk_bf16((b2[2] + bias) * bflo(u4.w) * bflo(z4.w), (b2[3] + bias) * bfhi(u4.w) * bfhi(z4.w));
                *(u32x4*)(MIX + rowM + ch) = w;
            }
        }
    }
    __syncthreads();
}

DI void sgu_sample_unit(const Params& p, int l, int b) {
    unsigned char* ws = p.ws;
    const u16* H = (const u16*)(ws + WS_H); u16* MIX = (u16*)(ws + WS_MIX);
    float* vn = (float*)shm;
    const int tid = tid_opaque(), wid = __builtin_amdgcn_readfirstlane(tid >> 6), lane = tid & 63;
    const int T0 = NTOKP + b * 16;
    const f32x4 g = *(const f32x4*)(p.ln_v_g + l * 256 + lane * 4), bb = *(const f32x4*)(p.ln_v_b + l * 256 + lane * 4);
    for (int tt = 0; tt < 2; ++tt) {
        const int tok = wid * 2 + tt;
        const u32x2 w = *(const u32x2*)(H + (size_t)(T0 + tok) * INW + C_VA + lane * 4);
        float x0 = bflo(w.x), x1 = bfhi(w.x), x2 = bflo(w.y), x3 = bfhi(w.y);
        const float mu = wave_sum((x0 + x1) + (x2 + x3)) * (1.f / 256.f);
        x0 -= mu; x1 -= mu; x2 -= mu; x3 -= mu;
        const float var = wave_sum((x0 * x0 + x1 * x1) + (x2 * x2 + x3 * x3)) * (1.f / 256.f);
        const float rs = rsqrtf(var + 1e-5f);
        f32x4 o; o[0] = x0 * rs * g[0] + bb[0]; o[1] = x1 * rs * g[1] + bb[1]; o[2] = x2 * rs * g[2] + bb[2]; o[3] = x3 * rs * g[3] + bb[3];
        *(f32x4*)(vn + tok * 256 + lane * 4) = o;
        *(f32x4*)(p.out + O_SV + ((size_t)(l * 16 + b) * 16 + tok) * 256 + lane * 4) = o;
    }
    __syncthreads();
    for (int e = 0; e < 8; ++e) {
        const int o = tid + 512 * e, i = o >> 8, ch = o & 255, g4 = ch >> 6;
        const float* wrow = p.w_s + ((size_t)(l * 4 + g4) * 128 + i) * 128;
        float s = p.b_s[(l * 4 + g4) * 128 + i];
        for (int j = 0; j < 16; ++j) s += wrow[j] * vn[j * 256 + ch];
        const size_t rowH = (size_t)(T0 + i) * INW;
        MIX[(size_t)(T0 + i) * MIXW + ch] = f2bf(s * bf2f(H[rowH + C_UA + ch]) * bf2f(H[rowH + C_ZA + ch]));
    }
    __syncthreads();
}

constexpr int HS = 72;
struct HgIn { u32x4 fb[4], q[4], v[4]; };
template <bool NEEDQ>
DI void hg_load(HgIn& x, const u16* __restrict__ H, int u, int hh, int half, int lane) {
    const int T0 = (u < NCH) ? u * 64 : NTOKP + (u - NCH) * 16, len = (u < NCH) ? 64 : 16;
#pragma unroll
    for (int i = 0; i < 4; ++i) {
        const int idx = half * 64 + lane + i * 128, j = idx >> 3, c8 = idx & 7;
        x.fb[i] = (u32x4){0u, 0u, 0u, 0u}; x.v[i] = (u32x4){0u, 0u, 0u, 0u}; x.q[i] = (u32x4){0u, 0u, 0u, 0u};
        if (j < len) {
            const u16* row = H + (size_t)(T0 + j) * INW + hh * 64 + c8 * 8;
            x.fb[i] = *(const u32x4*)(row + C_FB); x.v[i] = *(const u32x4*)(row + C_IB);
            if (NEEDQ) x.q[i] = *(const u32x4*)(row + C_QB);
        }
    }
}
DI void hgrn_local_body(const Params& p, int l, int u, const HgIn& x) {
    unsigned char* ws = p.ws;
    u16* UT = (u16*)(ws + WS_UT); float* DEC = (float*)(ws + WS_DEC);
    const float* LB = (const float*)(ws + WS_LB) + l * 256;
    const int tid = tid_opaque(), wid = __builtin_amdgcn_readfirstlane(tid >> 6), lane = tid & 63, fr = lane & 15, fq = lane >> 4;
    const int hh = wid >> 1, half = wid & 1;
    const int len = (u < NCH) ? 64 : 16;
    u16* vN = (u16*)shm + hh * (3 * 64 * HS);
    u16* kT = vN + 64 * HS;
    u16* fN = kT + 64 * HS;
    float* tot = (float*)(shm + 4 * 3 * 64 * HS * 2);
#pragma unroll
    for (int i = 0; i < 4; ++i) { const int idx = half * 64 + lane + i * 128, j = idx >> 3, c8 = idx & 7; *(u32x4*)(vN + j * HS + c8 * 8) = x.v[i]; *(u32x4*)(fN + j * HS + c8 * 8) = x.fb[i]; }
    __syncthreads();
    const float lb = LB[hh * 64 + lane];
    float fg[32], kk[32];
    float own = 1.f;
#pragma unroll
    for (int jj = 0; jj < 32; ++jj) {
        const int j = half * 32 + jj;
        const float gv = h2f(fN[j * HS + lane]);
        const float kv = (gv >= 0.f) ? gv : 1.f + gv, fv = (gv >= 0.f) ? 1.f - gv : -gv;
        fg[jj] = fv; kk[jj] = kv; own *= fv;
    }
    tot[(hh * 2 + half) * 64 + lane] = own;
    __syncthreads();
    {
        const float other = tot[(hh * 2 + (1 - half)) * 64 + lane];
        float s = half ? 1.f : other;
        unsigned pk[16];
#pragma unroll
        for (int jj = 31; jj >= 0; jj -= 2) {
            const float k1 = kk[jj] * s; s *= fg[jj];
            const float k0 = kk[jj - 1] * s; s *= fg[jj - 1];
            pk[jj >> 1] = cvt_pk_bf16(k0, k1);
        }
        if (half == 0) { const float dk = s; if (u < NCH) DEC[((size_t)u * 4 + hh) * 64 + lane] = dk; else tot[512 + hh * 64 + lane] = dk; }
#pragma unroll
        for (int q = 0; q < 4; ++q) { u32x4 w = {pk[4 * q], pk[4 * q + 1], pk[4 * q + 2], pk[4 * q + 3]}; *(u32x4*)(kT + lane * HS + half * 32 + q * 8) = w; }
    }
    __syncthreads();
    {
        f32x4 acc[2][4];
#pragma unroll
        for (int a = 0; a < 2; ++a)
#pragma unroll
            for (int kt = 0; kt < 4; ++kt) acc[a][kt] = (f32x4){0.f, 0.f, 0.f, 0.f};
#pragma unroll
        for (int ks = 0; ks < 2; ++ks) {
            bf16x8 av[2], bk[4];
#pragma unroll
            for (int a = 0; a < 2; ++a) {
                const u16* vr = vN + (ks * 32 + fq * 8 + (fr >> 2)) * HS + (half * 2 + a) * 16 + 4 * (fr & 3);
                const s16x4 lo = tr_read4(vr), hi = tr_read4(vr + 4 * HS);
                av[a] = __builtin_shufflevector(lo, hi, 0, 1, 2, 3, 4, 5, 6, 7);
            }
#pragma unroll
            for (int kt = 0; kt < 4; ++kt) bk[kt] = *(const bf16x8*)(kT + (kt * 16 + fr) * HS + ks * 32 + fq * 8);
#pragma unroll
            for (int a = 0; a < 2; ++a)
#pragma unroll
                for (int kt = 0; kt < 4; ++kt) acc[a][kt] = MFMA16(bk[kt], av[a], acc[a][kt]);
        }
        if (u < NCH) {
            u16* dst = UT + ((size_t)u * 4 + hh) * 4096;
#pragma unroll
            for (int a = 0; a < 2; ++a)
#pragma unroll
                for (int kt = 0; kt < 4; ++kt) {
                    u32x2 w; w.x = cvt_pk_bf16(acc[a][kt][0], acc[a][kt][1]); w.y = cvt_pk_bf16(acc[a][kt][2], acc[a][kt][3]);
                    *(u32x2*)(dst + ((half * 2 + a) * 16 + fr) * 64 + kt * 16 + fq * 4) = w;
                }
        } else {
            const size_t so = ((size_t)(l * 16 + (u - NCH)) * 4 + hh) * 4096;
#pragma unroll
            for (int kt = 0; kt < 4; ++kt)
#pragma unroll
                for (int r = 0; r < 4; ++r) {
                    const int k = kt * 16 + fq * 4 + r;
                    const float dk = tot[512 + hh * 64 + k];
#pragma unroll
                    for (int a = 0; a < 2; ++a) {
                        const int v = (half * 2 + a) * 16 + fr;
                        p.out[O_HS + so + k * 64 + v] = p.state_hgrn[so + k * 64 + v] * dk + acc[a][kt][r];
                    }
                }
        }
    }
    __syncthreads();
}
DI void hgrn_local_run(const Params& p, int l, int u0, int n) {
    const u16* H = (const u16*)(p.ws + WS_H);
    const int tid = tid_opaque(), wid = __builtin_amdgcn_readfirstlane(tid >> 6), lane = tid & 63;
    const int hh = wid >> 1, half = wid & 1;
    HgIn cur; hg_load<false>(cur, H, u0, hh, half, lane);
#pragma unroll 1
    for (int i = 0; i < n; ++i) {
        HgIn nxt = cur;
        if (i + 1 < n) hg_load<false>(nxt, H, u0 + i + 1, hh, half, lane);
        hgrn_local_body(p, l, u0 + i, cur);
        cur = nxt;
    }
}

DI void hgrn_scan_phase(const Params& p, int l, int wgi, int nwg) {
    unsigned char* ws = p.ws;
    const u16* __restrict__ UT = (const u16*)(ws + WS_UT); const float* __restrict__ DEC = (const float*)(ws + WS_DEC);
    u16* __restrict__ SBUF = (u16*)(ws + WS_SB);
    const long gt = (long)wgi * 512 + tid_opaque(), nth = (long)nwg * 512;
    for (long item = gt; item < 128 * 4096; item += nth) {
        const int seq = (int)(item >> 12), e = (int)(item & 4095), k = e & 63, v = e >> 6;
        if (seq < 64) {
            const int b = seq >> 2, hh = seq & 3;
            float s = 0.f;
            for (int c0 = 0; c0 < 64; c0 += 16) {
                float uu[16], dd[16];
#pragma unroll
                for (int c = 0; c < 16; ++c) { const size_t ub = (size_t)(b * 64 + c0 + c) * 4 + hh; uu[c] = bf2f(UT[ub * 4096 + e]); dd[c] = DEC[ub * 64 + k]; }
#pragma unroll
                for (int c = 0; c < 16; ++c) { const size_t ub = (size_t)(b * 64 + c0 + c) * 4 + hh; SBUF[ub * 4096 + e] = f2bf(s); s = dd[c] * s + uu[c]; }
            }
            p.out[O_HP + ((size_t)(l * 16 + b) * 4 + hh) * 4096 + k * 64 + v] = s;
        } else {
            const int b = (seq - 64) >> 2, hh = seq & 3;
            const size_t ub = (size_t)(NCH + b) * 4 + hh;
            SBUF[ub * 4096 + e] = f2bf(p.state_hgrn[((size_t)(l * 16 + b) * 4 + hh) * 4096 + k * 64 + v]);
        }
    }
}

DI void hgrn_out_body(const Params& p, int l, int u, const HgIn& x) {
    unsigned char* ws = p.ws;
    const u16* H = (const u16*)(ws + WS_H); u16* MIX = (u16*)(ws + WS_MIX);
    const u16* SBUF = (const u16*)(ws + WS_SB);
    const float* LB = (const float*)(ws + WS_LB) + l * 256;
    const int tid = tid_opaque(), wid = __builtin_amdgcn_readfirstlane(tid >> 6), lane = tid & 63, fr = lane & 15, fq = lane >> 4;
    const int hh = wid >> 1, half = wid & 1;
    const int T0 = (u < NCH) ? u * 64 : NTOKP + (u - NCH) * 16, len = (u < NCH) ? 64 : 16;
    u16* vN = (u16*)shm + hh * (4 * 64 * HS);
    u16* kh = vN + 64 * HS;
    u16* qh = kh + 64 * HS;
    u16* qt = qh + 64 * HS;
    float* tot = (float*)(shm + 4 * 4 * 64 * HS * 2);
#pragma unroll
    for (int i = 0; i < 4; ++i) {
        const int idx = half * 64 + lane + i * 128, j = idx >> 3, c8 = idx & 7;
        *(u32x4*)(vN + j * HS + c8 * 8) = x.v[i]; *(u32x4*)(kh + j * HS + c8 * 8) = x.fb[i]; *(u32x4*)(qh + j * HS + c8 * 8) = x.q[i];
    }
    bf16x8 sfr[2][4];
    {
        const u16* Sg = SBUF + ((size_t)u * 4 + hh) * 4096;
#pragma unroll
        for (int ks = 0; ks < 2; ++ks)
#pragma unroll
            for (int vt = 0; vt < 4; ++vt) sfr[ks][vt] = *(const bf16x8*)(Sg + ((vt >> 1) * 32 + 8 * (fr >> 2) + 4 * (vt & 1) + (fr & 3)) * 64 + ks * 32 + fq * 8);
    }
    u32x4 zw[2][2];
#pragma unroll
    for (int ii = 0; ii < 2; ++ii) {
        const int i = min((half * 2 + ii) * 16 + fr, len - 1);
#pragma unroll
        for (int vv = 0; vv < 2; ++vv) zw[ii][vv] = *(const u32x4*)(H + (size_t)(T0 + i) * INW + C_ZB + hh * 64 + vv * 32 + fq * 8);
    }
    __syncthreads();
    const float lb = LB[hh * 64 + lane];
    float fg[32], kk[32];
    float own = 1.f;
#pragma unroll
    for (int jj = 0; jj < 32; ++jj) {
        const int j = half * 32 + jj;
        const float gv = h2f(kh[j * HS + lane]);
        const float kv = (gv >= 0.f) ? gv : 1.f + gv, fv = (gv >= 0.f) ? 1.f - gv : -gv;
        own *= fv; fg[jj] = fv; kk[jj] = kv;
    }
    tot[(hh * 2 + half) * 64 + lane] = own;
    float qhv[32];
    if (half) {
        float D = 1.f;
#pragma unroll
        for (int jj = 0; jj < 32; ++jj) {
            const int j = 32 + jj;
            D *= fg[jj];
            const float qv = bf2f(qh[j * HS + lane]) * D;
            qhv[jj] = qv;
            kh[j * HS + lane] = f2bf(kk[jj] * __builtin_amdgcn_rcpf(D));
            qh[j * HS + lane] = f2bf(qv);
        }
    } else {
        float R = 1.f;
#pragma unroll
        for (int jj = 31; jj >= 0; --jj) {
            const int j = jj;
            const float qv = bf2f(qh[j * HS + lane]) * __builtin_amdgcn_rcpf(R);
            qhv[jj] = qv;
            kh[j * HS + lane] = f2bf(kk[jj] * R);
            qh[j * HS + lane] = f2bf(qv);
            R *= fg[jj];
        }
    }
    __syncthreads();
    {
        const float other = tot[(hh * 2 + (1 - half)) * 64 + lane];
        const float C = half ? other : own;
#pragma unroll
        for (int jj = 0; jj < 32; ++jj) { const int j = half * 32 + jj; qt[j * HS + lane] = f2bf(qhv[jj] * C); }
    }
    {
        f32x4 at[2][4];
#pragma unroll
        for (int ii = 0; ii < 2; ++ii)
#pragma unroll
            for (int jt = 0; jt < 4; ++jt) at[ii][jt] = (f32x4){0.f, 0.f, 0.f, 0.f};
#pragma unroll
        for (int ks = 0; ks < 2; ++ks) {
            bf16x8 bqf[2];
#pragma unroll
            for (int ii = 0; ii < 2; ++ii) bqf[ii] = *(const bf16x8*)(qh + ((half * 2 + ii) * 16 + fr) * HS + ks * 32 + fq * 8);
#pragma unroll
            for (int jt = 0; jt < 4; ++jt) if (jt <= half * 2 + 1) {
                const bf16x8 ak = *(const bf16x8*)(kh + (jt * 16 + fr) * HS + ks * 32 + fq * 8);
#pragma unroll
                for (int ii = 0; ii < 2; ++ii) at[ii][jt] = MFMA16(ak, bqf[ii], at[ii][jt]);
            }
        }
        bf16x8 pb[2][2];
#pragma unroll
        for (int ii = 0; ii < 2; ++ii) {
            const int i = (half * 2 + ii) * 16 + fr;
#pragma unroll
            for (int jt = 0; jt < 4; ++jt)
#pragma unroll
                for (int r = 0; r < 4; ++r) { const int j = jt * 16 + fq * 4 + r; if (j > i) at[ii][jt][r] = 0.f; }
#pragma unroll
            for (int s2 = 0; s2 < 2; ++s2) {
                u32x4 w;
                w.x = cvt_pk_bf16(at[ii][2 * s2][0], at[ii][2 * s2][1]); w.y = cvt_pk_bf16(at[ii][2 * s2][2], at[ii][2 * s2][3]);
                w.z = cvt_pk_bf16(at[ii][2 * s2 + 1][0], at[ii][2 * s2 + 1][1]); w.w = cvt_pk_bf16(at[ii][2 * s2 + 1][2], at[ii][2 * s2 + 1][3]);
                pb[ii][s2] = __builtin_bit_cast(bf16x8, w);
            }
        }
        f32x4 o[4][2];
#pragma unroll
        for (int vt = 0; vt < 4; ++vt) { o[vt][0] = (f32x4){0.f, 0.f, 0.f, 0.f}; o[vt][1] = (f32x4){0.f, 0.f, 0.f, 0.f}; }
#pragma unroll
        for (int s2 = 0; s2 < 2; ++s2) if (s2 <= half) {
#pragma unroll
            for (int vt = 0; vt < 4; ++vt) {
                const u16* vr = vN + (32 * s2 + 4 * fq + (fr >> 2)) * HS + (vt >> 1) * 32 + 8 * (fr & 3) + 4 * (vt & 1);
                const s16x4 lo = tr_read4(vr), hi = tr_read4(vr + 16 * HS);
                const bf16x8 a = __builtin_shufflevector(lo, hi, 0, 1, 2, 3, 4, 5, 6, 7);
                o[vt][0] = MFMA16(a, pb[0][s2], o[vt][0]); o[vt][1] = MFMA16(a, pb[1][s2], o[vt][1]);
            }
        }
        __syncthreads();
#pragma unroll
        for (int ks = 0; ks < 2; ++ks) {
            bf16x8 bqf[2];
#pragma unroll
            for (int ii = 0; ii < 2; ++ii) bqf[ii] = *(const bf16x8*)(qt + ((half * 2 + ii) * 16 + fr) * HS + ks * 32 + fq * 8);
#pragma unroll
            for (int vt = 0; vt < 4; ++vt) { o[vt][0] = MFMA16(sfr[ks][vt], bqf[0], o[vt][0]); o[vt][1] = MFMA16(sfr[ks][vt], bqf[1], o[vt][1]); }
        }
#pragma unroll
        for (int ii = 0; ii < 2; ++ii) {
            float ss = 0.f;
#pragma unroll
            for (int vt = 0; vt < 4; ++vt) { const f32x4 xx = o[vt][ii]; ss += (xx[0] * xx[0] + xx[1] * xx[1]) + (xx[2] * xx[2] + xx[3] * xx[3]); }
            ss += __shfl_xor(ss, 16); ss += __shfl_xor(ss, 32);
            const float rs = rsqrtf(ss * (1.f / 64.f) + 1e-6f);
            const int i = (half * 2 + ii) * 16 + fr;
            if (i < len) {
#pragma unroll
                for (int vv = 0; vv < 2; ++vv) {
                    const int v = vv * 32 + fq * 8;
                    const f32x4 ga = *(const f32x4*)(p.norm_b_g + l * 64 + v), gb = *(const f32x4*)(p.norm_b_g + l * 64 + v + 4);
                    const u32x4 z4 = zw[ii][vv];
                    const f32x4 xa = o[2 * vv][ii], xb = o[2 * vv + 1][ii];
                    u32x4 w;
                    w.x = cvt_pk_bf16(xa[0] * rs * ga[0] * bflo(z4.x), xa[1] * rs * ga[1] * bfhi(z4.x)); w.y = cvt_pk_bf16(xa[2] * rs * ga[2] * bflo(z4.y), xa[3] * rs * ga[3] * bfhi(z4.y));
                    w.z = cvt_pk_bf16(xb[0] * rs * gb[0] * bflo(z4.z), xb[1] * rs * gb[1] * bfhi(z4.z)); w.w = cvt_pk_bf16(xb[2] * rs * gb[2] * bflo(z4.w), xb[3] * rs * gb[3] * bfhi(z4.w));
                    *(u32x4*)(MIX + (size_t)(T0 + i) * MIXW + 256 + hh * 64 + v) = w;
                }
            }
        }
    }
}
DI void hgrn_out_run(const Params& p, int l, int u0, int n) {
    const u16* H = (const u16*)(p.ws + WS_H);
    const int tid = tid_opaque(), wid = __builtin_amdgcn_readfirstlane(tid >> 6), lane = tid & 63;
    const int hh = wid >> 1, half = wid & 1;
    HgIn cur; hg_load<true>(cur, H, u0, hh, half, lane);
#pragma unroll 1
    for (int i = 0; i < n; ++i) {
        HgIn nxt = cur;
        if (i + 1 < n) hg_load<true>(nxt, H, u0 + i + 1, hh, half, lane);
        hgrn_out_body(p, l, u0 + i, cur);
        cur = nxt;
    }
    __syncthreads();
}

DI void ln_phase(const Params& p, int l, int row0, int row1, int wgi, int nwg) {
    unsigned char* ws = p.ws;
    const u16* Z = (const u16*)(ws + WS_H);
    u16* XB = (u16*)(ws + WS_XB);
    const int tid = tid_opaque(), wid = __builtin_amdgcn_readfirstlane(tid >> 6), lane = tid & 63;
    f32x4 g[4], bb[4];
#pragma unroll
    for (int j = 0; j < 2; ++j) {
        g[2 * j] = *(const f32x4*)(p.ln_g + l * DM + lane * 8 + 512 * j); g[2 * j + 1] = *(const f32x4*)(p.ln_g + l * DM + lane * 8 + 512 * j + 4);
        bb[2 * j] = *(const f32x4*)(p.ln_b + l * DM + lane * 8 + 512 * j); bb[2 * j + 1] = *(const f32x4*)(p.ln_b + l * DM + lane * 8 + 512 * j + 4);
    }
    const int stride = nwg * 8;
    for (int rowa = row0 + wgi * 8 + wid; rowa < row1; rowa += 2 * stride) {
        const int rowb = rowa + stride;
        const bool hasb = rowb < row1;
        const u16* za = Z + (size_t)rowa * DM + lane * 8;
        const u16* zb = Z + (size_t)(hasb ? rowb : rowa) * DM + lane * 8;
        const u32x4 wa0 = *(const u32x4*)za, wa1 = *(const u32x4*)(za + 512), wb0 = *(const u32x4*)zb, wb1 = *(const u32x4*)(zb + 512);
#pragma unroll
        for (int rr = 0; rr < 2; ++rr) {
            if (rr == 1 && !hasb) break;
            const int row = rr ? rowb : rowa;
            const u32x4 w0 = rr ? wb0 : wa0, w1 = rr ? wb1 : wa1;
            f32x4 v[4];
            v[0] = (f32x4){bflo(w0.x), bfhi(w0.x), bflo(w0.y), bfhi(w0.y)}; v[1] = (f32x4){bflo(w0.z), bfhi(w0.z), bflo(w0.w), bfhi(w0.w)};
            v[2] = (f32x4){bflo(w1.x), bfhi(w1.x), bflo(w1.y), bfhi(w1.y)}; v[3] = (f32x4){bflo(w1.z), bfhi(w1.z), bflo(w1.w), bfhi(w1.w)};
            float s = 0.f;
#pragma unroll
            for (int j = 0; j < 4; ++j) s += (v[j][0] + v[j][1]) + (v[j][2] + v[j][3]);
            const float mu = wave_sum(s) * (1.f / DM);
            float s2 = 0.f;
#pragma unroll
            for (int j = 0; j < 4; ++j) { v[j] = v[j] - mu; s2 += (v[j][0] * v[j][0] + v[j][1] * v[j][1]) + (v[j][2] * v[j][2] + v[j][3] * v[j][3]); }
            const float rs = rsqrtf(wave_sum(s2) * (1.f / DM) + 1e-5f);
#pragma unroll
            for (int j = 0; j < 4; ++j) v[j] = v[j] * rs * g[j] + bb[j];
            if (l == 0) {
                u16* xr = XB + (size_t)row * DM + lane * 8;
#pragma unroll
                for (int j = 0; j < 2; ++j) {
                    u32x4 w; w.x = cvt_pk_bf16(v[2 * j][0], v[2 * j][1]); w.y = cvt_pk_bf16(v[2 * j][2], v[2 * j][3]); w.z = cvt_pk_bf16(v[2 * j + 1][0], v[2 * j + 1][1]); w.w = cvt_pk_bf16(v[2 * j + 1][2], v[2 * j + 1][3]);
                    *(u32x4*)(xr + 512 * j) = w;
                }
            } else {
                float* yr = p.out + (size_t)row * DM + lane * 8;
#pragma unroll
                for (int j = 0; j < 2; ++j) { __builtin_nontemporal_store(v[2 * j], (f32x4*)(yr + 512 * j)); __builtin_nontemporal_store(v[2 * j + 1], (f32x4*)(yr + 512 * j + 4)); }
            }
        }
    }
}

DI void phase_mix_a(const Params& p, int l) {
    unsigned char* ws = p.ws;
    const u16* H = (const u16*)(ws + WS_H); u16* MIX = (u16*)(ws + WS_MIX);
    constexpr int N_AT = 256, N_HL = NCH, N_SG = 512;
    const int G = gridDim.x;
    int w = blockIdx.x;
    for (; w < N_AT; w += G) attn_run(p, l, w);
    asm volatile("" ::: "memory");
    for (; w < N_AT + N_HL / 4; w += G) hgrn_local_run(p, l, (w - N_AT) * 4, 4);
    asm volatile("" ::: "memory");
    for (; w < N_AT + N_HL / 4 + N_SG; w += G) sgu_prompt_unit(p, l, w - N_AT - N_HL / 4);
}

DI void phase_mix_b(const Params& p, int l) {
    unsigned char* ws = p.ws;
    const u16* H = (const u16*)(ws + WS_H); u16* MIX = (u16*)(ws + WS_MIX);
    const u16* KVS = (const u16*)(ws + WS_KVS) + (size_t)l * 16 * 144 * 256;
    constexpr int N_HO = NCH / 4 + 16, N_HL = 16, N_AS = 32, N_SS = 16;
    const int G = gridDim.x;
    int w = blockIdx.x;
    for (; w < N_HO; w += G) { if (w < NCH / 4) hgrn_out_run(p, l, w * 4, 4); else hgrn_out_run(p, l, NCH + (w - NCH / 4), 1); }
    asm volatile("" ::: "memory");
    for (; w < N_HO + N_HL; w += G) hgrn_local_run(p, l, NCH + (w - N_HO), 1);
    asm volatile("" ::: "memory");
    for (; w < N_HO + N_HL + N_AS; w += G) {
        const int r = w - (N_HO + N_HL);
        const int g = r & 1, b = r >> 1;
        const size_t Tq = (size_t)NTOKP + b * 16;
        const u16* kv = KVS + (size_t)b * 144 * 256;
        attn_unit(H + Tq * INW + C_QC + g * 256, INW, 16, kv + g * 64, kv + 128 + g * 64, 256, 144,
                  H + Tq * INW + C_ZC + g * 256, INW, MIX + Tq * MIXW + 512 + g * 256, MIXW, p.sinks + l * 8 + g * 4);
    }
    asm volatile("" ::: "memory");
    for (; w < N_HO + N_HL + N_AS + N_SS; w += G) sgu_sample_unit(p, l, w - (N_HO + N_HL + N_AS));
}

__global__ void __launch_bounds__(512, 2) fwd_megakernel(Params p) {
    cg::grid_group grid = cg::this_grid();
    unsigned char* ws = p.ws;
    volatile LAS unsigned* st = (volatile LAS unsigned*)((LAS unsigned char*)shm + (LDS_BYTES - 16));
    if (threadIdx.x == 0) { st[0] = 0u; st[1] = 0u; }
    __syncthreads();
    XcdBarrier xb = xcd_barrier_post((unsigned*)(ws + WS_BAR), st);
    for (int rep = 0; rep < REP_PRO; ++rep) { phase_prologue(p); if (rep + 1 < REP_PRO) xcd_barrier(xb); }
    grid.sync();
    const int G = gridDim.x, wg = blockIdx.x;
#pragma unroll 1
    for (int l = 0; l < 2; ++l) {
#pragma unroll 1
        for (int rep = 0; rep < REP_G1; ++rep) {
            EpiIn e; e.ws = ws; e.out = p.out; e.l = l;
            #ifndef G1_WGM
#define G1_WGM 8
#endif
            StaticOrder so; so.init(NTOKP / BM, INW / BM, G, wg, 0, G1_WGM);
            gemm_phase((const u16*)(ws + WS_XB), (const u16*)(ws + WS_WTIN) + (size_t)l * INW * DM, so, e);
            xcd_barrier(xb);
        }
#pragma unroll 1
        for (int rep = 0; rep < REP_MIXA; ++rep) { phase_mix_a(p, l); xcd_barrier(xb); }
#pragma unroll 1
        for (int rep = 0; rep < REP_SCAN; ++rep) {
            if (wg < 12) {
                EpiIn e; e.ws = ws; e.out = p.out; e.l = l;
                StaticOrder so; so.init(1, INW / BM, 12, wg, NTOKP / BM);
                gemm_phase((const u16*)(ws + WS_XB), (const u16*)(ws + WS_WTIN) + (size_t)l * INW * DM, so, e);
            } else hgrn_scan_phase(p, l, wg - 12, G - 12);
            xcd_barrier(xb);
        }
#pragma unroll 1
        for (int rep = 0; rep < REP_HOUT; ++rep) { phase_mix_b(p, l); xcd_barrier(xb); }
#pragma unroll 1
        for (int rep = 0; rep < REP_G2; ++rep) {
            EpiOut e; e.ws = ws;
            StaticOrder so; so.init(NTOKP / BM, DM / BM, G, wg, 0);
            gemm_phase((const u16*)(ws + WS_MIX), (const u16*)(ws + WS_WTOUT) + (size_t)l * DM * MIXW, so, e);
            xcd_barrier(xb);
        }
#pragma unroll 1
        for (int rep = 0; rep < REP_LN; ++rep) {
            if (wg < 4) {
                EpiOut e; e.ws = ws;
                StaticOrder so; so.init(1, DM / BM, 4, wg, NTOKP / BM);
                gemm_phase((const u16*)(ws + WS_MIX), (const u16*)(ws + WS_WTOUT) + (size_t)l * DM * MIXW, so, e);
            } else ln_phase(p, l, 0, NTOKP, wg - 4, G - 4);
            xcd_barrier(xb);
        }
        if (wg < 32) ln_phase(p, l, NTOKP, MTOT, wg, 32);
    }
}


extern "C" void kernel_launch(void* const* d_in, const int* in_sizes, int n_in, void* d_out, int out_size, void* d_ws, size_t ws_size, hipStream_t stream) {
    static int grid_blocks = 0;
    if (!grid_blocks) {
        int dev = 0, cus = 0, per_cu = 0;
        (void)hipGetDevice(&dev);
        (void)hipDeviceGetAttribute(&cus, hipDeviceAttributeMultiprocessorCount, dev);
        (void)hipFuncSetAttribute((const void*)fwd_megakernel, hipFuncAttributeMaxDynamicSharedMemorySize, LDS_BYTES);
        (void)hipOccupancyMaxActiveBlocksPerMultiprocessor(&per_cu, (const void*)fwd_megakernel, 512, LDS_BYTES);
        if (per_cu < 1) { fprintf(stderr, "occupancy query returned %d\n", per_cu); per_cu = 1; }
        grid_blocks = cus * per_cu;
        if (ws_size < WS_END) fprintf(stderr, "workspace too small: %zu < %zu\n", ws_size, (size_t)WS_END);
    }
    Params p{};
    p.x_prompt = (const float*)d_in[0]; p.x_sample = (const float*)d_in[1]; p.cache_k = (const float*)d_in[2]; p.cache_v = (const float*)d_in[3];
    p.state_hgrn = (const float*)d_in[4]; p.w_in = (const float*)d_in[5]; p.ln_v_g = (const float*)d_in[6]; p.ln_v_b = (const float*)d_in[7];
    p.w_s = (const float*)d_in[8]; p.b_s = (const float*)d_in[9]; p.lb_param = (const float*)d_in[10]; p.norm_b_g = (const float*)d_in[11];
    p.sinks = (const float*)d_in[12]; p.w_out = (const float*)d_in[13]; p.ln_g = (const float*)d_in[14]; p.ln_b = (const float*)d_in[15];
    p.out = (float*)d_out; p.ws = (unsigned char*)d_ws;
    for (int i = 0; i < 8; ++i) p.inv[i] = powf(500000.0f, -(float)(2 * i) / 16.0f);
    (void)hipMemsetAsync((unsigned char*)d_ws + WS_BAR, 0, 16384, stream);
    void* args[] = {&p};
    hipError_t e = hipLaunchCooperativeKernel((const void*)fwd_megakernel, dim3(grid_blocks), dim3(512), args, LDS_BYTES, stream);
    if (e != hipSuccess) fprintf(stderr, "cooperative launch failed: %s (grid %d)\n", hipGetErrorString(e), grid_blocks);
}
```
